# Optimizing an MI355X kernel written in HIP

```python
import jax, jax.numpy as jnp
from jax import lax
import numpy as np

D_MODEL = 1024
BATCH = 8
SEQ = 4096
DEPTH = 2

GRID_W = 64
CTX_LEN = 256
EPS = 1e-6
ATTN_QBLOCK = 128
ROPE_BASE = 10000.0

MLA_HEADS = 8
MLA_Q_RANK = 384
MLA_KV_RANK = 256
MLA_NOPE = 64
MLA_ROPE = 32
MLA_V = 64
ROPE_PAIRS = MLA_ROPE // 4
MLSTM_HEADS = 4
MLSTM_DH = 128
MLSTM_CONV = 3
MLSTM_CHUNK = 64
GLA_HEADS = 4
GLA_DK = 64
GLA_DV = 128
GLA_GATE_RANK = 16
GLA_TAU = 16.0
GLA_CHUNK = 64
NA_HEADS = 8
NA_DH = 64
NA_KH = 8
NA_KW = 16

BRANCH_A = MLA_HEADS * MLA_V
BRANCH_B = MLSTM_HEADS * MLSTM_DH
BRANCH_C = GLA_HEADS * GLA_DV
BRANCH_D = NA_HEADS * NA_DH
EVEN_SPLITS = (MLA_Q_RANK, MLA_KV_RANK, MLA_ROPE, BRANCH_B, BRANCH_B, BRANCH_B, BRANCH_B, 4 * MLSTM_HEADS, BRANCH_A + BRANCH_B)
ODD_SPLITS = (GLA_HEADS * GLA_DK, GLA_HEADS * GLA_DK, BRANCH_C, 2 * GLA_GATE_RANK, BRANCH_D, BRANCH_D, BRANCH_D, BRANCH_C + BRANCH_D)
EVEN_IN = sum(EVEN_SPLITS)
ODD_IN = sum(ODD_SPLITS)

kernel_name = 'hybrid_mla_mlstm_gla_natten_dit'


def split_cols(a, sizes):
    return jnp.split(a, np.cumsum(sizes)[:-1].tolist(), axis=-1)


def rmsnorm(x, g):
    xf = x.astype(jnp.float32)
    xf = xf * lax.rsqrt(jnp.mean(xf * xf, axis=-1, keepdims=True) + EPS)
    return xf.astype(x.dtype) * g


def head_rmsnorm(x, g, n_heads):
    B, T, W = x.shape
    return rmsnorm(x.reshape(B, T, n_heads, W // n_heads), g.reshape(n_heads, -1)).reshape(B, T, W)


def to_heads(a, n_heads):
    B, T, W = a.shape
    return a.reshape(B, T, n_heads, W // n_heads).transpose(0, 2, 1, 3)


def merge_heads(a):
    B, H, T, d = a.shape
    return a.transpose(0, 2, 1, 3).reshape(B, T, H * d)


def centred_dwconv(x, w, b):
    K = w.shape[0]
    T = x.shape[1]
    pad = K // 2
    xp = jnp.pad(x, ((0, 0), (pad, K - 1 - pad), (0, 0)))
    y = xp[:, 0:T] * w[0]
    for j in range(1, K):
        y = y + xp[:, j:j + T] * w[j]
    return y + b


def rope2d_tables(S):
    t = jnp.arange(S)
    inv = 1.0 / (ROPE_BASE ** (jnp.arange(ROPE_PAIRS, dtype=jnp.float32) / ROPE_PAIRS))
    ang = jnp.concatenate([(t // GRID_W)[:, None] * inv, (t % GRID_W)[:, None] * inv], axis=-1)
    return jnp.cos(ang), jnp.sin(ang)


def apply_rope2d(x, cos, sin):
    cos = cos.astype(x.dtype)
    sin = sin.astype(x.dtype)
    parts = []
    for a in range(2):
        y = x[..., a * 2 * ROPE_PAIRS:(a + 1) * 2 * ROPE_PAIRS]
        y1, y2 = y[..., :ROPE_PAIRS], y[..., ROPE_PAIRS:]
        ca = cos[:, a * ROPE_PAIRS:(a + 1) * ROPE_PAIRS]
        sa = sin[:, a * ROPE_PAIRS:(a + 1) * ROPE_PAIRS]
        parts += [y1 * ca - y2 * sa, y2 * ca + y1 * sa]
    return jnp.concatenate(parts, axis=-1)


def to_chunks(a, L):
    B, H, T = a.shape[:3]
    return jnp.moveaxis(a.reshape(B, H, T // L, L, *a.shape[3:]), 2, 0)


def from_chunks(a):
    nc, B, H, L = a.shape[:4]
    return jnp.moveaxis(a, 0, 2).reshape(B, H, nc * L, *a.shape[4:])


def block_attention(q, k, v, scale):
    B, H, S, dq = q.shape
    nb = S // ATTN_QBLOCK
    qb = jnp.moveaxis(q.reshape(B, H, nb, ATTN_QBLOCK, dq), 2, 0)

    def one_block(qi):
        s = jnp.einsum('bhqd,bhkd->bhqk', qi, k).astype(jnp.float32) * scale
        p = jax.nn.softmax(s, axis=-1).astype(v.dtype)
        return jnp.einsum('bhqk,bhkd->bhqd', p, v)

    o = lax.map(one_block, qb)
    return jnp.moveaxis(o, 0, 2).reshape(B, H, S, v.shape[-1])


def mlstm_chunked(q, k, v, ig, lf, state):
    L = MLSTM_CHUNK
    causal = jnp.tril(jnp.ones((L, L), dtype=bool))

    def step(carry, xs):
        C, n, m = carry
        qc, kc, vc, ic, fc = xs
        b = jnp.cumsum(fc, axis=-1)
        logw = jnp.where(causal, b[..., :, None] - b[..., None, :] + ic[..., None, :], -jnp.inf)
        inter = b + m[..., None]
        m_t = jnp.maximum(inter, jnp.max(logw, axis=-1))
        w_intra = jnp.exp(logw - m_t[..., None])
        w_inter = jnp.exp(inter - m_t)
        qk = jnp.einsum('bhtd,bhsd->bhts', qc, kc) * w_intra
        num = jnp.einsum('bhts,bhsv->bhtv', qk, vc) + w_inter[..., None] * jnp.einsum('bhtd,bhdv->bhtv', qc, C)
        den = jnp.sum(qk, axis=-1) + w_inter * jnp.einsum('bhtd,bhd->bht', qc, n)
        h = num / jnp.maximum(jnp.abs(den), jnp.exp(-m_t))[..., None]
        b_last = b[..., -1]
        logk = b_last[..., None] - b + ic
        m_new = jnp.maximum(b_last + m, jnp.max(logk, axis=-1))
        carry_decay = jnp.exp(b_last + m - m_new)
        kw = jnp.exp(logk - m_new[..., None])[..., None] * kc
        C = carry_decay[..., None, None] * C + jnp.einsum('bhsd,bhsv->bhdv', kw, vc)
        n = carry_decay[..., None] * n + jnp.sum(kw, axis=2)
        return (C, n, m_new), h

    xs = tuple(to_chunks(a.astype(jnp.float32), L) for a in (q, k, v, ig, lf))
    state, h = lax.scan(step, state, xs)
    return from_chunks(h), state


def gla_chunked(q, k, v, lg, S0):
    L = GLA_CHUNK
    causal = jnp.tril(jnp.ones((L, L), dtype=bool))

    def step(S, xs):
        qc, kc, vc, gc = xs
        bcum = jnp.cumsum(gc, axis=2)
        rel = bcum[:, :, :, None, :] - bcum[:, :, None, :, :]
        decay = jnp.exp(jnp.where(causal[:, :, None], rel, -jnp.inf))
        att = jnp.einsum('bhtd,bhsd,bhtsd->bhts', qc, kc, decay)
        o = jnp.einsum('bhts,bhsv->bhtv', att, vc) + jnp.einsum('bhtd,bhdv->bhtv', qc * jnp.exp(bcum), S)
        b_last = bcum[:, :, -1:]
        S_new = jnp.exp(b_last[:, :, 0])[..., None] * S + jnp.einsum('bhsd,bhsv->bhdv', kc * jnp.exp(b_last - bcum), vc)
        return S_new, o

    xs = tuple(to_chunks(a.astype(jnp.float32), L) for a in (q, k, v, lg))
    S, o = lax.scan(step, S0, xs)
    return from_chunks(o), S


def bidirectional_scan(chunk_fn, init_state, shared_c, gates_c, shared_l, gates_l):
    outs_c, outs_l = [], []
    for d in range(2):
        if d == 0:
            f = lambda a: a
        else:
            f = lambda a: jnp.flip(a, axis=2)
        hc, st = chunk_fn(*[f(a) for a in shared_c], *[f(g[d]) for g in gates_c], init_state)
        hl, _ = chunk_fn(*[f(a) for a in shared_l], *[f(g[d]) for g in gates_l], st)
        outs_c.append(f(hc))
        outs_l.append(f(hl))
    return outs_c[0] + outs_c[1], outs_l[0] + outs_l[1]


def neighbourhood_attention(q, k, v, k_ctx, v_ctx, rpb, rows):
    B, H, S, d = q.shape
    kh = min(NA_KH, rows)
    qg = q.reshape(B, H, rows, GRID_W, d)
    kg = k.reshape(B, H, rows, GRID_W, d)
    vg = v.reshape(B, H, rows, GRID_W, d)
    r_idx = jnp.arange(rows)
    c_idx = jnp.arange(GRID_W)
    win_rows = jnp.clip(r_idx - kh // 2, 0, rows - kh)[:, None] + jnp.arange(kh)
    win_cols = jnp.clip(c_idx - NA_KW // 2, 0, GRID_W - NA_KW)[:, None] + jnp.arange(NA_KW)
    dcol = win_cols - c_idx[:, None] + (NA_KW - 1)
    scale = d ** -0.5
    n_loc = kh * NA_KW

    def one_row(r):
        rws = win_rows[r]
        drow = rws - r + (NA_KH - 1)
        bias = rpb[:, drow[None, :, None], dcol[:, None, :]].astype(jnp.float32)
        qr = qg[:, :, r]
        kw = kg[:, :, rws][:, :, :, win_cols]
        vw = vg[:, :, rws][:, :, :, win_cols]
        s_loc = jnp.einsum('bhcd,bhicjd->bhcij', qr, kw).astype(jnp.float32) * scale + bias
        s_ctx = jnp.einsum('bhcd,bhnd->bhcn', qr, k_ctx).astype(jnp.float32) * scale
        logits = jnp.concatenate([s_loc.reshape(B, H, GRID_W, n_loc), s_ctx], axis=-1)
        p = jax.nn.softmax(logits, axis=-1).astype(v.dtype)
        p_loc = p[..., :n_loc].reshape(B, H, GRID_W, kh, NA_KW)
        return jnp.einsum('bhcij,bhicjd->bhcd', p_loc, vw) + jnp.einsum('bhcn,bhnd->bhcd', p[..., n_loc:], v_ctx)

    o = lax.map(one_row, r_idx)
    return jnp.moveaxis(o, 0, 2).reshape(B, H, S, d)


def mla_mlstm_mixer(u_lat, u_ctx, cos, sin, w_in, q_norm, w_uq, kv_norm, w_ukv, conv_w, conv_b, b_i, b_f, h_norm, w_out, need_ctx):
    def project(u, rotate):
        B, T, _ = u.shape
        cq, ckv, k_rope, mq, mk, mv, mo, gates, z = split_cols(u @ w_in, EVEN_SPLITS)
        q = to_heads(rmsnorm(cq, q_norm) @ w_uq, MLA_HEADS)
        kv = to_heads(rmsnorm(ckv, kv_norm) @ w_ukv, MLA_HEADS)
        q_nope, q_rope = q[..., :MLA_NOPE], q[..., MLA_NOPE:]
        k_nope, v = kv[..., :MLA_NOPE], kv[..., MLA_NOPE:]
        k_rope = k_rope[:, None]
        if rotate:
            q_rope = apply_rope2d(q_rope, cos, sin)
            k_rope = apply_rope2d(k_rope, cos, sin)
        q = jnp.concatenate([q_nope, q_rope], axis=-1)
        k = jnp.concatenate([k_nope, jnp.broadcast_to(k_rope, (B, MLA_HEADS, T, MLA_ROPE))], axis=-1)
        qk = jax.nn.silu(centred_dwconv(jnp.concatenate([mq, mk], axis=-1), conv_w, conv_b))
        mq = to_heads(qk[..., :BRANCH_B], MLSTM_HEADS) * MLSTM_DH ** -0.5
        mk = to_heads(qk[..., BRANCH_B:], MLSTM_HEADS)
        mv = to_heads(mv, MLSTM_HEADS)
        g = gates.reshape(B, T, 2, 2, MLSTM_HEADS).astype(jnp.float32)
        ig = (g[:, :, :, 0] + b_i).transpose(2, 0, 3, 1)
        lf = jax.nn.log_sigmoid(g[:, :, :, 1] + b_f).transpose(2, 0, 3, 1)
        return (q, k, v), (mq, mk, mv), (ig, lf), mo, z

    (qa_l, ka_l, va_l), seq_l, gates_l, mo_l, z_l = project(u_lat, True)
    (qa_c, ka_c, va_c), seq_c, gates_c, mo_c, z_c = project(u_ctx, False)
    scale = (MLA_NOPE + MLA_ROPE) ** -0.5
    a_lat = block_attention(qa_l, jnp.concatenate([ka_c, ka_l], axis=2), jnp.concatenate([va_c, va_l], axis=2), scale)
    B = u_lat.shape[0]
    init = (jnp.zeros((B, MLSTM_HEADS, MLSTM_DH, MLSTM_DH), jnp.float32),
            jnp.zeros((B, MLSTM_HEADS, MLSTM_DH), jnp.float32),
            jnp.zeros((B, MLSTM_HEADS), jnp.float32))
    h_c, h_l = bidirectional_scan(mlstm_chunked, init, seq_c, gates_c, seq_l, gates_l)

    def combine(a, h, mo, z, dtype):
        hm = head_rmsnorm(jax.nn.sigmoid(mo.astype(jnp.float32)) * merge_heads(h), h_norm, MLSTM_HEADS).astype(dtype)
        return (jnp.concatenate([merge_heads(a), hm], axis=-1) * jax.nn.silu(z)) @ w_out

    y_lat = combine(a_lat, h_l, mo_l, z_l, u_lat.dtype)
    y_ctx = None
    if need_ctx:
        y_ctx = combine(block_attention(qa_c, ka_c, va_c, scale), h_c, mo_c, z_c, u_ctx.dtype)
    return y_lat, y_ctx


def gla_na_mixer(u_lat, u_ctx, rows, w_in, w_gate, b_gate, gla_norm, rpb, w_out, need_ctx):
    def project(u):
        B, T, _ = u.shape
        gq, gk, gv, ga, nq, nk, nv, z = split_cols(u @ w_in, ODD_SPLITS)
        ga = ga.reshape(B, T, 2, GLA_GATE_RANK)
        lg = jax.nn.log_sigmoid(jnp.einsum('btdr,drk->dbtk', ga, w_gate).astype(jnp.float32) + b_gate[:, None, None]) / GLA_TAU
        lg = lg.reshape(2, B, T, GLA_HEADS, GLA_DK).transpose(0, 1, 3, 2, 4)
        seq = (to_heads(gq, GLA_HEADS) * GLA_DK ** -0.5, to_heads(gk, GLA_HEADS), to_heads(gv, GLA_HEADS))
        na = (to_heads(nq, NA_HEADS), to_heads(nk, NA_HEADS), to_heads(nv, NA_HEADS))
        return seq, (lg,), na, z

    seq_l, gates_l, (nq_l, nk_l, nv_l), z_l = project(u_lat)
    seq_c, gates_c, (nq_c, nk_c, nv_c), z_c = project(u_ctx)
    B = u_lat.shape[0]
    init = jnp.zeros((B, GLA_HEADS, GLA_DK, GLA_DV), jnp.float32)
    o_c, o_l = bidirectional_scan(gla_chunked, init, seq_c, gates_c, seq_l, gates_l)
    na_l = neighbourhood_attention(nq_l, nk_l, nv_l, nk_c, nv_c, rpb, rows)

    def combine(o, na, z, dtype):
        g = head_rmsnorm(merge_heads(o), gla_norm, GLA_HEADS).astype(dtype)
        return (jnp.concatenate([g, merge_heads(na)], axis=-1) * jax.nn.silu(z)) @ w_out

    y_lat = combine(o_l, na_l, z_l, u_lat.dtype)
    y_ctx = None
    if need_ctx:
        y_ctx = combine(o_c, block_attention(nq_c, nk_c, nv_c, NA_DH ** -0.5), z_c, u_ctx.dtype)
    return y_lat, y_ctx


def setup_inputs(seed: int = 0) -> dict:
    key = jax.random.key(seed)
    keys = iter(jax.random.split(key, 32))

    def rnd(shape, s):
        return jax.random.normal(next(keys), shape, jnp.float32) * s

    def gain(n):
        return 1.0 + rnd((n,), 0.05)

    D = D_MODEL
    return {
        'x': rnd((BATCH, SEQ, D), 1.0),
        'c': rnd((BATCH, D), 1.0),
        'ctx': rnd((BATCH, CTX_LEN, D), 1.0),
        'c_ctx': rnd((D,), 1.0),
        'l0_norm': gain(D),
        'l0_w_mod': rnd((D, 3 * D), 0.5 * D ** -0.5),
        'l0_b_mod': rnd((3 * D,), 0.02),
        'l0_w_in': rnd((D, EVEN_IN), D ** -0.5),
        'l0_mla_q_norm': gain(MLA_Q_RANK),
        'l0_mla_w_uq': rnd((MLA_Q_RANK, MLA_HEADS * (MLA_NOPE + MLA_ROPE)), MLA_Q_RANK ** -0.5),
        'l0_mla_kv_norm': gain(MLA_KV_RANK),
        'l0_mla_w_ukv': rnd((MLA_KV_RANK, MLA_HEADS * (MLA_NOPE + MLA_V)), MLA_KV_RANK ** -0.5),
        'l0_mlstm_conv_w': rnd((MLSTM_CONV, 2 * BRANCH_B), MLSTM_CONV ** -0.5),
        'l0_mlstm_conv_b': rnd((2 * BRANCH_B,), 0.02),
        'l0_mlstm_b_i': rnd((2, MLSTM_HEADS), 0.1),
        'l0_mlstm_b_f': jnp.linspace(3.0, 6.0, MLSTM_HEADS)[None] + rnd((2, MLSTM_HEADS), 0.1),
        'l0_mlstm_norm': gain(BRANCH_B),
        'l0_w_out': rnd((BRANCH_A + BRANCH_B, D), (BRANCH_A + BRANCH_B) ** -0.5),
        'l1_norm': gain(D),
        'l1_w_mod': rnd((D, 3 * D), 0.5 * D ** -0.5),
        'l1_b_mod': rnd((3 * D,), 0.02),
        'l1_w_in': rnd((D, ODD_IN), D ** -0.5),
        'l1_gla_w_gate': rnd((2, GLA_GATE_RANK, GLA_HEADS * GLA_DK), GLA_GATE_RANK ** -0.5),
        'l1_gla_b_gate': rnd((2, GLA_HEADS * GLA_DK), 0.5),
        'l1_gla_norm': gain(BRANCH_C),
        'l1_na_rpb': rnd((NA_HEADS, 2 * NA_KH - 1, 2 * NA_KW - 1), 0.1),
        'l1_w_out': rnd((BRANCH_C + BRANCH_D, D), (BRANCH_C + BRANCH_D) ** -0.5),
        'final_norm': gain(D),
    }


def reference(x, c, ctx, c_ctx,
              l0_norm, l0_w_mod, l0_b_mod, l0_w_in, l0_mla_q_norm, l0_mla_w_uq, l0_mla_kv_norm, l0_mla_w_ukv,
              l0_mlstm_conv_w, l0_mlstm_conv_b, l0_mlstm_b_i, l0_mlstm_b_f, l0_mlstm_norm, l0_w_out,
              l1_norm, l1_w_mod, l1_b_mod, l1_w_in, l1_gla_w_gate, l1_gla_b_gate, l1_gla_norm, l1_na_rpb, l1_w_out,
              final_norm):
    S = x.shape[1]
    rows = S // GRID_W
    cos, sin = rope2d_tables(S)
    norms = (l0_norm, l1_norm)
    mods = ((l0_w_mod, l0_b_mod), (l1_w_mod, l1_b_mod))
    mixer_params = (
        (l0_w_in, l0_mla_q_norm, l0_mla_w_uq, l0_mla_kv_norm, l0_mla_w_ukv, l0_mlstm_conv_w, l0_mlstm_conv_b,
         l0_mlstm_b_i, l0_mlstm_b_f, l0_mlstm_norm, l0_w_out),
        (l1_w_in, l1_gla_w_gate, l1_gla_b_gate, l1_gla_norm, l1_na_rpb, l1_w_out),
    )
    h_lat, h_ctx = x, ctx
    for layer in range(DEPTH):
        need_ctx = layer < DEPTH - 1
        w_mod, b_mod = mods[layer]
        shift_l, scale_l, gate_l = jnp.split(jax.nn.silu(c) @ w_mod + b_mod, 3, axis=-1)
        shift_c, scale_c, gate_c = jnp.split(jax.nn.silu(c_ctx) @ w_mod + b_mod, 3, axis=-1)
        u_lat = rmsnorm(h_lat, norms[layer]) * (1 + scale_l[:, None]) + shift_l[:, None]
        u_ctx = rmsnorm(h_ctx, norms[layer]) * (1 + scale_c) + shift_c
        if layer % 2 == 0:
            y_lat, y_ctx = mla_mlstm_mixer(u_lat, u_ctx, cos, sin, *mixer_params[layer], need_ctx=need_ctx)
        else:
            y_lat, y_ctx = gla_na_mixer(u_lat, u_ctx, rows, *mixer_params[layer], need_ctx=need_ctx)
        h_lat = h_lat + gate_l[:, None] * y_lat
        if need_ctx:
            h_ctx = h_ctx + gate_c * y_ctx
    return rmsnorm(h_lat, final_norm)
```

```cpp
#ifndef HOST_TEST
#include <hip/hip_runtime.h>
#include <hip/hip_cooperative_groups.h>
#include <cstdio>
#include <cstdint>
namespace cg = cooperative_groups;
#endif

#if defined(SMALL_CFG)
constexpr int DM = 128, NB = 2, SEQ = 256, GW = 16, CTX = 64, MLA_H = 2, QR = 48, KVR = 32, ML_H = 2, GLA_H = 2, NA_H = 2;
#elif defined(MED_CFG)
constexpr int DM = 256, NB = 1, SEQ = 1024, GW = 64, CTX = 256, MLA_H = 8, QR = 384, KVR = 256, ML_H = 4, GLA_H = 4, NA_H = 8;
#else
constexpr int DM = 1024, NB = 8, SEQ = 4096, GW = 64, CTX = 256, MLA_H = 8, QR = 384, KVR = 256, ML_H = 4, GLA_H = 4, NA_H = 8;
#endif
constexpr int NOPE = 64, ROPE = 32, VD = 64, QD = 96, ML_D = 128, GLA_DK = 64, GLA_DV = 128, GRANK = 16, NA_D = 64, NA_KH = 8, NA_KW = 16;
constexpr float EPS = 1e-6f;
constexpr int BRA = MLA_H * VD, BRB = ML_H * ML_D, BRC = GLA_H * GLA_DV, BRD = NA_H * NA_D;
constexpr int TB = CTX + SEQ, M = NB * TB, MLAT = NB * SEQ, NV = NB + 1, GROWS = SEQ / GW;
constexpr int QW = MLA_H * QD, KVW = MLA_H * (NOPE + VD);
constexpr int S0_CQ = 0, S0_CKV = QR, S0_KR = QR + KVR, S0_MQ = S0_KR + ROPE, S0_MK = S0_MQ + BRB, S0_MV = S0_MK + BRB, S0_MO = S0_MV + BRB,
              S0_G = S0_MO + BRB, S0_Z = S0_G + 4 * ML_H, N0 = S0_Z + BRA + BRB;
constexpr int P0_CQ = 0, P0_CKV = QR, P0_MQ = QR + KVR, P0_MK = P0_MQ + BRB, P0_MV = P0_MK + BRB, P0_MO = P0_MV + BRB, P0_Z = P0_MO + BRB,
              P0_KR = P0_Z + BRA + BRB, P0_G = P0_KR + ROPE;
static_assert(P0_G + 4 * ML_H == N0, "layer-0 column map");
constexpr int S1_GQ = 0, S1_GK = GLA_H * GLA_DK, S1_GV = 2 * GLA_H * GLA_DK, S1_GA = S1_GV + BRC, S1_NQ = S1_GA + 2 * GRANK, S1_NK = S1_NQ + BRD,
              S1_NV = S1_NK + BRD, S1_Z = S1_NV + BRD, N1 = S1_Z + BRC + BRD;
constexpr int P1_GQ = 0, P1_GK = S1_GK, P1_GV = S1_GV, P1_NQ = S1_GA, P1_NK = P1_NQ + BRD, P1_NV = P1_NK + BRD, P1_Z = P1_NV + BRD, P1_GA = P1_Z + BRC + BRD;
static_assert(P1_GA + 2 * GRANK == N1, "layer-1 column map");
constexpr int NMAX = N0 > N1 ? N0 : N1;
constexpr int LDP = (NMAX + 255) / 256 * 256;
constexpr float LOG2E = 1.4426950408889634f;
constexpr float C2Q = 0.10206207261596575f * LOG2E;
constexpr int NTHREADS = 512;
constexpr int RPOS = GW > GROWS ? GW : GROWS;
constexpr int CW0 = BRA + BRB, CW1 = BRC + BRD;
constexpr int LDA = (DM > CW0 ? (DM > CW1 ? DM : CW1) : (CW0 > CW1 ? CW0 : CW1));

__device__ __forceinline__ int l0_src(int j) {
  if (j < P0_MQ) return j;
  if (j < P0_Z) return S0_MQ + (j - P0_MQ);
  if (j < P0_KR) return S0_Z + (j - P0_Z);
  if (j < P0_G) return S0_KR + (j - P0_KR);
  if (j < N0) return S0_G + (j - P0_G);
  return -1;
}
__device__ __forceinline__ int l1_src(int j) {
  if (j < P1_NQ) return j;
  if (j < P1_Z) return S1_NQ + (j - P1_NQ);
  if (j < P1_GA) return S1_Z + (j - P1_Z);
  if (j < N1) return S1_GA + (j - P1_GA);
  return -1;
}

typedef unsigned short bf16_t;
#ifdef HOST_TEST
static inline float fast_exp(float x) { return expf(x); }
static inline float fast_log(float x) { return logf(x); }
#else
__device__ __forceinline__ float fast_exp(float x) { return __expf(x); }
__device__ __forceinline__ float fast_log(float x) { return __logf(x); }
#endif
__device__ __forceinline__ float bf2f(bf16_t h) { unsigned u = (unsigned)h << 16; float f; __builtin_memcpy(&f, &u, 4); return f; }
__device__ __forceinline__ bf16_t f2bf(float f) { unsigned u; __builtin_memcpy(&u, &f, 4); return (bf16_t)((u + 0x7fffu + ((u >> 16) & 1u)) >> 16); }
__device__ __forceinline__ float silu_f(float x) { return x / (1.f + fast_exp(-x)); }
__device__ __forceinline__ float sigmoid_f(float x) { return 1.f / (1.f + fast_exp(-x)); }
__device__ __forceinline__ float log_sigmoid_f(float x) { return fminf(x, 0.f) - log1pf(fast_exp(-fabsf(x))); }

struct Params {
  const float *x, *c, *ctx, *c_ctx;
  const float *l0_norm, *l0_w_mod, *l0_b_mod, *l0_w_in, *q_norm, *w_uq, *kv_norm, *w_ukv, *conv_w, *conv_b, *b_i, *b_f, *h_norm, *l0_w_out;
  const float *l1_norm, *l1_w_mod, *l1_b_mod, *l1_w_in, *w_gate, *b_gate, *gla_norm, *rpb, *l1_w_out, *final_norm;
  float* out;
  float *modv;
  float *sw;
  float *ssq0, *ssq1;
  float *ssq_q, *ssq_kv;
  float *ssq2;
  float *gm1;
  float *ropet;
  float *scanst;
  bf16_t *Wt0, *Wt1, *Wo0, *Wo1, *Wq, *Wkv;
  bf16_t *A0;
  bf16_t *A1;
  bf16_t *mqc, *mkc;
  bf16_t *Pb;
  bf16_t *qb, *kn, *vb;
  bf16_t *Hf, *Hb;
  int ph_lo, ph_hi;
};

__device__ __forceinline__ long gtid() { return (long)blockIdx.x * blockDim.x + threadIdx.x; }
__device__ __forceinline__ long gsize() { return (long)gridDim.x * blockDim.x; }

__device__ __forceinline__ size_t hoff(int c, size_t row, size_t NR) { return ((size_t)(c >> 5) * NR + row) * 32 + (c & 31); }
__device__ __forceinline__ int row_variant(int m) { const int b = m / TB, t = m % TB; return t < CTX ? NB : b; }
__device__ __forceinline__ const float* row_input(const Params& p, int m) {
  const int b = m / TB, t = m % TB;
  return t < CTX ? p.ctx + ((size_t)b * CTX + t) * DM : p.x + ((size_t)b * SEQ + (t - CTX)) * DM;
}
__device__ __forceinline__ float rope_inv(int i) { return exp2f(-(float)i * (13.287712379549449f / 8.f)); }

__device__ __forceinline__ void nv_mod_l(const Params& p, const int l, const float* __restrict__ w, const float* __restrict__ b) {
  for (long idx = gtid(); idx < (long)NV * 3 * DM; idx += gsize()) {
    const int v = (int)(idx / (3 * DM)), j = (int)(idx % (3 * DM));
    const float* cv = p.c + (size_t)(v < NB ? v : 0) * DM;
    float acc = b[j];
    for (int k = 0; k < DM; ++k) { const float cc = v < NB ? cv[k] : p.c_ctx[k]; acc += silu_f(cc) * w[(size_t)k * 3 * DM + j]; }
    p.modv[(size_t)l * NV * 3 * DM + idx] = acc;
  }
}
__device__ __forceinline__ void nv_mod(const Params& p) {
  nv_mod_l(p, 0, p.l0_w_mod, p.l0_b_mod);
  nv_mod_l(p, 1, p.l1_w_mod, p.l1_b_mod);
  for (long i = gtid(); i < M; i += gsize()) { p.ssq_q[i] = 0.f; p.ssq_kv[i] = 0.f; p.ssq1[i] = 0.f; p.ssq0[i] = 0.f; if (i < MLAT) p.ssq2[i] = 0.f; }
}
__device__ __forceinline__ void nv_prep0(const Params& p) {
  for (long m = gtid(); m < M; m += gsize()) {
    const float* xr = row_input(p, (int)m); const int v = row_variant((int)m);
    const float* sc = p.modv + ((size_t)0 * NV + v) * 3 * DM + DM;
    float ss = 0.f;
    for (int k = 0; k < DM; ++k) { const float xv = xr[k]; ss += xv * xv; p.A0[(size_t)m * LDA + k] = f2bf(xv * p.l0_norm[k] * (1.f + sc[k])); }
    p.ssq0[m] = ss;
  }
}
template <int L> __device__ __forceinline__ void nv_sw_l(const Params& p, const float* __restrict__ w) {
  constexpr int NO = L ? N1 : N0;
  for (long idx = gtid(); idx < (long)NV * LDP; idx += gsize()) {
    const int v = (int)(idx / LDP), j = (int)(idx % LDP);
    const int src = L ? l1_src(j) : l0_src(j);
    const float* sh = p.modv + ((size_t)L * NV + v) * 3 * DM;
    float acc = 0.f;
    if (src >= 0) for (int k = 0; k < DM; ++k) acc += sh[k] * w[(size_t)k * NO + src];
    p.sw[(size_t)L * NV * LDP + idx] = acc;
  }
}
__device__ __forceinline__ void nv_sw(const Params& p) { nv_sw_l<0>(p, p.l0_w_in); nv_sw_l<1>(p, p.l1_w_in); }
template <int l> __device__ __forceinline__ void nv_gemm_in(const Params& p) {
  constexpr int NO = l ? N1 : N0; const float* __restrict__ w = l ? p.l1_w_in : p.l0_w_in; const bf16_t* __restrict__ A = l ? p.A1 : p.A0; const float* __restrict__ ssq = l ? p.ssq1 : p.ssq0;
  for (long idx = gtid(); idx < (long)(M / 4) * NO; idx += gsize()) {
    const int j = (int)(idx % NO), mg = (int)(idx / NO);
    const int src = l ? l1_src(j) : l0_src(j);
    const bool rope = (l == 0) && j >= P0_KR && j < P0_KR + ROPE && ((mg * 4) % TB) >= CTX;
    int jj = 0, src2 = src; if (rope) { jj = j - P0_KR; src2 = ((jj & 15) < 8) ? src + 8 : src - 8; }
    float acc[4] = {0.f, 0.f, 0.f, 0.f}, acc2[4] = {0.f, 0.f, 0.f, 0.f};
    for (int k = 0; k < DM; ++k) {
      const float wv = w[(size_t)k * NO + src], wv2 = w[(size_t)k * NO + src2];
#pragma unroll
      for (int r = 0; r < 4; ++r) { const float a = bf2f(A[(size_t)(mg * 4 + r) * LDA + k]); acc[r] += a * wv; acc2[r] += a * wv2; }
    }
#pragma unroll
    for (int r = 0; r < 4; ++r) {
      const int m = mg * 4 + r, v = row_variant(m);
      const float rstd = rsqrtf(ssq[m] * (1.f / DM) + EPS);
      const float* swv = p.sw + ((size_t)l * NV + v) * LDP;
      float val = rstd * acc[r] + swv[j];
      if (rope) {
        const int j2 = ((jj & 15) < 8) ? j + 8 : j - 8;
        const float val2 = rstd * acc2[r] + swv[j2];
        const int tl = (m % TB) - CTX, pos = (jj < 16) ? tl / GW : tl % GW;
        const float ang = (float)pos * rope_inv(jj & 7); const float cs = cosf(ang), sn = sinf(ang);
        val = ((jj & 15) < 8) ? val * cs - val2 * sn : val * cs + val2 * sn;
      }
      p.Pb[(size_t)m * LDP + j] = f2bf(val);
      if (l == 0 && j < QR) atomicAdd(&p.ssq_q[m], val * val); else if (l == 0 && j < QR + KVR) atomicAdd(&p.ssq_kv[m], val * val);
    }
  }
}
__device__ __forceinline__ void nv_uq(const Params& p) {
  for (long idx = gtid(); idx < (long)M * QW; idx += gsize()) {
    const int j = (int)(idx % QW), m = (int)(idx / QW);
    const int jh = j % QD; const bool rope = jh >= NOPE && (m % TB) >= CTX;
    const int jj = jh - NOPE; const int j2 = rope ? (((jj & 15) < 8) ? j + 8 : j - 8) : j;
    float acc = 0.f, acc2 = 0.f;
    for (int k = 0; k < QR; ++k) { const float a = bf2f(p.Pb[(size_t)m * LDP + P0_CQ + k]) * p.q_norm[k]; acc += a * p.w_uq[(size_t)k * QW + j]; acc2 += a * p.w_uq[(size_t)k * QW + j2]; }
    const float rstd = rsqrtf(p.ssq_q[m] * (1.f / QR) + EPS);
    float val = acc * rstd;
    if (rope) {
      const float val2 = acc2 * rstd; const int tl = (m % TB) - CTX, pos = (jj < 16) ? tl / GW : tl % GW;
      const float ang = (float)pos * rope_inv(jj & 7); const float cs = cosf(ang), sn = sinf(ang);
      val = ((jj & 15) < 8) ? val * cs - val2 * sn : val * cs + val2 * sn;
    }
    p.qb[(size_t)m * QW + j] = f2bf(val * C2Q);
  }
}
__device__ __forceinline__ void nv_ukv(const Params& p) {
  for (long idx = gtid(); idx < (long)M * KVW; idx += gsize()) {
    const int j = (int)(idx % KVW), m = (int)(idx / KVW);
    float acc = 0.f;
    for (int k = 0; k < KVR; ++k) acc += bf2f(p.Pb[(size_t)m * LDP + P0_CKV + k]) * p.kv_norm[k] * p.w_ukv[(size_t)k * KVW + j];
    const float val = acc * rsqrtf(p.ssq_kv[m] * (1.f / KVR) + EPS);
    const int hh = j / (NOPE + VD), jj = j % (NOPE + VD);
    if (jj < NOPE) p.kn[(size_t)m * BRA + hh * NOPE + jj] = f2bf(val); else p.vb[(size_t)m * BRA + hh * VD + (jj - NOPE)] = f2bf(val);
  }
}
__device__ __forceinline__ void nv_conv(const Params& p) {
  for (long idx = gtid(); idx < (long)M * 2 * BRB; idx += gsize()) {
    const int j = (int)(idx % (2 * BRB)), m = (int)(idx / (2 * BRB)); const int t = m % TB;
    const int lo = t < CTX ? 0 : CTX, hi = t < CTX ? CTX : TB;
    float y = p.conv_b[j];
#pragma unroll
    for (int tap = 0; tap < 3; ++tap) { const int tt = t + tap - 1; if (tt >= lo && tt < hi) y += bf2f(p.Pb[(size_t)(m + tap - 1) * LDP + P0_MQ + j]) * p.conv_w[tap * 2 * BRB + j]; }
    y = silu_f(y);
    if (j < BRB) p.mqc[(size_t)m * BRB + j] = f2bf(y * 0.08838834764831845f); else p.mkc[(size_t)m * BRB + (j - BRB)] = f2bf(y);
  }
}
__device__ __forceinline__ void nv_attn_mla(const Params& p) {
  for (long idx = gtid(); idx < (long)NB * MLA_H * TB; idx += gsize()) {
    const int t = (int)(idx % TB), h = (int)((idx / TB) % MLA_H), b = (int)(idx / ((long)TB * MLA_H));
    const int m = b * TB + t; const int nkeys = t < CTX ? CTX : TB;
    float q[QD], o[VD];
#pragma unroll
    for (int d = 0; d < QD; ++d) q[d] = bf2f(p.qb[(size_t)m * QW + h * QD + d]);
#pragma unroll
    for (int d = 0; d < VD; ++d) o[d] = 0.f;
    float mx = -1e30f, l = 0.f;
    for (int key = 0; key < nkeys; ++key) {
      const size_t kk = (size_t)b * TB + key; float s = 0.f;
#pragma unroll
      for (int d = 0; d < NOPE; ++d) s += q[d] * bf2f(p.kn[kk * BRA + h * NOPE + d]);
#pragma unroll
      for (int d = 0; d < ROPE; ++d) s += q[NOPE + d] * bf2f(p.Pb[kk * LDP + P0_KR + d]);
      const float mn = fmaxf(mx, s), alpha = exp2f(mx - mn), pp = exp2f(s - mn);
      l = l * alpha + pp; mx = mn;
#pragma unroll
      for (int d = 0; d < VD; ++d) o[d] = o[d] * alpha + pp * bf2f(p.vb[kk * BRA + h * VD + d]);
    }
    const float il = 1.f / l;
#pragma unroll
    for (int d = 0; d < VD; ++d) p.A0[(size_t)m * LDA + h * VD + d] = f2bf(o[d] * il * silu_f(bf2f(p.Pb[(size_t)m * LDP + P0_Z + h * VD + d])));
  }
}
__device__ __forceinline__ int seq_token(int s, int dir) {
  if (dir == 0) return s;
  return s < CTX ? CTX - 1 - s : TB - 1 - (s - CTX);
}
__device__ __forceinline__ void nv_mlstm(const Params& p) {
  __shared__ float qs[ML_D], ks[ML_D], red[ML_D];
  const int j = threadIdx.x;
  for (int item = blockIdx.x; item < NB * ML_H * 2; item += gridDim.x) {
    const int dir = item & 1, h = (item >> 1) % ML_H, b = item / (2 * ML_H);
    float C[ML_D]; float nj = 0.f, mst = 0.f;
#pragma unroll
    for (int d = 0; d < ML_D; ++d) C[d] = 0.f;
    bf16_t* Hout = dir ? p.Hb : p.Hf;
    for (int s = 0; s < TB; ++s) {
      const int t = seq_token(s, dir); const size_t m = (size_t)b * TB + t;
      const float ig = bf2f(p.Pb[m * LDP + P0_G + dir * 2 * ML_H + h]) + p.b_i[dir * ML_H + h];
      const float lf = log_sigmoid_f(bf2f(p.Pb[m * LDP + P0_G + dir * 2 * ML_H + ML_H + h]) + p.b_f[dir * ML_H + h]);
      const float mn = fmaxf(lf + mst, ig), decay = fast_exp(lf + mst - mn), iw = fast_exp(ig - mn); mst = mn;
      float vj = 0.f;
      if (j < ML_D) { qs[j] = bf2f(p.mqc[m * BRB + h * ML_D + j]); ks[j] = bf2f(p.mkc[m * BRB + h * ML_D + j]); vj = bf2f(p.Pb[m * LDP + P0_MV + h * ML_D + j]); }
      __syncthreads();
      float num = 0.f;
      if (j < ML_D) {
#pragma unroll
        for (int d = 0; d < ML_D; ++d) { C[d] = decay * C[d] + iw * ks[d] * vj; num += qs[d] * C[d]; }
        nj = decay * nj + iw * ks[j]; red[j] = qs[j] * nj;
      }
      __syncthreads();
      if (j < ML_D) {
        float den = 0.f;
        for (int d = 0; d < ML_D; ++d) den += red[d];
        Hout[hoff(h * ML_D + j, m, M)] = f2bf(num / fmaxf(fabsf(den), fast_exp(-mst)));
      }
      __syncthreads();
    }
  }
}
__device__ __forceinline__ void nv_comb0(const Params& p) {
  for (long idx = gtid(); idx < (long)M * ML_H; idx += gsize()) {
    const int hh = (int)(idx % ML_H); const size_t m = (size_t)(idx / ML_H);
    float ss = 0.f;
    for (int d = 0; d < ML_D; ++d) { const int c = hh * ML_D + d;
      const float g = sigmoid_f(bf2f(p.Pb[m * LDP + P0_MO + c])) * (bf2f(p.Hf[hoff(c, m, M)]) + bf2f(p.Hb[hoff(c, m, M)])); ss += g * g; }
    const float rstd = rsqrtf(ss * (1.f / ML_D) + EPS);
    for (int d = 0; d < ML_D; ++d) { const int c = hh * ML_D + d;
      const float g = sigmoid_f(bf2f(p.Pb[m * LDP + P0_MO + c])) * (bf2f(p.Hf[hoff(c, m, M)]) + bf2f(p.Hb[hoff(c, m, M)]));
      p.A0[m * LDA + BRA + c] = f2bf(g * rstd * p.h_norm[c] * silu_f(bf2f(p.Pb[m * LDP + P0_Z + BRA + c]))); }
  }
}
__device__ __forceinline__ void nv_out0(const Params& p) {
  for (long idx = gtid(); idx < (long)(M / 4) * DM; idx += gsize()) {
    const int j = (int)(idx % DM), mg = (int)(idx / DM);
    float acc[4] = {0.f, 0.f, 0.f, 0.f};
    for (int k = 0; k < BRA + BRB; ++k) { const float wv = p.l0_w_out[(size_t)k * DM + j];
#pragma unroll
      for (int r = 0; r < 4; ++r) acc[r] += bf2f(p.A0[(size_t)(mg * 4 + r) * LDA + k]) * wv; }
#pragma unroll
    for (int r = 0; r < 4; ++r) {
      const int m = mg * 4 + r, v = row_variant(m), b = m / TB, t = m % TB;
      const float gate = p.modv[((size_t)0 * NV + v) * 3 * DM + 2 * DM + j];
      const float h1 = row_input(p, m)[j] + gate * acc[r];
      if (t >= CTX) p.out[((size_t)b * SEQ + (t - CTX)) * DM + j] = h1;
      atomicAdd(&p.ssq1[m], h1 * h1);
      p.A1[(size_t)m * LDA + j] = f2bf(h1 * p.l1_norm[j] * (1.f + p.modv[((size_t)1 * NV + v) * 3 * DM + DM + j]));
    }
  }
}
__device__ __forceinline__ void nv_gla(const Params& p) {
  __shared__ float qs[GLA_DK], ks[GLA_DK], al[GLA_DK];
  const int j = threadIdx.x;
  for (int item = blockIdx.x; item < NB * GLA_H * 2; item += gridDim.x) {
    const int dir = item & 1, h = (item >> 1) % GLA_H, b = item / (2 * GLA_H);
    float S[GLA_DK];
#pragma unroll
    for (int d = 0; d < GLA_DK; ++d) S[d] = 0.f;
    bf16_t* Oout = dir ? p.Hb : p.Hf;
    for (int s = 0; s < TB; ++s) {
      const int t = seq_token(s, dir); const size_t m = (size_t)b * TB + t;
      if (j < GLA_DK) {
        float g = p.b_gate[dir * GLA_H * GLA_DK + h * GLA_DK + j];
        for (int r = 0; r < GRANK; ++r) g += bf2f(p.Pb[m * LDP + P1_GA + dir * GRANK + r]) * p.w_gate[((size_t)dir * GRANK + r) * GLA_H * GLA_DK + h * GLA_DK + j];
        al[j] = fast_exp(log_sigmoid_f(g) * (1.f / 16.f));
        qs[j] = bf2f(p.Pb[m * LDP + P1_GQ + h * GLA_DK + j]) * 0.125f; ks[j] = bf2f(p.Pb[m * LDP + P1_GK + h * GLA_DK + j]);
      }
      float vj = 0.f; if (j < GLA_DV) vj = bf2f(p.Pb[m * LDP + P1_GV + h * GLA_DV + j]);
      __syncthreads();
      if (j < GLA_DV) {
        float o = 0.f;
#pragma unroll
        for (int d = 0; d < GLA_DK; ++d) { S[d] = al[d] * S[d] + ks[d] * vj; o += qs[d] * S[d]; }
        if (t >= CTX) Oout[hoff(h * GLA_DV + j, (size_t)b * SEQ + (t - CTX), MLAT)] = f2bf(o);
      }
      __syncthreads();
    }
  }
}
__device__ __forceinline__ void nv_na(const Params& p) {
  for (long idx = gtid(); idx < (long)NB * NA_H * SEQ; idx += gsize()) {
    const int tl = (int)(idx % SEQ), h = (int)((idx / SEQ) % NA_H), b = (int)(idx / ((long)SEQ * NA_H));
    const int r = tl / GW, c = tl % GW; const size_t m = (size_t)b * TB + CTX + tl;
    int rs = r - NA_KH / 2; rs = rs < 0 ? 0 : (rs > GROWS - NA_KH ? GROWS - NA_KH : rs);
    int cs = c - NA_KW / 2; cs = cs < 0 ? 0 : (cs > GW - NA_KW ? GW - NA_KW : cs);
    float q[NA_D], o[NA_D];
#pragma unroll
    for (int d = 0; d < NA_D; ++d) { q[d] = bf2f(p.Pb[m * LDP + P1_NQ + h * NA_D + d]) * 0.125f; o[d] = 0.f; }
    float mx = -1e30f, l = 0.f;
    for (int key = 0; key < NA_KH * NA_KW + CTX; ++key) {
      size_t kk; float bias = 0.f;
      if (key < NA_KH * NA_KW) { const int i = key / NA_KW, jc = key % NA_KW; kk = (size_t)b * TB + CTX + (rs + i) * GW + cs + jc;
        bias = p.rpb[((size_t)h * (2 * NA_KH - 1) + (rs + i - r + NA_KH - 1)) * (2 * NA_KW - 1) + (cs + jc - c + NA_KW - 1)]; }
      else kk = (size_t)b * TB + (key - NA_KH * NA_KW);
      float s = 0.f;
#pragma unroll
      for (int d = 0; d < NA_D; ++d) s += q[d] * bf2f(p.Pb[kk * LDP + P1_NK + h * NA_D + d]);
      s += bias;
      const float mn = fmaxf(mx, s), alpha = fast_exp(mx - mn), pp = fast_exp(s - mn);
      l = l * alpha + pp; mx = mn;
#pragma unroll
      for (int d = 0; d < NA_D; ++d) o[d] = o[d] * alpha + pp * bf2f(p.Pb[kk * LDP + P1_NV + h * NA_D + d]);
    }
    const float il = 1.f / l; const size_t ml = (size_t)b * SEQ + tl;
#pragma unroll
    for (int d = 0; d < NA_D; ++d) p.A0[ml * LDA + BRC + h * NA_D + d] = f2bf(o[d] * il * silu_f(bf2f(p.Pb[m * LDP + P1_Z + BRC + h * NA_D + d])));
  }
}
__device__ __forceinline__ void nv_comb1(const Params& p) {
  for (long idx = gtid(); idx < (long)MLAT * GLA_H; idx += gsize()) {
    const int hh = (int)(idx % GLA_H); const size_t ml = (size_t)(idx / GLA_H); const size_t m = (ml / SEQ) * TB + CTX + (ml % SEQ);
    float ss = 0.f;
    for (int d = 0; d < GLA_DV; ++d) { const int c = hh * GLA_DV + d; const float g = bf2f(p.Hf[hoff(c, ml, MLAT)]) + bf2f(p.Hb[hoff(c, ml, MLAT)]); ss += g * g; }
    const float rstd = rsqrtf(ss * (1.f / GLA_DV) + EPS);
    for (int d = 0; d < GLA_DV; ++d) { const int c = hh * GLA_DV + d; const float g = bf2f(p.Hf[hoff(c, ml, MLAT)]) + bf2f(p.Hb[hoff(c, ml, MLAT)]);
      p.A0[ml * LDA + c] = f2bf(g * rstd * p.gla_norm[c] * silu_f(bf2f(p.Pb[m * LDP + P1_Z + c]))); }
  }
}
__device__ __forceinline__ void nv_out1(const Params& p) {
  for (long idx = gtid(); idx < (long)(MLAT / 4) * DM; idx += gsize()) {
    const int j = (int)(idx % DM), mg = (int)(idx / DM);
    float acc[4] = {0.f, 0.f, 0.f, 0.f};
    for (int k = 0; k < BRC + BRD; ++k) { const float wv = p.l1_w_out[(size_t)k * DM + j];
#pragma unroll
      for (int r = 0; r < 4; ++r) acc[r] += bf2f(p.A0[(size_t)(mg * 4 + r) * LDA + k]) * wv; }
#pragma unroll
    for (int r = 0; r < 4; ++r) { const size_t ml = (size_t)mg * 4 + r; const int b = (int)(ml / SEQ);
      p.out[ml * DM + j] += p.modv[((size_t)1 * NV + b) * 3 * DM + 2 * DM + j] * acc[r]; }
  }
}
__device__ __forceinline__ void nv_final(const Params& p) {
  for (long ml = gtid(); ml < MLAT; ml += gsize()) {
    float* r = p.out + (size_t)ml * DM; float ss = 0.f;
    for (int k = 0; k < DM; ++k) ss += r[k] * r[k];
    const float rstd = rsqrtf(ss * (1.f / DM) + EPS);
    for (int k = 0; k < DM; ++k) r[k] = r[k] * rstd * p.final_norm[k];
  }
}


#ifdef HOST_TEST
#define UNIFORM(x) (x)
#define WAVE_LDS_SYNC() wave_barrier()
static int g_fastmask = 0;
#define USE_FAST(k) ((g_fastmask >> (k)) & 1)
#else
#define UNIFORM(x) __builtin_amdgcn_readfirstlane(x)
#define WAVE_LDS_SYNC() asm volatile("s_waitcnt lgkmcnt(0)" ::: "memory")
#ifndef FASTMASK
#define FASTMASK 0x7FFF
#endif
#define USE_FAST(k) ((FASTMASK >> (k)) & 1)
#endif

#ifndef HOST_TEST
namespace pg8 {
#define PG8_LAS __attribute__((address_space(3)))
typedef unsigned short bf16_t;
typedef short bf16x8 __attribute__((ext_vector_type(8)));
typedef float f32x4 __attribute__((ext_vector_type(4)));
typedef unsigned u32x4 __attribute__((ext_vector_type(4)));
constexpr int BM = 256, BK = 64, HALF = 128, HTB = HALF * BK * 2  , STAGE_BYTES = 8 * HTB, NXCD = 8, WGM = 8;

__host__ __device__ __forceinline__ int lds_byte(int r, int c) { const int st = (r >> 4) * 2 + (c >> 5), rr = r & 15, cc = c & 31, ob = rr * 64 + cc * 2; return st * 1024 + (ob ^ (((ob >> 9) & 1) << 5)); }
__host__ __device__ __forceinline__ void stage_rc(int b, int& R, int& C) { const int st = b / 1024, sb = b % 1024, swz = sb ^ (((sb >> 9) & 1) << 5); R = (st >> 1) * 16 + swz / 64; C = (st & 1) * 32 + (swz % 64) / 2; }
__host__ __device__ __forceinline__ int perm32(int rho) { const int n = rho >> 4, i = rho & 15; return 8 * (i >> 2) + 4 * n + (i & 3); }

struct Unit { int pm, pn; };
struct Gemm { const bf16_t* A; const bf16_t* Bt; int M, N, K, lda, ldb; };

struct StaticOrder {
    int nM, nN, nwg, G, c;
    __host__ __device__ void init(int M, int N, int G_, int c_) { nM = M / BM; nN = N / BM; nwg = nM * nN; G = G_; c = c_; }
    __host__ __device__ bool next(int i, Unit& u) const {
        const long L = (long)i * G + c; if (L >= nwg) return false;
        int wgid = (int)L; { const int q = nwg / NXCD, r = nwg % NXCD, xcd = wgid % NXCD, off = wgid / NXCD; wgid = (xcd < r ? xcd * (q + 1) : r * (q + 1) + (xcd - r) * q) + off; }
        const int nig = WGM * nN, gid = wgid / nig, fm = gid * WGM, gsz = (nM - fm) < WGM ? (nM - fm) : WGM;
        u.pm = fm + ((wgid % nig) % gsz); u.pn = (wgid % nig) / gsz; return true;
    }
    __device__ __forceinline__ void a_ready(const Unit&) const {}
    __device__ __forceinline__ void done(const Unit&) const {}
};
__device__ __forceinline__ unsigned cvt_pk_bf16(float lo, float hi) { unsigned r; asm volatile("v_cvt_pk_bf16_f32 %0, %1, %2" : "=v"(r) : "v"(lo), "v"(hi)); return r; }
template <class Epi, class Sched, bool ALIGN_EPI = false, bool SP2 = false>
__device__ __forceinline__ void gemm_phase(PG8_LAS unsigned char* lds, const Gemm g, const Sched& S, const Epi& E) {
    const int tid = threadIdx.x, wid = __builtin_amdgcn_readfirstlane(tid >> 6), lane = tid & 63, wr = wid >> 2, wc = wid & 3, fr = lane & 15, fq = lane >> 4;
    const int K = g.K, nt = K / BK;
    unsigned voffA[2], voffB[2];
#pragma unroll
    for (int i = 0; i < 2; ++i) { int R, C; stage_rc(tid * 16 + i * 8192, R, C); const int Rb = Epi::PERM ? ((R & ~31) + perm32(R & 31)) : R;
        voffA[i] = (unsigned)(R * g.lda + C) * 2u; voffB[i] = (unsigned)(Rb * g.ldb + C) * 2u; }
    const size_t kstep = (size_t)(BK * 2);
    const size_t hstepA = (size_t)HALF * g.lda * 2, hstepB = (size_t)HALF * g.ldb * 2;
    const size_t tstepA = 2 * hstepA, tstepB = 2 * hstepB;
    const unsigned ldsw = (unsigned)wid * 1024u;
    const int aoff = lds_byte(wr * 64 + fr, fq * 8), boff = lds_byte(wc * 32 + fr, fq * 8);
#define PG8_SA(b, h) (((b) * 2 + (h)) * HTB)
#define PG8_SB(b, h) ((4 + (b) * 2 + (h)) * HTB)
#define PG8_STAGE(bufoff, gbase, voff) do { _Pragma("unroll") for (int _i = 0; _i < 2; ++_i) \
        __builtin_amdgcn_global_load_lds((const unsigned*)((const char*)(gbase) + (voff)[_i]), (PG8_LAS unsigned*)(lds + (bufoff) + ldsw + _i * 8192), 16, 0, 0); } while (0)
#define PG8_LDA(dst, b, h) do { _Pragma("unroll") for (int m = 0; m < 4; ++m) _Pragma("unroll") for (int k = 0; k < 2; ++k) dst[m][k] = *(const PG8_LAS bf16x8*)(lds + PG8_SA(b, h) + aoff + m * 2048 + k * 1024); } while (0)
#define PG8_LDB(dst, b, h) do { _Pragma("unroll") for (int n = 0; n < 2; ++n) _Pragma("unroll") for (int k = 0; k < 2; ++k) dst[n][k] = *(const PG8_LAS bf16x8*)(lds + PG8_SB(b, h) + boff + n * 2048 + k * 1024); } while (0)
#define PG8_MMA(ai, bj, At, Bt) do { __builtin_amdgcn_s_setprio(1); _Pragma("unroll") for (int m = 0; m < 4; ++m) _Pragma("unroll") for (int n = 0; n < 2; ++n) _Pragma("unroll") for (int k = 0; k < 2; ++k) \
        acc[ai][bj][m][n] = __builtin_amdgcn_mfma_f32_16x16x32_bf16(Bt[n][k], At[m][k], acc[ai][bj][m][n], 0, 0, 0); __builtin_amdgcn_s_setprio(0); } while (0)
#define PG8_WAIT_V(n) asm volatile("s_waitcnt vmcnt(" #n ")" ::: "memory")
#define PG8_WAIT_L(n) asm volatile("s_waitcnt lgkmcnt(" #n ")" ::: "memory")
#define PG8_BAR __builtin_amdgcn_s_barrier()
#define PG8_SCHED __builtin_amdgcn_sched_barrier(0)
    Unit cur, nxt; int ui = 0;
    if (!S.next(0, cur)) return;
    f32x4 acc[2][2][4][2];
#pragma unroll
    for (int a = 0; a < 2; ++a)
#pragma unroll
        for (int b = 0; b < 2; ++b)
#pragma unroll
            for (int m = 0; m < 4; ++m)
#pragma unroll
                for (int n = 0; n < 2; ++n) acc[a][b][m][n] = (f32x4){0.f, 0.f, 0.f, 0.f};
    bf16x8 At[4][2], B0[2][2], B1[2][2];
    const char* cA = (const char*)g.A + (size_t)cur.pm * tstepA; const char* cB = (const char*)g.Bt + (size_t)cur.pn * tstepB;
    S.a_ready(cur);
    if constexpr (SP2) {
        PG8_STAGE(PG8_SB(0, 0), cB, voffB); PG8_STAGE(PG8_SB(0, 1), cB + hstepB, voffB); PG8_STAGE(PG8_SA(0, 0), cA, voffA); PG8_STAGE(PG8_SA(0, 1), cA + hstepA, voffA);
        if (wr == 1) PG8_BAR;
        PG8_WAIT_V(2); PG8_BAR;
        PG8_STAGE(PG8_SB(1, 0), cB + kstep, voffB); PG8_STAGE(PG8_SA(1, 0), cA + kstep, voffA); PG8_STAGE(PG8_SB(1, 1), cB + hstepB + kstep, voffB);
        PG8_WAIT_V(6); PG8_BAR;
    } else {
        PG8_STAGE(PG8_SB(0, 0), cB, voffB); PG8_STAGE(PG8_SA(0, 0), cA, voffA); PG8_STAGE(PG8_SB(0, 1), cB + hstepB, voffB); PG8_STAGE(PG8_SA(0, 1), cA + hstepA, voffA);
        if (wr == 1) PG8_BAR;
        PG8_WAIT_V(4); PG8_BAR;
        PG8_STAGE(PG8_SB(1, 0), cB + kstep, voffB); PG8_STAGE(PG8_SA(1, 0), cA + kstep, voffA); PG8_STAGE(PG8_SB(1, 1), cB + hstepB + kstep, voffB);
        PG8_WAIT_V(6); PG8_BAR;
    }
    for (;;) {
        const bool has_next = S.next(ui + 1, nxt);
        const char* nA = has_next ? (const char*)g.A + (size_t)nxt.pm * tstepA : cA; const char* nB = has_next ? (const char*)g.Bt + (size_t)nxt.pn * tstepB : cB;
#pragma unroll 1
        for (int t = 0; t < nt; t += 2) {
            const bool last = (t == nt - 2);
            const char* a1 = cA + (size_t)(t + 1) * kstep;
            const char* a2 = last ? nA : cA + (size_t)(t + 2) * kstep; const char* b2 = last ? nB : cB + (size_t)(t + 2) * kstep;
            const char* a3 = a2 + kstep; const char* b3 = b2 + kstep;
            if (last && has_next) S.a_ready(nxt);
            if constexpr (SP2) {
            PG8_LDB(B0, 0, 0); PG8_LDB(B1, 0, 1); PG8_SCHED; PG8_LDA(At, 0, 0); PG8_STAGE(PG8_SA(1, 1), a1 + hstepA, voffA);
            PG8_WAIT_V(8); PG8_WAIT_L(0); PG8_BAR; PG8_MMA(0, 0, At, B0); PG8_MMA(0, 1, At, B1); PG8_BAR; PG8_SCHED;
            PG8_LDA(At, 0, 1); PG8_STAGE(PG8_SB(0, 0), b2, voffB); PG8_STAGE(PG8_SB(0, 1), b2 + hstepB, voffB); PG8_STAGE(PG8_SA(0, 0), a2, voffA);
            PG8_WAIT_V(8); PG8_WAIT_L(0); PG8_BAR; PG8_MMA(1, 0, At, B0); PG8_MMA(1, 1, At, B1); PG8_BAR; PG8_SCHED;
            PG8_LDB(B0, 1, 0); PG8_LDB(B1, 1, 1); PG8_SCHED; PG8_LDA(At, 1, 0); PG8_STAGE(PG8_SA(0, 1), a2 + hstepA, voffA);
            PG8_WAIT_V(8); PG8_WAIT_L(0); PG8_BAR; PG8_MMA(0, 0, At, B0); PG8_MMA(0, 1, At, B1); PG8_BAR; PG8_SCHED;
            PG8_LDA(At, 1, 1); PG8_STAGE(PG8_SB(1, 0), b3, voffB); PG8_STAGE(PG8_SB(1, 1), b3 + hstepB, voffB); PG8_STAGE(PG8_SA(1, 0), a3, voffA);
            PG8_WAIT_V(8); PG8_WAIT_L(0); PG8_BAR; PG8_MMA(1, 0, At, B0); PG8_MMA(1, 1, At, B1); PG8_BAR; PG8_SCHED;
            } else {
            PG8_LDB(B0, 0, 0); PG8_SCHED; PG8_LDA(At, 0, 0); PG8_STAGE(PG8_SA(1, 1), a1 + hstepA, voffA);
            PG8_WAIT_L(8); PG8_BAR; PG8_WAIT_L(0); PG8_MMA(0, 0, At, B0); PG8_BAR; PG8_SCHED;
            PG8_LDB(B1, 0, 1); PG8_STAGE(PG8_SB(0, 0), b2, voffB);
            PG8_BAR; PG8_WAIT_L(0); PG8_MMA(0, 1, At, B1); PG8_BAR;
            PG8_LDA(At, 0, 1); PG8_STAGE(PG8_SA(0, 0), a2, voffA);
            PG8_BAR; PG8_WAIT_L(0); PG8_MMA(1, 0, At, B0); PG8_BAR; PG8_SCHED;
            PG8_STAGE(PG8_SB(0, 1), b2 + hstepB, voffB);
            PG8_WAIT_V(6); PG8_BAR; PG8_MMA(1, 1, At, B1); PG8_BAR;
            PG8_LDB(B0, 1, 0); PG8_SCHED; PG8_LDA(At, 1, 0); PG8_STAGE(PG8_SA(0, 1), a2 + hstepA, voffA);
            PG8_WAIT_L(8); PG8_BAR; PG8_WAIT_L(0); PG8_MMA(0, 0, At, B0); PG8_BAR; PG8_SCHED;
            PG8_LDB(B1, 1, 1); PG8_STAGE(PG8_SB(1, 0), b3, voffB);
            PG8_BAR; PG8_WAIT_L(0); PG8_MMA(0, 1, At, B1); PG8_BAR;
            PG8_LDA(At, 1, 1); PG8_STAGE(PG8_SA(1, 0), a3, voffA);
            PG8_BAR; PG8_WAIT_L(0); PG8_MMA(1, 0, At, B0); PG8_BAR; PG8_SCHED;
            PG8_STAGE(PG8_SB(1, 1), b3 + hstepB, voffB);
            PG8_WAIT_V(6); PG8_BAR; PG8_MMA(1, 1, At, B1); PG8_BAR;
            }
        }
        if constexpr (ALIGN_EPI) { if (wr == 0) PG8_BAR; }
        if constexpr (!Epi::AFTER_DRAIN) { E(acc, cur, wr, wc, fr, fq); S.done(cur); }
        if (!has_next) break;
#pragma unroll
        for (int a = 0; a < 2; ++a)
#pragma unroll
            for (int b = 0; b < 2; ++b)
#pragma unroll
                for (int m = 0; m < 4; ++m)
#pragma unroll
                    for (int n = 0; n < 2; ++n) acc[a][b][m][n] = (f32x4){0.f, 0.f, 0.f, 0.f};
        cur = nxt; cA = nA; cB = nB; ++ui;
        if constexpr (ALIGN_EPI) { if (wr == 1) PG8_BAR; }
    }
    PG8_WAIT_V(0);
    if constexpr (!ALIGN_EPI) { if (wr == 0) PG8_BAR; }
    PG8_BAR;
    if constexpr (Epi::AFTER_DRAIN) { E.fused(acc, cur, wr, wc, fr, fq, lds, wid, lane); S.done(cur); }
#undef PG8_SA
#undef PG8_SB
#undef PG8_STAGE
#undef PG8_LDA
#undef PG8_LDB
#undef PG8_MMA
#undef PG8_WAIT_V
#undef PG8_WAIT_L
#undef PG8_BAR
#undef PG8_SCHED
}
}
#else
namespace pg8 {
typedef unsigned short bf16_t;
constexpr int BM = 256, BK = 64, HALF = 128, STAGE_BYTES = 131072, NXCD = 8, WGM = 8;
struct Unit { int pm, pn; };
struct Gemm { const bf16_t* A; const bf16_t* Bt; int M, N, K, lda, ldb; };
struct StaticOrder {
    int nM, nN, nwg, G, c;
    void init(int M, int N, int G_, int c_) { nM = M / BM; nN = N / BM; nwg = nM * nN; G = G_; c = c_; }
    bool next(int i, Unit& u) const {
        const long L = (long)i * G + c; if (L >= nwg) return false;
        int wgid = (int)L; { const int q = nwg / NXCD, r = nwg % NXCD, xcd = wgid % NXCD, off = wgid / NXCD; wgid = (xcd < r ? xcd * (q + 1) : r * (q + 1) + (xcd - r) * q) + off; }
        const int nig = WGM * nN, gid = wgid / nig, fm = gid * WGM, gsz = (nM - fm) < WGM ? (nM - fm) : WGM;
        u.pm = fm + ((wgid % nig) % gsz); u.pn = (wgid % nig) / gsz; return true;
    }
};
template <class Epi, class Sched, bool ALIGN_EPI = false, bool SP2 = false>
static void gemm_phase(unsigned char*, const Gemm g, const Sched& S, const Epi& E) {
    const int tid = threadIdx.x, wid = tid >> 6, lane = tid & 63, wr = wid >> 2, wc = wid & 3, fr = lane & 15, fq = lane >> 4;
    Unit cur;
    for (int ui = 0; S.next(ui, cur); ++ui) {
        f32x4 acc[2][2][4][2];
        for (int ai = 0; ai < 2; ++ai) for (int bj = 0; bj < 2; ++bj) for (int m = 0; m < 4; ++m) for (int n = 0; n < 2; ++n) for (int e = 0; e < 4; ++e) {
            const int row = cur.pm * 256 + ai * 128 + wr * 64 + m * 16 + fr;
            const int col = cur.pn * 256 + bj * 128 + wc * 32 + (Epi::PERM ? 8 * fq + 4 * n + e : 16 * n + 4 * fq + e);
            float sum = 0.f; for (int k = 0; k < g.K; ++k) sum += bf2f(g.A[(size_t)row * g.lda + k]) * bf2f(g.Bt[(size_t)col * g.ldb + k]);
            acc[ai][bj][m][n][e] = sum; }
        E(acc, cur, wr, wc, fr, fq);
    }
}
}
#define PG8_LAS
#endif
typedef float f32x4_t __attribute__((ext_vector_type(4)));
typedef unsigned u32x4_t __attribute__((ext_vector_type(4)));
typedef unsigned u32x2_t __attribute__((ext_vector_type(2)));
#ifdef HOST_TEST
__device__ __forceinline__ unsigned pk2bf(float lo, float hi) { return (unsigned)f2bf(lo) | ((unsigned)f2bf(hi) << 16); }
#else
__device__ __forceinline__ unsigned pk2bf(float lo, float hi) { unsigned r; asm volatile("v_cvt_pk_bf16_f32 %0, %1, %2" : "=v"(r) : "v"(lo), "v"(hi)); return r; }
#endif

template <int MODE>
__device__ __forceinline__ void fp_wt(const float* __restrict__ W, const float* __restrict__ kscale, bf16_t* __restrict__ Wt, const int K, const int NO, const int NP) {
  for (long idx = gtid(); idx < (long)NP * (K / 8); idx += gsize()) {
    const int n = (int)(idx % NP), kc = (int)(idx / NP);
    const int src = MODE == 0 ? l0_src(n) : (MODE == 1 ? l1_src(n) : (n < NO ? n : -1));
    float v[8];
#pragma unroll
    for (int i = 0; i < 8; ++i) { v[i] = src >= 0 ? W[(size_t)(kc * 8 + i) * NO + src] : 0.f; if (MODE == 2 && kscale) v[i] *= kscale[kc * 8 + i]; }
    u32x4_t o; o.x = pk2bf(v[0], v[1]); o.y = pk2bf(v[2], v[3]); o.z = pk2bf(v[4], v[5]); o.w = pk2bf(v[6], v[7]);
    *(u32x4_t*)(Wt + (size_t)n * K + kc * 8) = o;
  }
}
__device__ __forceinline__ void fp_mod(const Params& p, float* ldsf) {
  float* sc = ldsf;
  float* red = ldsf + NV * DM;
  const int tid = threadIdx.x, jl = tid & 63, ks = tid >> 6;
  for (int i = tid; i < NV * DM; i += NTHREADS) sc[i] = silu_f(i < NB * DM ? p.c[i] : p.c_ctx[i - NB * DM]);
  __syncthreads();
  constexpr int NJB = 3 * DM / 64, KS = DM / 8;
  for (int item = blockIdx.x; item < 2 * NJB; item += gridDim.x) {
    const int l = item / NJB, j = (item % NJB) * 64 + jl;
    const float* w = l ? p.l1_w_mod : p.l0_w_mod; const float* bm = l ? p.l1_b_mod : p.l0_b_mod;
    float acc[NV];
#pragma unroll
    for (int v = 0; v < NV; ++v) acc[v] = 0.f;
    for (int k = ks * KS; k < (ks + 1) * KS; ++k) { const float wv = w[(size_t)k * 3 * DM + j];
#pragma unroll
      for (int v = 0; v < NV; ++v) acc[v] += sc[v * DM + k] * wv; }
#pragma unroll
    for (int v = 0; v < NV; ++v) red[(ks * NV + v) * 64 + jl] = acc[v];
    __syncthreads();
    for (int o = tid; o < NV * 64; o += NTHREADS) { const int v = o / 64, jj = o % 64; float t = bm[(item % NJB) * 64 + jj];
#pragma unroll
      for (int q = 0; q < 8; ++q) t += red[(q * NV + v) * 64 + jj];
      p.modv[((size_t)l * NV + v) * 3 * DM + (item % NJB) * 64 + jj] = t; }
    __syncthreads();
  }
}

template <int L> __device__ __forceinline__ void fp_sw_l(const Params& p, float* ldsf, const float* __restrict__ w) {
  float* sh = ldsf;
  float* red = ldsf + NV * DM;
  const int tid = threadIdx.x, jl = tid & 63, ks = tid >> 6;
  for (int i = tid; i < NV * DM; i += NTHREADS) { const int v = i / DM, k = i % DM; sh[i] = p.modv[((size_t)L * NV + v) * 3 * DM + k]; }
  __syncthreads();
  constexpr int NJB = LDP / 64, KS = DM / 8, NO = L ? N1 : N0;
  for (int item = blockIdx.x; item < NJB; item += gridDim.x) {
    const int j = item * 64 + jl;
    const int src = L ? l1_src(j) : l0_src(j);
    float acc[NV];
#pragma unroll
    for (int v = 0; v < NV; ++v) acc[v] = 0.f;
    if (src >= 0) {
#pragma unroll 8
      for (int k = ks * KS; k < (ks + 1) * KS; ++k) { const float wv = w[(size_t)k * NO + src];
#pragma unroll
        for (int v = 0; v < NV; ++v) acc[v] += sh[v * DM + k] * wv; } }
#pragma unroll
    for (int v = 0; v < NV; ++v) red[(ks * NV + v) * 64 + jl] = acc[v];
    __syncthreads();
    for (int o = tid; o < NV * 64; o += NTHREADS) { const int v = o / 64, jj = o % 64; float t = 0.f;
#pragma unroll
      for (int q = 0; q < 8; ++q) t += red[(q * NV + v) * 64 + jj];
      p.sw[((size_t)L * NV + v) * LDP + item * 64 + jj] = t; }
    __syncthreads();
  }
  __syncthreads();
}
__device__ __forceinline__ void fp_sw(const Params& p, float* ldsf) { fp_sw_l<0>(p, ldsf, p.l0_w_in); fp_sw_l<1>(p, ldsf, p.l1_w_in); }
__device__ __forceinline__ void fp_zero(const Params& p) {
  for (long i = gtid(); i < (long)RPOS * 8; i += gsize()) { const int pos = (int)(i / 8), e = (int)(i % 8); float sn, cs; sincosf((float)pos * rope_inv(e), &sn, &cs); p.ropet[i] = cs; p.ropet[RPOS * 8 + i] = sn; }
  for (long i = gtid(); i < M; i += gsize()) { p.ssq_q[i] = 0.f; p.ssq_kv[i] = 0.f; p.ssq1[i] = 0.f; p.ssq0[i] = 0.f; if (i < MLAT) p.ssq2[i] = 0.f; }
}
__device__ __forceinline__ float wave_sum(float v) {
#pragma unroll
  for (int o = 1; o < 64; o <<= 1) v += __shfl_xor(v, o);
  return v;
}
__device__ __forceinline__ void fp_prep0(const Params& p) {
  const int lane = threadIdx.x & 63, gw = (int)(gtid() >> 6), ngw = (int)(gsize() >> 6);
  for (int m = gw; m < M; m += ngw) {
    const float* xr = row_input(p, m); const int v = row_variant(m);
    const float* sc = p.modv + ((size_t)0 * NV + v) * 3 * DM + DM;
    float ss = 0.f;
    for (int c = lane * 4; c < DM; c += 256) {
      const f32x4_t xv = *(const f32x4_t*)(xr + c), g = *(const f32x4_t*)(p.l0_norm + c), s1 = *(const f32x4_t*)(sc + c);
      ss += xv.x * xv.x + xv.y * xv.y + xv.z * xv.z + xv.w * xv.w;
      u32x2_t o; o.x = pk2bf(xv.x * g.x * (1.f + s1.x), xv.y * g.y * (1.f + s1.y)); o.y = pk2bf(xv.z * g.z * (1.f + s1.z), xv.w * g.w * (1.f + s1.w));
      *(u32x2_t*)(p.A0 + (size_t)m * LDA + c) = o; }
    ss = wave_sum(ss);
    if (lane == 0) p.ssq0[m] = ss;
  }
}
__device__ __forceinline__ void fp_gm1(const Params& p) {
  for (long idx = gtid(); idx < (long)NV * DM; idx += gsize()) { const int v = (int)(idx / DM), k = (int)(idx % DM);
    p.gm1[idx] = p.l1_norm[k] * (1.f + p.modv[((size_t)1 * NV + v) * 3 * DM + DM + k]); }
}

__device__ __forceinline__ void rope8(const float* __restrict__ ropet, f32x4_t& v0, f32x4_t& v1, const int fq, const int tl) {
  const int pos = fq < 2 ? tl / GW : tl % GW; const bool first = (fq & 1) == 0;
  const f32x4_t c0 = *(const f32x4_t*)(ropet + pos * 8), c1 = *(const f32x4_t*)(ropet + pos * 8 + 4), s0 = *(const f32x4_t*)(ropet + RPOS * 8 + pos * 8), s1 = *(const f32x4_t*)(ropet + RPOS * 8 + pos * 8 + 4);
#pragma unroll
  for (int e = 0; e < 8; ++e) {
    const float own = e < 4 ? v0[e & 3] : v1[e & 3]; const float oth = __shfl_xor(own, 16);
    const float cs = e < 4 ? c0[e & 3] : c1[e & 3], sn = e < 4 ? s0[e & 3] : s1[e & 3];
    const float r = first ? own * cs - oth * sn : own * cs + oth * sn;
    if (e < 4) v0[e & 3] = r; else v1[e & 3] = r;
  }
}
template <int L> struct EpiIn {
  static constexpr bool PERM = true, AFTER_DRAIN = false;
  bf16_t* Pb; const float* ssq; const float* sw; float* ssq_q; float* ssq_kv; const float* ropet;
  __device__ __forceinline__ void operator()(const f32x4_t (&acc)[2][2][4][2], const pg8::Unit& u, int wr, int wc, int fr, int fq) const {
    const int r0 = u.pm * 256, tt = r0 % TB, b = r0 / TB; const bool latent = tt >= CTX; const int v = latent ? b : NB;
    const float* swv = sw + (size_t)v * LDP;
    float rstd[2][4];
#pragma unroll
    for (int ai = 0; ai < 2; ++ai)
#pragma unroll
      for (int m = 0; m < 4; ++m) rstd[ai][m] = rsqrtf(ssq[r0 + ai * 128 + wr * 64 + m * 16 + fr] * (1.f / DM) + EPS);
#pragma unroll
    for (int bj = 0; bj < 2; ++bj) {
      const int cg = u.pn * 256 + bj * 128 + wc * 32, c0 = cg + 8 * fq;
      const f32x4_t s0 = *(const f32x4_t*)(swv + c0), s1 = *(const f32x4_t*)(swv + c0 + 4);
      const bool is_rope = L == 0 && cg == P0_KR && latent;
      const int seg = L == 0 ? (cg < QR ? 1 : (cg < QR + KVR ? 2 : 0)) : 0;
#pragma unroll
      for (int ai = 0; ai < 2; ++ai)
#pragma unroll
        for (int m = 0; m < 4; ++m) {
          const int row = r0 + ai * 128 + wr * 64 + m * 16 + fr;
          f32x4_t v0 = acc[ai][bj][m][0] * rstd[ai][m] + s0, v1 = acc[ai][bj][m][1] * rstd[ai][m] + s1;
          if (seg) { float q = v0.x * v0.x + v0.y * v0.y + v0.z * v0.z + v0.w * v0.w + v1.x * v1.x + v1.y * v1.y + v1.z * v1.z + v1.w * v1.w;
            q += __shfl_xor(q, 16); q += __shfl_xor(q, 32); if (fq == 0) atomicAdd(seg == 1 ? &ssq_q[row] : &ssq_kv[row], q); }
          if (is_rope) rope8(ropet, v0, v1, fq, tt - CTX + ai * 128 + wr * 64 + m * 16 + fr);
          u32x4_t o; o.x = pk2bf(v0.x, v0.y); o.y = pk2bf(v0.z, v0.w); o.z = pk2bf(v1.x, v1.y); o.w = pk2bf(v1.z, v1.w);
          *(u32x4_t*)(Pb + (size_t)row * LDP + c0) = o;
        }
    }
  }
};
struct EpiQ {
  static constexpr bool PERM = true, AFTER_DRAIN = false;
  bf16_t* qb; const float* ssq_q; const float* ropet;
  __device__ __forceinline__ void operator()(const f32x4_t (&acc)[2][2][4][2], const pg8::Unit& u, int wr, int wc, int fr, int fq) const {
    const int r0 = u.pm * 256, tt = r0 % TB; const bool latent = tt >= CTX;
    float rsv[2][4];
#pragma unroll
    for (int ai = 0; ai < 2; ++ai)
#pragma unroll
      for (int m = 0; m < 4; ++m) rsv[ai][m] = rsqrtf(ssq_q[r0 + ai * 128 + wr * 64 + m * 16 + fr] * (1.f / QR) + EPS);
#pragma unroll
    for (int bj = 0; bj < 2; ++bj) {
      const int cg = u.pn * 256 + bj * 128 + wc * 32, c0 = cg + 8 * fq;
      const bool is_rope = latent && ((cg / 32) % 3 == 2);
#pragma unroll
      for (int ai = 0; ai < 2; ++ai)
#pragma unroll
        for (int m = 0; m < 4; ++m) {
          const int row = r0 + ai * 128 + wr * 64 + m * 16 + fr;
          const float rs = rsv[ai][m];
          f32x4_t v0 = acc[ai][bj][m][0] * rs, v1 = acc[ai][bj][m][1] * rs;
          if (is_rope) rope8(ropet, v0, v1, fq, tt - CTX + ai * 128 + wr * 64 + m * 16 + fr);
          v0 = v0 * C2Q; v1 = v1 * C2Q;
          u32x4_t o; o.x = pk2bf(v0.x, v0.y); o.y = pk2bf(v0.z, v0.w); o.z = pk2bf(v1.x, v1.y); o.w = pk2bf(v1.z, v1.w);
          if (c0 < QW) *(u32x4_t*)(qb + (size_t)row * QW + c0) = o;
        }
    }
  }
};
struct EpiKV {
  static constexpr bool PERM = true, AFTER_DRAIN = false;
  bf16_t* kn; bf16_t* vb; const float* ssq_kv;
  __device__ __forceinline__ void operator()(const f32x4_t (&acc)[2][2][4][2], const pg8::Unit& u, int wr, int wc, int fr, int fq) const {
    const int r0 = u.pm * 256;
    float rsv[2][4];
#pragma unroll
    for (int ai = 0; ai < 2; ++ai)
#pragma unroll
      for (int m = 0; m < 4; ++m) rsv[ai][m] = rsqrtf(ssq_kv[r0 + ai * 128 + wr * 64 + m * 16 + fr] * (1.f / KVR) + EPS);
#pragma unroll
    for (int bj = 0; bj < 2; ++bj) {
      const int cg = u.pn * 256 + bj * 128 + wc * 32, G = cg / 32, hh = G / 4, part = G % 4;
      bf16_t* dst = (part < 2 ? kn : vb) + hh * 64 + (part & 1) * 32 + 8 * fq;
#pragma unroll
      for (int ai = 0; ai < 2; ++ai)
#pragma unroll
        for (int m = 0; m < 4; ++m) {
          const int row = r0 + ai * 128 + wr * 64 + m * 16 + fr;
          const float rs = rsv[ai][m];
          const f32x4_t v0 = acc[ai][bj][m][0] * rs, v1 = acc[ai][bj][m][1] * rs;
          u32x4_t o; o.x = pk2bf(v0.x, v0.y); o.y = pk2bf(v0.z, v0.w); o.z = pk2bf(v1.x, v1.y); o.w = pk2bf(v1.z, v1.w);
          if (cg < KVW) *(u32x4_t*)(dst + (size_t)row * BRA) = o;
        }
    }
  }
};
struct EpiOut0 {
  static constexpr bool PERM = false, AFTER_DRAIN = false;
  const float* x; const float* ctx; const float* modv; const float* gm1; float* out; bf16_t* A1; float* ssq1;
  __device__ __forceinline__ void operator()(const f32x4_t (&acc)[2][2][4][2], const pg8::Unit& u, int wr, int wc, int fr, int fq) const {
    const int r0 = u.pm * 256, tt = r0 % TB, b = r0 / TB; const bool latent = tt >= CTX; const int v = latent ? b : NB;
    const float* gate = modv + ((size_t)0 * NV + v) * 3 * DM + 2 * DM; const float* gm = gm1 + (size_t)v * DM;
#pragma unroll
    for (int ai = 0; ai < 2; ++ai)
#pragma unroll
      for (int m = 0; m < 4; ++m) {
        const int rl = ai * 128 + wr * 64 + m * 16 + fr, row = r0 + rl;
        const size_t io = latent ? ((size_t)b * SEQ + (tt - CTX + rl)) * DM : ((size_t)b * CTX + (tt + rl)) * DM;
        const float* xin = (latent ? x : ctx) + io; float q = 0.f;
#pragma unroll
        for (int bj = 0; bj < 2; ++bj)
#pragma unroll
          for (int n = 0; n < 2; ++n) {
            const int c = u.pn * 256 + bj * 128 + wc * 32 + n * 16 + fq * 4;
            const f32x4_t h1 = *(const f32x4_t*)(xin + c) + *(const f32x4_t*)(gate + c) * acc[ai][bj][m][n];
            q += h1.x * h1.x + h1.y * h1.y + h1.z * h1.z + h1.w * h1.w;
            if (latent) *(f32x4_t*)(out + io + c) = h1;
            const f32x4_t a = h1 * *(const f32x4_t*)(gm + c);
            u32x2_t o; o.x = pk2bf(a.x, a.y); o.y = pk2bf(a.z, a.w);
            *(u32x2_t*)(A1 + (size_t)row * LDA + c) = o;
          }
        q += __shfl_xor(q, 16); q += __shfl_xor(q, 32); if (fq == 0) atomicAdd(&ssq1[row], q);
      }
  }
};
struct EpiOut1 {
  static constexpr bool PERM = false, AFTER_DRAIN = false;
  const float* modv; float* out; float* ssq2;
  __device__ __forceinline__ void operator()(const f32x4_t (&acc)[2][2][4][2], const pg8::Unit& u, int wr, int wc, int fr, int fq) const {
    const int r0 = u.pm * 256, b = r0 / SEQ;
    const float* gate = modv + ((size_t)1 * NV + b) * 3 * DM + 2 * DM;
#pragma unroll
    for (int ai = 0; ai < 2; ++ai)
#pragma unroll
      for (int m = 0; m < 4; ++m) {
        const int row = r0 + ai * 128 + wr * 64 + m * 16 + fr; float q = 0.f;
#pragma unroll
        for (int bj = 0; bj < 2; ++bj)
#pragma unroll
          for (int n = 0; n < 2; ++n) {
            const int c = u.pn * 256 + bj * 128 + wc * 32 + n * 16 + fq * 4;
            float* o = out + (size_t)row * DM + c;
            const f32x4_t h2 = *(const f32x4_t*)o + *(const f32x4_t*)(gate + c) * acc[ai][bj][m][n];
            q += h2.x * h2.x + h2.y * h2.y + h2.z * h2.z + h2.w * h2.w;
            *(f32x4_t*)o = h2;
          }
        q += __shfl_xor(q, 16); q += __shfl_xor(q, 32); if (fq == 0) atomicAdd(&ssq2[row], q);
      }
  }
};
template <class Epi> __device__ __forceinline__ void run_gemm(unsigned char* lds, const bf16_t* A, int lda, const bf16_t* Bt, int ldb, int Mr, int N, int K, const Epi& E) {
  pg8::Gemm g{A, Bt, Mr, N, K, lda, ldb}; pg8::StaticOrder S; S.init(Mr, N, (int)gridDim.x, (int)blockIdx.x);
  pg8::gemm_phase<Epi, pg8::StaticOrder, true, true>((PG8_LAS unsigned char*)lds, g, S, E);
}
__device__ __forceinline__ void fp_final(const Params& p) {
  const int lane = threadIdx.x & 63, gw = (int)(gtid() >> 6), ngw = (int)(gsize() >> 6);
  for (int ml = gw; ml < MLAT; ml += ngw) {
    const float rstd = rsqrtf(p.ssq2[ml] * (1.f / DM) + EPS); float* r = p.out + (size_t)ml * DM;
    for (int c = lane * 4; c < DM; c += 256) { const f32x4_t h = *(const f32x4_t*)(r + c), g = *(const f32x4_t*)(p.final_norm + c); *(f32x4_t*)(r + c) = h * rstd * g; }
  }
}


typedef short bf16x8_t __attribute__((ext_vector_type(8)));
typedef short s16x4_t __attribute__((ext_vector_type(4)));
typedef float f32x16_t __attribute__((ext_vector_type(16)));
#ifdef HOST_TEST
#define SBAR()
#define MFMA_ASM_PAD()
#define LGKM_WAIT()
#define VM_WAIT3()
#define VM_WAIT0()
__device__ __forceinline__ unsigned cvtpk(float lo, float hi) { return pk2bf(lo, hi); }
#define MFMA32(a, b, c) shim_mfma_32x32x16(a, b, c)
#define MFMA16(a, b, c) shim_mfma_16x16x32(a, b, c)
#define TR_READ(vb, OFF) shim_tr_read((vb) + (OFF))
#define LDS_ADDR(ptr) ((int)((const unsigned char*)(ptr) - g_lds_base))
#define EXP2F(x) exp2f(x)
#define RCPF(x) (1.f / (x))
#else
#define SBAR() __builtin_amdgcn_sched_barrier(0)
#define MFMA_ASM_PAD() do { __builtin_amdgcn_sched_barrier(0); asm volatile("s_nop 15\n\ts_nop 3" ::: "memory"); __builtin_amdgcn_sched_barrier(0); } while (0)
#define LGKM_WAIT() asm volatile("s_waitcnt lgkmcnt(0)" ::: "memory")
#define VM_WAIT3() asm volatile("s_waitcnt vmcnt(3)" ::: "memory")
#define VM_WAIT0() asm volatile("s_waitcnt vmcnt(0)" ::: "memory")
__device__ __forceinline__ unsigned cvtpk(float lo, float hi) { unsigned r; asm volatile("v_cvt_pk_bf16_f32 %0, %1, %2" : "=v"(r) : "v"(lo), "v"(hi)); return r; }
#define MFMA32(a, b, c) __builtin_amdgcn_mfma_f32_32x32x16_bf16(a, b, c, 0, 0, 0)
#define MFMA16(a, b, c) __builtin_amdgcn_mfma_f32_16x16x32_bf16(a, b, c, 0, 0, 0)
template <int OFF> __device__ __forceinline__ s16x4_t tr_read_dev(int vb) { s16x4_t r; asm volatile("ds_read_b64_tr_b16 %0, %1 offset:%2" : "=&v"(r) : "v"(vb), "i"(OFF) : "memory"); return r; }
#define TR_READ(vb, OFF) tr_read_dev<OFF>(vb)
#define LDS_ADDR(ptr) ((int)(uintptr_t)(ptr))
#define EXP2F(x) __builtin_amdgcn_exp2f(x)
#define RCPF(x) __builtin_amdgcn_rcpf(x)
#endif
namespace att {
constexpr int NW = 8, QBLK = 32, KVBLK = 64;
constexpr int SHM_K = KVBLK * 256, SHM_V = KVBLK * 128 * 2;
constexpr int NBUF = 3;
constexpr int OFF_V = 0, OFF_K = NBUF * SHM_V, OFF_WS = NBUF * SHM_V + NBUF * SHM_K, LDS_ATT = OFF_WS + NW * 64 * 4;
constexpr float THR2 = 11.5f;
#define KSWZ(row, colB) ((row) * 256 + ((colB) ^ (((row) & 7) << 4)))
__device__ __forceinline__ int crow(int r, int hi) { return (r & 3) + 8 * (r >> 2) + 4 * hi; }
__device__ __forceinline__ void partialSM(f32x16_t& p0, f32x16_t& p1, float& m_reg, float& mn, float& alpha) {
  float pmax = p0[0];
#pragma unroll
  for (int r = 1; r < 16; ++r) pmax = fmaxf(pmax, p0[r]);
#pragma unroll
  for (int r = 0; r < 16; ++r) pmax = fmaxf(pmax, p1[r]);
  { auto rr = __builtin_amdgcn_permlane32_swap(__builtin_bit_cast(unsigned, pmax), __builtin_bit_cast(unsigned, pmax), false, false);
    pmax = fmaxf(__builtin_bit_cast(float, (unsigned)rr[0]), __builtin_bit_cast(float, (unsigned)rr[1])); }
  if (__all(pmax - m_reg <= THR2)) { mn = m_reg; alpha = 1.f; }
  else { mn = fmaxf(m_reg, pmax); alpha = EXP2F(m_reg - mn); m_reg = mn; }
#pragma unroll
  for (int r = 0; r < 16; ++r) { p0[r] -= mn; p1[r] -= mn; }
#pragma unroll
  for (int r = 0; r < 16; ++r) p0[r] = EXP2F(p0[r]);
}
__device__ __forceinline__ void finishSM(f32x16_t& p0, f32x16_t& p1, float alpha, float& l_reg, bf16x8_t& pa0, bf16x8_t& pa1, bf16x8_t& pa2, bf16x8_t& pa3) {
#pragma unroll
  for (int r = 0; r < 16; ++r) p1[r] = EXP2F(p1[r]);
  float ps = 0.f;
#pragma unroll
  for (int r = 0; r < 16; ++r) ps += p0[r];
#pragma unroll
  for (int r = 0; r < 16; ++r) ps += p1[r];
  { auto rr = __builtin_amdgcn_permlane32_swap(__builtin_bit_cast(unsigned, ps), __builtin_bit_cast(unsigned, ps), false, false);
    ps = __builtin_bit_cast(float, (unsigned)rr[0]) + __builtin_bit_cast(float, (unsigned)rr[1]); }
  l_reg = l_reg * alpha + ps;
#define PK4(P, BASE, OUT) do { unsigned a0 = cvtpk(P[BASE + 0], P[BASE + 1]), a1 = cvtpk(P[BASE + 2], P[BASE + 3]);   \
    unsigned b0 = cvtpk(P[BASE + 4], P[BASE + 5]), b1 = cvtpk(P[BASE + 6], P[BASE + 7]);                              \
    auto r0 = __builtin_amdgcn_permlane32_swap(a0, b0, false, false); auto r1 = __builtin_amdgcn_permlane32_swap(a1, b1, false, false); \
    u32x4_t w = {(unsigned)r0[0], (unsigned)r1[0], (unsigned)r0[1], (unsigned)r1[1]}; OUT = __builtin_bit_cast(bf16x8_t, w); } while (0)
  PK4(p0, 0, pa0); PK4(p0, 8, pa1); PK4(p1, 0, pa2); PK4(p1, 8, pa3);
#undef PK4
}
__device__ __forceinline__ void qkt(f32x16_t& p0, f32x16_t& p1, const unsigned char* Ks, const bf16x8_t* qr, int r32, int hi) {
#pragma unroll
  for (int r = 0; r < 16; ++r) { p0[r] = 0.f; p1[r] = 0.f; }
#pragma unroll
  for (int d0 = 0; d0 < 6; ++d0) { const int cb = (d0 * 16 + hi * 8) * 2;
    const bf16x8_t b0 = *reinterpret_cast<const bf16x8_t*>(Ks + KSWZ(r32, cb));
    const bf16x8_t b1 = *reinterpret_cast<const bf16x8_t*>(Ks + KSWZ(32 + r32, cb));
    p0 = MFMA32(b0, qr[d0], p0); p1 = MFMA32(b1, qr[d0], p1); }
}
__device__ __forceinline__ int v_st(int k, int c) { const int kk = (k & ~0xC) | ((k & 4) << 1) | ((k & 8) >> 1); return ((kk >> 3) * 4 + (c >> 5)) * 512 + ((kk & 7) * 32 + (c & 31)) * 2; }
__device__ __forceinline__ int v_rd_base(int lane) { return ((lane & 3) << 3) | (((lane >> 2) & 3) << 6) | (((lane >> 4) & 1) << 5) | (((lane >> 5) & 1) << 8); }
constexpr int v_rd_off(int d0, int ks, int half) { return d0 * 512 + ks * 4096 + half * 2048; }
template <int D0> __device__ __forceinline__ void pv_one(f32x16_t& od, int vb, bf16x8_t pa0, bf16x8_t pa1, bf16x8_t pa2, bf16x8_t pa3) {
  const s16x4_t l0 = TR_READ(vb, v_rd_off(D0, 0, 0)), h0 = TR_READ(vb, v_rd_off(D0, 0, 1)), l1 = TR_READ(vb, v_rd_off(D0, 1, 0)), h1 = TR_READ(vb, v_rd_off(D0, 1, 1));
  const s16x4_t l2 = TR_READ(vb, v_rd_off(D0, 2, 0)), h2 = TR_READ(vb, v_rd_off(D0, 2, 1)), l3 = TR_READ(vb, v_rd_off(D0, 3, 0)), h3 = TR_READ(vb, v_rd_off(D0, 3, 1));
  LGKM_WAIT(); SBAR();
#define PKV(L, H) (bf16x8_t){L[0], L[1], L[2], L[3], H[0], H[1], H[2], H[3]}
  od = MFMA32(pa0, PKV(l0, h0), od); od = MFMA32(pa1, PKV(l1, h1), od); od = MFMA32(pa2, PKV(l2, h2), od); od = MFMA32(pa3, PKV(l3, h3), od);
#undef PKV
}
__device__ __forceinline__ void pv_d0(f32x16_t* o, int vb, bf16x8_t pa0, bf16x8_t pa1, bf16x8_t pa2, bf16x8_t pa3) {
  pv_one<0>(o[0], vb, pa0, pa1, pa2, pa3); pv_one<1>(o[1], vb, pa0, pa1, pa2, pa3);
}
__device__ __forceinline__ void attn_unit(const bf16_t* __restrict__ Qb, const bf16_t* __restrict__ Kn, const bf16_t* __restrict__ Kr, const bf16_t* __restrict__ Vh, const int nkeys,
                                          bf16_t* __restrict__ Ob, const bf16_t* __restrict__ Zb, unsigned char* lds) {
  const int tid = threadIdx.x, wid = tid >> 6, lane = tid & 63, r32 = lane & 31, hi = lane >> 5;
  unsigned char* V_lds = lds + OFF_V; unsigned char* K_lds = lds + OFF_K;
  float* wsf = (float*)(lds + OFF_WS) + wid * 64; float* li_l = wsf; float* al_l = wsf + 32;
  float m_reg = -1e30f, l_reg = 0.f; f32x16_t o[2]; bf16x8_t qr[6];
#pragma unroll
  for (int r = 0; r < 16; ++r) { o[0][r] = 0.f; o[1][r] = 0.f; }
  { const unsigned offq = (unsigned)((wid * QBLK + r32) * QW + hi * 8);
#pragma unroll
    for (int d0 = 0; d0 < 6; ++d0) qr[d0] = *reinterpret_cast<const bf16x8_t*>(Qb + offq + d0 * 16); }
  const int vb0 = LDS_ADDR(V_lds) + v_rd_base(lane);
  bf16x8_t sA_kn, sA_kr, sA_v, sB_kn, sB_kr, sB_v;
#ifdef HOST_TEST
#define OPAQUE_TID() const int t_ = tid
#else
#define OPAQUE_TID() int t_ = tid; asm volatile("" : "+v"(t_))
#endif
#define SLOAD(S, k0) do { OPAQUE_TID(); const int srow_ = t_ >> 3, sc8_ = t_ & 7, rrow_ = (t_ & 255) >> 2, cr_ = t_ & 3; \
    const unsigned offn_ = (unsigned)(srow_ * BRA + sc8_ * 8), offr_ = (unsigned)(rrow_ * LDP + cr_ * 8); \
    const bf16_t* kn_t = Kn + (size_t)(k0) * BRA; const bf16_t* kr_t = Kr + (size_t)(k0) * LDP; const bf16_t* v_t = Vh + (size_t)(k0) * BRA; \
    S##_kn = *reinterpret_cast<const bf16x8_t*>(kn_t + offn_); S##_kr = *reinterpret_cast<const bf16x8_t*>(kr_t + offr_); S##_v = *reinterpret_cast<const bf16x8_t*>(v_t + offn_); } while (0)
#define SWRITE(b, S) do { OPAQUE_TID(); const int srow_ = t_ >> 3, sc8_ = t_ & 7, rrow_ = (t_ & 255) >> 2, cr_ = t_ & 3; \
    *reinterpret_cast<bf16x8_t*>(K_lds + (b) * SHM_K + KSWZ(srow_, sc8_ * 16)) = S##_kn; *reinterpret_cast<bf16x8_t*>(K_lds + (b) * SHM_K + KSWZ(rrow_, (8 + cr_) * 16)) = S##_kr; \
    *reinterpret_cast<bf16x8_t*>(V_lds + (b) * SHM_V + v_st(srow_, sc8_ * 8)) = S##_v; } while (0)
#define RESC(a) do { if (__any((a) < 1.f)) { if (hi == 0) al_l[r32] = (a); WAVE_LDS_SYNC(); \
    _Pragma("unroll") for (int r = 0; r < 16; ++r) { const float f = al_l[crow(r, hi)]; o[0][r] *= f; o[1][r] *= f; } WAVE_LDS_SYNC(); } } while (0)
  f32x16_t pA0, pA1, pB0, pB1; float mnA, mnB, alA, alB; bf16x8_t pa0, pa1, pa2, pa3; const int NT = nkeys / KVBLK;
  SLOAD(sA, 0); VM_WAIT0(); SWRITE(0, sA); __syncthreads();
  qkt(pA0, pA1, K_lds, qr, r32, hi); partialSM(pA0, pA1, m_reg, mnA, alA);
  SLOAD(sB, KVBLK); if (2 < NT) SLOAD(sA, 2 * KVBLK);
  VM_WAIT3(); SWRITE(1, sB); __syncthreads();
  int bc = 0, bn = 1, bw = 2;
#define ROT() do { const int t_ = bc; bc = bn; bn = bw; bw = t_; } while (0)
#pragma unroll 1
  for (int j = 1; j + 1 < NT; j += 2) {
    SBAR(); qkt(pB0, pB1, K_lds + bn * SHM_K, qr, r32, hi);
    finishSM(pA0, pA1, alA, l_reg, pa0, pa1, pa2, pa3); SBAR();
    SLOAD(sB, (j + 2) * KVBLK); SBAR();
    pv_d0(o, vb0 + bc * SHM_V, pa0, pa1, pa2, pa3); partialSM(pB0, pB1, m_reg, mnB, alB);
    VM_WAIT3(); SWRITE(bw, sA);
    RESC(alB); __syncthreads(); ROT();
    SBAR(); qkt(pA0, pA1, K_lds + bn * SHM_K, qr, r32, hi);
    finishSM(pB0, pB1, alB, l_reg, pa0, pa1, pa2, pa3); SBAR();
    if (j + 3 < NT) SLOAD(sA, (j + 3) * KVBLK); SBAR();
    pv_d0(o, vb0 + bc * SHM_V, pa0, pa1, pa2, pa3); partialSM(pA0, pA1, m_reg, mnA, alA);
    VM_WAIT3(); SWRITE(bw, sB);
    RESC(alA); __syncthreads(); ROT();
  }
  SBAR(); qkt(pB0, pB1, K_lds + bn * SHM_K, qr, r32, hi);
  finishSM(pA0, pA1, alA, l_reg, pa0, pa1, pa2, pa3); SBAR();
  pv_d0(o, vb0 + bc * SHM_V, pa0, pa1, pa2, pa3); partialSM(pB0, pB1, m_reg, mnB, alB);
  RESC(alB);
  finishSM(pB0, pB1, alB, l_reg, pa0, pa1, pa2, pa3); SBAR();
  pv_d0(o, vb0 + bn * SHM_V, pa0, pa1, pa2, pa3);
  __syncthreads();
#undef ROT
  if (hi == 0) li_l[r32] = l_reg;
  WAVE_LDS_SYNC();
  float rli[16];
#pragma unroll
  for (int r = 0; r < 16; ++r) rli[r] = RCPF(li_l[crow(r, hi)]);
  WAVE_LDS_SYNC();
#pragma unroll
  for (int r = 0; r < 16; ++r) { const unsigned orow = (unsigned)(wid * QBLK + crow(r, hi));
#pragma unroll
    for (int d0 = 0; d0 < 2; ++d0) { const unsigned col = (unsigned)(d0 * 32 + r32); const float z = bf2f(Zb[orow * LDP + col]);
      Ob[orow * LDA + col] = f2bf(o[d0][r] * rli[r] * silu_f(z)); } }
#undef SLOAD
#undef SWRITE
#undef RESC
#undef OPAQUE_TID
}
}
__device__ __forceinline__ void fp_attn(const Params& p, unsigned char* lds) {
  const int G = (int)gridDim.x, bx = (int)blockIdx.x; const int vcu = (G % 8 == 0) ? (bx % 8) * (G / 8) + bx / 8 : bx;
  constexpr int QPB = SEQ / 256, NLAT = NB * MLA_H * QPB, NCTXU = NB * MLA_H;
#pragma unroll 1
  for (int u = vcu; u < NLAT + NCTXU; u += G) {
    int b, h, t0, nkeys;
    if (u < NLAT) { const int bh = u / QPB, qblk = u % QPB; b = bh / MLA_H; h = bh % MLA_H; t0 = CTX + qblk * 256; nkeys = TB; }
    else { const int bh = u - NLAT; b = bh / MLA_H; h = bh % MLA_H; t0 = 0; nkeys = CTX; }
    const size_t m0 = (size_t)b * TB + t0, k0 = (size_t)b * TB;
    att::attn_unit(p.qb + m0 * QW + h * QD, p.kn + k0 * BRA + h * NOPE, p.Pb + k0 * LDP + P0_KR, p.vb + k0 * BRA + h * VD, nkeys,
                   p.A0 + m0 * LDA + h * VD, p.Pb + m0 * LDP + P0_Z + h * VD, lds);
  }
}


namespace scan {
constexpr int VT_LD = 72;
constexpr int NSEG = 8;
struct WaveLds { bf16_t vt[32 * VT_LD]; float Tg[64], Te1[64], Te2[64], Tw2[64], Tden[64], Tinv[64]; int Trow[64]; float Tn[128]; };
static_assert(sizeof(WaveLds) % 16 == 0, "per-wave LDS block alignment");
constexpr int ST_STRIDE = 4096 + 128 + 8;
__device__ __forceinline__ float wave_psum(float v, int lane) {
#pragma unroll
  for (int d = 1; d < 64; d <<= 1) { const float o = __shfl_up(v, d); if (lane >= d) v += o; }
  return v;
}
__device__ __forceinline__ float wave_pmax(float v, int lane) {
#pragma unroll
  for (int d = 1; d < 64; d <<= 1) { const float o = __shfl_up(v, d); if (lane >= d) v = fmaxf(v, o); }
  return v;
}
__device__ __forceinline__ int crow(int r, int hi) { return (r & 3) + 8 * (r >> 2) + 4 * hi; }
__device__ __forceinline__ bf16x8_t acc_frag(const f32x16_t& x, int s) {
  u32x4_t w = {cvtpk(x[8 * s + 0], x[8 * s + 1]), cvtpk(x[8 * s + 2], x[8 * s + 3]), cvtpk(x[8 * s + 4], x[8 * s + 5]), cvtpk(x[8 * s + 6], x[8 * s + 7])};
  return __builtin_bit_cast(bf16x8_t, w);
}
__device__ __forceinline__ bf16x8_t pk4_frag(const f32x16_t& P, int base) {
  const unsigned a0 = cvtpk(P[base + 0], P[base + 1]), a1 = cvtpk(P[base + 2], P[base + 3]), b0 = cvtpk(P[base + 4], P[base + 5]), b1 = cvtpk(P[base + 6], P[base + 7]);
  auto r0 = __builtin_amdgcn_permlane32_swap(a0, b0, false, false); auto r1 = __builtin_amdgcn_permlane32_swap(a1, b1, false, false);
  u32x4_t w = {(unsigned)r0[0], (unsigned)r1[0], (unsigned)r0[1], (unsigned)r1[1]}; return __builtin_bit_cast(bf16x8_t, w);
}
typedef short s16x4v __attribute__((ext_vector_type(4)));
__device__ __forceinline__ bf16x8_t ld_nat(const bf16_t* p) { return *reinterpret_cast<const bf16x8_t*>(p); }
__device__ __forceinline__ bf16x8_t ld_perm(const bf16_t* p, int hi) {
  const s16x4v a = *reinterpret_cast<const s16x4v*>(p + 4 * hi), b = *reinterpret_cast<const s16x4v*>(p + 8 + 4 * hi);
  return (bf16x8_t){a[0], a[1], a[2], a[3], b[0], b[1], b[2], b[3]};
}
__device__ __forceinline__ void seg_range(int seg, int& c0, int& nc) { constexpr int nch = TB / 64, base = nch / NSEG, rem = nch % NSEG; c0 = seg * base + (seg < rem ? seg : rem); nc = base + (seg < rem ? 1 : 0); }

template <bool FULL>
__device__ __forceinline__ void mlstm_chunk(const Params& p, WaveLds& L, const int b, const int h, const int dir, const int vs, const int pc,
                                            f32x16_t (&C)[4], float (&nk)[4], float& m, float& bsum, const int lane) {
  const int r32 = lane & 31, hi = lane >> 5;
  const int mrow_l = b * TB + seq_token(pc * 64 + lane, dir);
  const int mr[2] = {b * TB + seq_token(pc * 64 + r32, dir), b * TB + seq_token(pc * 64 + 32 + r32, dir)};
  const bf16_t* Kb[2] = {p.mkc + (size_t)mr[0] * BRB + h * ML_D, p.mkc + (size_t)mr[1] * BRB + h * ML_D};
  const bf16_t* Qb[2] = {p.mqc + (size_t)mr[0] * BRB + h * ML_D, p.mqc + (size_t)mr[1] * BRB + h * ML_D};
  const bf16_t* pg = p.Pb + (size_t)mrow_l * LDP + P0_G + dir * 2 * ML_H + h;
  const float ig = bf2f(pg[0]) + p.b_i[dir * ML_H + h];
  const float lf = log_sigmoid_f(bf2f(pg[ML_H]) + p.b_f[dir * ML_H + h]);
  const float bc = wave_psum(lf, lane), g = ig - bc, pm = wave_pmax(g, lane);
  const float pm63 = __shfl(pm, 63), blast = __shfl(bc, 63), mm63 = fmaxf(m, pm63);
  { const bf16_t* vr = p.Pb + (size_t)mrow_l * LDP + P0_MV + h * ML_D + vs * 32;
#pragma unroll
    for (int c = 0; c < 4; ++c) { const bf16x8_t v8 = ld_nat(vr + c * 8);
#pragma unroll
      for (int e = 0; e < 8; ++e) L.vt[(c * 8 + e) * VT_LD + lane] = (bf16_t)v8[e]; } }
  L.Tw2[lane] = fast_exp(g - mm63);
  MFMA_ASM_PAD();
  float qn = 0.f, expmt = 0.f;
  if (FULL) {
    const float mm = fmaxf(m, pm);
    L.Tg[lane] = g; L.Te1[lane] = fast_exp(pm - mm); L.Te2[lane] = fast_exp(m - mm); L.Trow[lane] = mrow_l; expmt = fast_exp(-(bc + mm));
    const bf16_t* qrow = p.mqc + (size_t)mrow_l * BRB + h * ML_D;
#pragma unroll 4
    for (int c = 0; c < 16; ++c) { const bf16x8_t q8 = ld_nat(qrow + c * 8);
#pragma unroll
      for (int e = 0; e < 8; ++e) qn += bf2f((bf16_t)q8[e]) * L.Tn[c * 8 + e]; }
  }
  WAVE_LDS_SYNC();
  if (FULL) {
    f32x16_t O[2], Y[2];
#pragma unroll
    for (int tblk = 0; tblk < 2; ++tblk) {
#pragma unroll
      for (int r = 0; r < 16; ++r) { O[tblk][r] = 0.f; Y[tblk][r] = 0.f; }
      const int t = r32 + 32 * tblk; const float pm_t = __shfl(pm, t); float denl = 0.f;
#pragma unroll
      for (int sblk = 0; sblk <= tblk; ++sblk) {
        f32x16_t S;
#pragma unroll
        for (int r = 0; r < 16; ++r) S[r] = 0.f;
#pragma unroll
        for (int st = 0; st < 8; ++st) S = MFMA32(ld_nat(Kb[sblk] + 16 * st + 8 * hi), ld_nat(Qb[tblk] + 16 * st + 8 * hi), S);
#pragma unroll
        for (int r = 0; r < 16; ++r) { const int sidx = crow(r, hi) + 32 * sblk; const float w = fast_exp(L.Tg[sidx] - pm_t); const float pr = (sidx <= t) ? S[r] * w : 0.f; S[r] = pr; denl += pr; }
        const bf16x8_t pa0 = pk4_frag(S, 0), pa1 = pk4_frag(S, 8);
        O[tblk] = MFMA32(pa0, ld_nat(L.vt + r32 * VT_LD + 32 * sblk + 8 * hi), O[tblk]);
        O[tblk] = MFMA32(pa1, ld_nat(L.vt + r32 * VT_LD + 32 * sblk + 16 + 8 * hi), O[tblk]);
      }
      denl += __shfl_xor(denl, 32);
      if (hi == 0) L.Tden[t] = denl;
#pragma unroll
      for (int kblk = 0; kblk < 4; ++kblk)
#pragma unroll
        for (int s2 = 0; s2 < 2; ++s2) Y[tblk] = MFMA32(ld_perm(Qb[tblk] + 32 * kblk + 16 * s2, hi), acc_frag(C[kblk], s2), Y[tblk]);
    }
    WAVE_LDS_SYNC();
    { const float den = L.Te1[lane] * L.Tden[lane] + L.Te2[lane] * qn; L.Tinv[lane] = 1.f / fmaxf(fabsf(den), expmt); }
    WAVE_LDS_SYNC();
    bf16_t* Hout = (dir ? p.Hb : p.Hf) + (size_t)(h * 4 + vs) * M * 32 + r32;
#pragma unroll
    for (int tblk = 0; tblk < 2; ++tblk)
#pragma unroll
      for (int r = 0; r < 16; ++r) { const int t = crow(r, hi) + 32 * tblk;
        Hout[(size_t)L.Trow[t] * 32] = f2bf((L.Te1[t] * O[tblk][r] + L.Te2[t] * Y[tblk][r]) * L.Tinv[t]); }
  }
  const float a = fast_exp(m - mm63);
  bf16x8_t I0, I1;
#pragma unroll
  for (int j = 0; j < 8; ++j) { I0[j] = (r32 == 8 * hi + j) ? (short)0x3F80 : (short)0; I1[j] = (r32 == 16 + 8 * hi + j) ? (short)0x3F80 : (short)0; }
#pragma unroll
  for (int kblk = 0; kblk < 4; ++kblk) {
#pragma unroll
    for (int r = 0; r < 16; ++r) C[kblk][r] *= a;
    float nsum = 0.f;
#pragma unroll
    for (int sblk = 0; sblk < 2; ++sblk) {
      f32x16_t X;
#pragma unroll
      for (int r = 0; r < 16; ++r) X[r] = 0.f;
      X = MFMA32(ld_nat(Kb[sblk] + 32 * kblk + 8 * hi), I0, X);
      X = MFMA32(ld_nat(Kb[sblk] + 32 * kblk + 16 + 8 * hi), I1, X);
#pragma unroll
      for (int r = 0; r < 16; ++r) { X[r] *= L.Tw2[crow(r, hi) + 32 * sblk]; nsum += X[r]; }
      C[kblk] = MFMA32(acc_frag(X, 0), ld_perm(L.vt + r32 * VT_LD + 32 * sblk, hi), C[kblk]);
      C[kblk] = MFMA32(acc_frag(X, 1), ld_perm(L.vt + r32 * VT_LD + 32 * sblk + 16, hi), C[kblk]);
    }
    nsum += __shfl_xor(nsum, 32);
    nk[kblk] = a * nk[kblk] + nsum;
  }
  m = blast + mm63; bsum += blast;
  WAVE_LDS_SYNC();
  if (FULL && hi == 0) {
#pragma unroll
    for (int kblk = 0; kblk < 4; ++kblk) L.Tn[kblk * 32 + r32] = nk[kblk];
  }
  WAVE_LDS_SYNC();
}
template <int PASS> __device__ __forceinline__ void mlstm_pass(const Params& p, unsigned char* lds) {
  const int lane = threadIdx.x & 63, wid = UNIFORM((int)(threadIdx.x >> 6)), r32 = lane & 31, hi = lane >> 5;
  WaveLds& L = *reinterpret_cast<WaveLds*>(lds + (size_t)wid * sizeof(WaveLds));
  const int nwaves = (int)gridDim.x * (NTHREADS / 64);
#pragma unroll 1
  for (int item = (int)blockIdx.x * (NTHREADS / 64) + wid; item < NB * ML_H * 2 * 4 * NSEG; item += nwaves) {
    const int seg = item % NSEG, vs = (item / NSEG) % 4, dir = (item / (NSEG * 4)) % 2, h = (item / (NSEG * 8)) % ML_H, b = item / (NSEG * 8 * ML_H);
    if (PASS == 1 && seg == NSEG - 1) continue;
    int c0, nc; seg_range(seg, c0, nc);
    f32x16_t C[4]; float nk[4] = {0.f, 0.f, 0.f, 0.f}; float m = (PASS == 1) ? -1e30f : 0.f, bsum = 0.f;
#pragma unroll
    for (int k = 0; k < 4; ++k)
#pragma unroll
      for (int r = 0; r < 16; ++r) C[k][r] = 0.f;
    float* stbase = p.scanst + (size_t)(item / NSEG) * (NSEG - 1) * ST_STRIDE;
    if (PASS == 2) {
#pragma unroll 1
      for (int j = 0; j < seg; ++j) {
        const float* st = stbase + (size_t)j * ST_STRIDE;
        const float m2 = st[4096 + 128], B2 = st[4096 + 129];
        const float mn = fmaxf(B2 + m, m2), fa = fast_exp(B2 + m - mn), fb = fast_exp(m2 - mn);
#pragma unroll
        for (int k = 0; k < 4; ++k) {
#pragma unroll
          for (int r = 0; r < 16; ++r) C[k][r] = fa * C[k][r] + fb * st[(k * 16 + r) * 64 + lane];
          nk[k] = fa * nk[k] + fb * st[4096 + k * 32 + r32]; }
        m = mn;
      }
      if (hi == 0) {
#pragma unroll
        for (int k = 0; k < 4; ++k) L.Tn[k * 32 + r32] = nk[k]; }
      WAVE_LDS_SYNC();
    }
#pragma unroll 1
    for (int ci = 0; ci < nc; ++ci) mlstm_chunk<PASS == 2>(p, L, b, h, dir, vs, c0 + ci, C, nk, m, bsum, lane);
    if (PASS == 1) {
      float* st = stbase + (size_t)seg * ST_STRIDE;
#pragma unroll
      for (int k = 0; k < 4; ++k) {
#pragma unroll
        for (int r = 0; r < 16; ++r) st[(k * 16 + r) * 64 + lane] = C[k][r];
        if (hi == 0) st[4096 + k * 32 + r32] = nk[k]; }
      if (lane == 0) { st[4096 + 128] = m; st[4096 + 129] = bsum; }
    }
  }
}
}


namespace scan {
constexpr int OFF_TILES = 8 * (int)sizeof(WaveLds);
struct Pre { bf16x8_t tq[4], tk[4], v[4]; float g0, g1; };
constexpr int MQ_LD = ML_D + 8;
constexpr int M_TILE = 64 * MQ_LD;
template <bool LIGHT>
__device__ __forceinline__ void mlstm_prefetch(const Params& p, Pre& R, const int b, const int h, const int dir, const int vs, const int pc, const int gt, const int lane) {
  const int tlo = dir ? seq_token(pc * 64 + 63, dir) : seq_token(pc * 64, dir);
  const size_t m0 = (size_t)b * TB + tlo;
  const bf16_t* qb = p.mqc + m0 * BRB + h * ML_D; const bf16_t* kb = p.mkc + m0 * BRB + h * ML_D;
#pragma unroll
  for (int i = 0; i < 4; ++i) { const int j = gt + 256 * i, row = j >> 4; const unsigned off = (unsigned)((dir ? 63 - row : row) * BRB + (j & 15) * 8); if (!LIGHT) R.tq[i] = ld_nat(qb + off); R.tk[i] = ld_nat(kb + off); }
  if (LIGHT) {
    const unsigned voff = (unsigned)((dir ? 63 - lane : lane) * LDP);
    const bf16_t* vr = p.Pb + m0 * LDP + P0_MV + h * ML_D + vs * 32 + voff;
#pragma unroll
    for (int c = 0; c < 4; ++c) R.v[c] = ld_nat(vr + c * 8);
    const bf16_t* pg = p.Pb + m0 * LDP + P0_G + dir * 2 * ML_H + h + voff;
    R.g0 = bf2f(pg[0]); R.g1 = bf2f(pg[ML_H]);
  }
}
template <bool LIGHT>
__device__ __forceinline__ void mlstm_tiles_to_lds(const Pre& R, bf16_t* Qt, bf16_t* Kt, const int gt) {
#pragma unroll
  for (int i = 0; i < 4; ++i) { const int j = gt + 256 * i, row = j >> 4, c16 = j & 15;
    if (!LIGHT) *reinterpret_cast<bf16x8_t*>(Qt + row * MQ_LD + c16 * 8) = R.tq[i]; *reinterpret_cast<bf16x8_t*>(Kt + row * MQ_LD + c16 * 8) = R.tk[i]; }
}
template <bool FULL>
__device__ __forceinline__ void mlstm_chunk2(const Params& p, WaveLds& L, const bf16_t* Qt, const bf16_t* Kt, Pre& R, const int b, const int h, const int dir, const int vs, const int pc, const int pc_next,
                                             f32x16_t (&C)[4], float (&nk)[4], float& m, float& bsum, const int gt_in, const int lane_in) {
  int lane = lane_in, gt = gt_in;
#ifndef HOST_TEST
  asm volatile("" : "+v"(lane), "+v"(gt));
#endif
  const int r32 = lane & 31, hi = lane >> 5;
  const int mrow_l = b * TB + seq_token(pc * 64 + lane, dir);
  const bf16_t* prow = p.Pb + (size_t)mrow_l * LDP;
  const float ig = (FULL ? bf2f(prow[P0_G + dir * 2 * ML_H + h]) : R.g0) + p.b_i[dir * ML_H + h];
  const float lf = log_sigmoid_f((FULL ? bf2f(prow[P0_G + dir * 2 * ML_H + ML_H + h]) : R.g1) + p.b_f[dir * ML_H + h]);
  { const bf16_t* vr = prow + P0_MV + h * ML_D + vs * 32;
#pragma unroll
    for (int c = 0; c < 4; ++c) { const bf16x8_t v8 = FULL ? ld_nat(vr + c * 8) : R.v[c];
#pragma unroll
      for (int e = 0; e < 8; ++e) L.vt[(c * 8 + e) * VT_LD + lane] = (bf16_t)v8[e]; } }
  if (!FULL && pc_next >= 0) mlstm_prefetch<true>(p, R, b, h, dir, vs, pc_next, gt, lane);
  const float bc = wave_psum(lf, lane), g = ig - bc, pm = wave_pmax(g, lane);
  const float pm63 = __shfl(pm, 63), blast = __shfl(bc, 63), mm63 = fmaxf(m, pm63);
  L.Tw2[lane] = fast_exp(g - mm63);
  MFMA_ASM_PAD();
  float qn = 0.f, expmt = 0.f;
  if (FULL) {
    const float mm = fmaxf(m, pm);
    L.Tg[lane] = g; L.Te2[lane] = fast_exp(m - mm); L.Trow[lane] = mrow_l; expmt = fast_exp(-(bc + mm));
    const bf16_t* qrow = Qt + lane * MQ_LD;
#pragma unroll 4
    for (int c = 0; c < 16; ++c) { const bf16x8_t q8 = ld_nat(qrow + c * 8);
#pragma unroll
      for (int e = 0; e < 8; ++e) qn += bf2f((bf16_t)q8[e]) * L.Tn[c * 8 + e]; }
  }
  WAVE_LDS_SYNC();
  if (FULL) {
    bf16_t* Hout = (dir ? p.Hb : p.Hf) + (size_t)(h * 4 + vs) * M * 32 + r32;
    const float mm_l = fmaxf(m, pm);
#pragma unroll
    for (int tblk = 0; tblk < 2; ++tblk) {
      asm volatile("" ::: "memory");
      f32x16_t A;
#pragma unroll
      for (int r = 0; r < 16; ++r) A[r] = 0.f;
      const int t = r32 + 32 * tblk; const float mm_t = __shfl(mm_l, t); float denl = 0.f;
      const bf16_t* Qb = Qt + (32 * tblk + r32) * MQ_LD;
#pragma unroll
      for (int kblk = 0; kblk < 4; ++kblk)
#pragma unroll
        for (int s2 = 0; s2 < 2; ++s2) A = MFMA32(ld_perm(Qb + 32 * kblk + 16 * s2, hi), acc_frag(C[kblk], s2), A);
#pragma unroll
      for (int r = 0; r < 16; ++r) A[r] *= L.Te2[crow(r, hi) + 32 * tblk];
#pragma unroll
      for (int sblk = 0; sblk <= tblk; ++sblk) {
        asm volatile("" ::: "memory");
        const bf16_t* Kb = Kt + (32 * sblk + r32) * MQ_LD;
        f32x16_t S;
#pragma unroll
        for (int r = 0; r < 16; ++r) S[r] = 0.f;
#pragma unroll
        for (int st = 0; st < 8; ++st) S = MFMA32(ld_nat(Kb + 16 * st + 8 * hi), ld_nat(Qb + 16 * st + 8 * hi), S);
#pragma unroll
        for (int r = 0; r < 16; ++r) { const int sidx = crow(r, hi) + 32 * sblk; const float w = fast_exp(L.Tg[sidx] - mm_t); const float pr = (sidx <= t) ? S[r] * w : 0.f; S[r] = pr; denl += pr; }
        const bf16x8_t pa0 = pk4_frag(S, 0), pa1 = pk4_frag(S, 8);
        A = MFMA32(pa0, ld_nat(L.vt + r32 * VT_LD + 32 * sblk + 8 * hi), A);
        A = MFMA32(pa1, ld_nat(L.vt + r32 * VT_LD + 32 * sblk + 16 + 8 * hi), A);
      }
      denl += __shfl_xor(denl, 32);
      if (hi == 0) L.Tden[t] = denl;
      WAVE_LDS_SYNC();
      if ((lane >> 5) == tblk) { const float den = L.Tden[lane] + L.Te2[lane] * qn; L.Tinv[lane] = 1.f / fmaxf(fabsf(den), expmt); }
      WAVE_LDS_SYNC();
#pragma unroll
      for (int r = 0; r < 16; ++r) { const int tt = crow(r, hi) + 32 * tblk; Hout[(size_t)L.Trow[tt] * 32] = f2bf(A[r] * L.Tinv[tt]); }
    }
  }
  asm volatile("" ::: "memory");
  if (FULL && pc_next >= 0) mlstm_prefetch<false>(p, R, b, h, dir, vs, pc_next, gt, lane);
  const float a = fast_exp(m - mm63);
  bf16x8_t I0, I1;
#pragma unroll
  for (int j = 0; j < 8; ++j) { I0[j] = (r32 == 8 * hi + j) ? (short)0x3F80 : (short)0; I1[j] = (r32 == 16 + 8 * hi + j) ? (short)0x3F80 : (short)0; }
#pragma unroll
  for (int kblk = 0; kblk < 4; ++kblk) {
    asm volatile("" ::: "memory");
#pragma unroll
    for (int r = 0; r < 16; ++r) C[kblk][r] *= a;
    float nsum = 0.f;
#pragma unroll
    for (int sblk = 0; sblk < 2; ++sblk) {
      const bf16_t* Kb = Kt + (32 * sblk + r32) * MQ_LD;
      f32x16_t X;
#pragma unroll
      for (int r = 0; r < 16; ++r) X[r] = 0.f;
      X = MFMA32(ld_nat(Kb + 32 * kblk + 8 * hi), I0, X);
      X = MFMA32(ld_nat(Kb + 32 * kblk + 16 + 8 * hi), I1, X);
#pragma unroll
      for (int r = 0; r < 16; ++r) { X[r] *= L.Tw2[crow(r, hi) + 32 * sblk]; nsum += X[r]; }
      C[kblk] = MFMA32(acc_frag(X, 0), ld_perm(L.vt + r32 * VT_LD + 32 * sblk, hi), C[kblk]);
      C[kblk] = MFMA32(acc_frag(X, 1), ld_perm(L.vt + r32 * VT_LD + 32 * sblk + 16, hi), C[kblk]);
    }
    nsum += __shfl_xor(nsum, 32);
    nk[kblk] = a * nk[kblk] + nsum;
  }
  m = blast + mm63; bsum += blast;
  WAVE_LDS_SYNC();
  if (FULL && hi == 0) {
#pragma unroll
    for (int kblk = 0; kblk < 4; ++kblk) L.Tn[kblk * 32 + r32] = nk[kblk];
  }
  WAVE_LDS_SYNC();
}
template <int PASS> __device__ __forceinline__ void mlstm_block(const Params& p, unsigned char* lds) {
  const int tid = threadIdx.x, lane = tid & 63, wid = UNIFORM(tid >> 6), r32 = lane & 31, hi = lane >> 5, grp = wid >> 2, vs = wid & 3, gt = tid & 255;
  WaveLds& L = *reinterpret_cast<WaveLds*>(lds + (size_t)wid * sizeof(WaveLds));
  bf16_t* Qt = reinterpret_cast<bf16_t*>(lds + OFF_TILES) + (size_t)grp * 2 * M_TILE; bf16_t* Kt = Qt + M_TILE;
  constexpr int NIT = NB * ML_H * 2 * NSEG;
#pragma unroll 1
  for (int pidx = (int)blockIdx.x; pidx < NIT / 2; pidx += (int)gridDim.x) {
    const int it = 2 * pidx + grp, seg = it % NSEG, dir = (it / NSEG) % 2, h = (it / (NSEG * 2)) % ML_H, b = it / (NSEG * 2 * ML_H);
    int c0, nc, c0b, ncb; seg_range(seg, c0, nc); seg_range((2 * pidx + (grp ^ 1)) % NSEG, c0b, ncb);
    if (PASS == 1 && seg == NSEG - 1) nc = 0;
    if (PASS == 1 && (2 * pidx + (grp ^ 1)) % NSEG == NSEG - 1) ncb = 0;
    const int ncmax = nc > ncb ? nc : ncb;
    f32x16_t C[4]; float nk[4] = {0.f, 0.f, 0.f, 0.f}; float m = (PASS == 1) ? -1e30f : 0.f, bsum = 0.f;
#pragma unroll
    for (int k = 0; k < 4; ++k)
#pragma unroll
      for (int r = 0; r < 16; ++r) C[k][r] = 0.f;
    float* stbase = p.scanst + (size_t)((((b * ML_H + h) * 2 + dir) * 4 + vs)) * (NSEG - 1) * ST_STRIDE;
    if (PASS == 2) {
#pragma unroll 1
      for (int j = 0; j < seg; ++j) {
        const float* st = stbase + (size_t)j * ST_STRIDE;
        const float m2 = st[4096 + 128], B2 = st[4096 + 129];
        const float mn = fmaxf(B2 + m, m2), fa = fast_exp(B2 + m - mn), fb = fast_exp(m2 - mn);
        const float* sp = st;
#pragma unroll
        for (int k = 0; k < 4; ++k) {
#pragma unroll
          for (int r = 0; r < 16; ++r) { C[k][r] = fa * C[k][r] + fb * sp[lane]; sp += 64; }
          nk[k] = fa * nk[k] + fb * st[4096 + k * 32 + r32]; }
        m = mn;
      }
      if (hi == 0) {
#pragma unroll
        for (int k = 0; k < 4; ++k) L.Tn[k * 32 + r32] = nk[k]; }
      WAVE_LDS_SYNC();
    }
    Pre R;
    if (nc > 0) { mlstm_prefetch<PASS == 1>(p, R, b, h, dir, vs, c0, gt, lane); mlstm_tiles_to_lds<PASS == 1>(R, Qt, Kt, gt); }
    __syncthreads();
#pragma unroll 1
    for (int ci = 0; ci < ncmax; ++ci) {
      const bool act = ci < nc, more = ci + 1 < nc;
      if (act) mlstm_chunk2<PASS == 2>(p, L, Qt, Kt, R, b, h, dir, vs, c0 + ci, more ? c0 + ci + 1 : -1, C, nk, m, bsum, gt, lane);
      __syncthreads();
      if (more) mlstm_tiles_to_lds<PASS == 1>(R, Qt, Kt, gt);
      __syncthreads();
    }
    if (PASS == 1 && nc > 0) {
      float* st = stbase + (size_t)seg * ST_STRIDE;
      float* sp = st;
#pragma unroll
      for (int k = 0; k < 4; ++k) {
#pragma unroll
        for (int r = 0; r < 16; ++r) { sp[lane] = C[k][r]; sp += 64; }
        if (hi == 0) st[4096 + k * 32 + r32] = nk[k]; }
      if (lane == 0) { st[4096 + 128] = m; st[4096 + 129] = bsum; }
    }
  }
}
}

namespace scan {
constexpr int GK = GLA_H * GLA_DK;
constexpr int NCH = TB / 64;
constexpr int GST_STRIDE = 2048 + 64 + 8;
static_assert(4 * GK <= LDA, "Q'|K' for both directions fit in the A1 region");
__device__ __forceinline__ bf16_t* gla_qp(const Params& p, int dir) { return p.A1 + (size_t)dir * M * GK; }
__device__ __forceinline__ bf16_t* gla_kp(const Params& p, int dir) { return p.A1 + (size_t)(2 + dir) * M * GK; }
__device__ __forceinline__ float* gla_ebl(const Params& p) { return p.scanst + (size_t)NB * GLA_H * 2 * 4 * (NSEG - 1) * GST_STRIDE; }
constexpr int PRE_WLDS = 2 * 64 * 64 * 2 + 64 * GRANK * 2;
__device__ __forceinline__ void gla_prepass(const Params& p, unsigned char* lds) {
  const int lane = threadIdx.x & 63, wid = UNIFORM((int)(threadIdx.x >> 6)), nwaves = (int)gridDim.x * (NTHREADS / 64);
  bf16_t* qt = reinterpret_cast<bf16_t*>(lds + (size_t)wid * PRE_WLDS); bf16_t* kt = qt + 64 * 64; bf16_t* gat = kt + 64 * 64;
#pragma unroll 1
  for (int item = (int)blockIdx.x * (NTHREADS / 64) + wid; item < NB * 2 * NCH * GLA_H; item += nwaves) {
    const int h = item % GLA_H, pc = (item / GLA_H) % NCH, dir = (item / (GLA_H * NCH)) % 2, b = item / (GLA_H * NCH * 2);
    const size_t m = (size_t)b * TB + seq_token(pc * 64 + lane, dir);
    const bf16_t* prow = p.Pb + m * LDP;
    { bf16x8_t qv[8], kv[8];
#pragma unroll
      for (int c = 0; c < 8; ++c) { qv[c] = ld_nat(prow + P1_GQ + h * GLA_DK + c * 8); kv[c] = ld_nat(prow + P1_GK + h * GLA_DK + c * 8); }
      const bf16x8_t g0 = ld_nat(prow + P1_GA + dir * GRANK), g1 = ld_nat(prow + P1_GA + dir * GRANK + 8);
#pragma unroll
      for (int c = 0; c < 8; ++c) { *reinterpret_cast<bf16x8_t*>(qt + lane * 64 + c * 8) = qv[c]; *reinterpret_cast<bf16x8_t*>(kt + lane * 64 + c * 8) = kv[c]; }
      *reinterpret_cast<bf16x8_t*>(gat + lane * GRANK) = g0; *reinterpret_cast<bf16x8_t*>(gat + lane * GRANK + 8) = g1; }
    float wg[GRANK];
#pragma unroll
    for (int r = 0; r < GRANK; ++r) wg[r] = p.w_gate[((size_t)dir * GRANK + r) * GK + h * GLA_DK + lane];
    const float bg = p.b_gate[dir * GK + h * GLA_DK + lane];
    WAVE_LDS_SYNC();
    float bc = 0.f;
#pragma unroll 4
    for (int i = 0; i < 64; ++i) {
      const bf16x8_t g0 = *reinterpret_cast<const bf16x8_t*>(gat + i * GRANK), g1 = *reinterpret_cast<const bf16x8_t*>(gat + i * GRANK + 8);
      float gp = bg;
#pragma unroll
      for (int r = 0; r < 8; ++r) gp += bf2f((bf16_t)g0[r]) * wg[r] + bf2f((bf16_t)g1[r]) * wg[8 + r];
      bc += (fminf(gp, 0.f) - fast_log(1.f + fast_exp(-fabsf(gp)))) * (1.f / 16.f);
      const float q = bf2f(qt[i * 64 + lane]) * 0.125f, k = bf2f(kt[i * 64 + lane]);
      qt[i * 64 + lane] = f2bf(q * fast_exp(bc)); kt[i * 64 + lane] = f2bf(k * fast_exp(-bc));
    }
    gla_ebl(p)[(((size_t)dir * NB + b) * NCH + pc) * GK + h * GLA_DK + lane] = fast_exp(bc);
    WAVE_LDS_SYNC();
    bf16_t* Qo = gla_qp(p, dir) + m * GK + h * GLA_DK; bf16_t* Ko = gla_kp(p, dir) + m * GK + h * GLA_DK;
#pragma unroll
    for (int c = 0; c < 8; ++c) { *reinterpret_cast<bf16x8_t*>(Qo + c * 8) = *reinterpret_cast<const bf16x8_t*>(qt + lane * 64 + c * 8);
      *reinterpret_cast<bf16x8_t*>(Ko + c * 8) = *reinterpret_cast<const bf16x8_t*>(kt + lane * 64 + c * 8); }
    WAVE_LDS_SYNC();
  }
}
template <bool FULL>
__device__ __forceinline__ void gla_chunk(const Params& p, WaveLds& L, const int b, const int h, const int dir, const int vs, const int pc, f32x16_t (&S)[2], float (&dprod)[2], const int lane) {
  const int r32 = lane & 31, hi = lane >> 5;
  const int tok_l = seq_token(pc * 64 + lane, dir), mrow_l = b * TB + tok_l;
  const int mr[2] = {b * TB + seq_token(pc * 64 + r32, dir), b * TB + seq_token(pc * 64 + 32 + r32, dir)};
  const bf16_t* Kb[2] = {gla_kp(p, dir) + (size_t)mr[0] * GK + h * GLA_DK, gla_kp(p, dir) + (size_t)mr[1] * GK + h * GLA_DK};
  const bf16_t* Qb[2] = {gla_qp(p, dir) + (size_t)mr[0] * GK + h * GLA_DK, gla_qp(p, dir) + (size_t)mr[1] * GK + h * GLA_DK};
  const float* eb = gla_ebl(p) + (((size_t)dir * NB + b) * NCH + pc) * GK + h * GLA_DK;
  { const bf16_t* vr = p.Pb + (size_t)mrow_l * LDP + P1_GV + h * GLA_DV + vs * 32;
#pragma unroll
    for (int c = 0; c < 4; ++c) { const bf16x8_t v8 = ld_nat(vr + c * 8);
#pragma unroll
      for (int e = 0; e < 8; ++e) L.vt[(c * 8 + e) * VT_LD + lane] = (bf16_t)v8[e]; } }
  L.Tg[lane] = eb[lane];
  MFMA_ASM_PAD();
  const bool emit = FULL && pc >= CTX / 64;
  if (emit) L.Trow[lane] = b * SEQ + (tok_l - CTX);
  WAVE_LDS_SYNC();
  if (emit) {
    bf16_t* Oout = (dir ? p.Hb : p.Hf) + (size_t)(h * 4 + vs) * MLAT * 32 + r32;
#pragma unroll
    for (int tblk = 0; tblk < 2; ++tblk) {
      f32x16_t O;
#pragma unroll
      for (int r = 0; r < 16; ++r) O[r] = 0.f;
      const int t = r32 + 32 * tblk;
#pragma unroll
      for (int sblk = 0; sblk <= tblk; ++sblk) {
        f32x16_t P;
#pragma unroll
        for (int r = 0; r < 16; ++r) P[r] = 0.f;
#pragma unroll
        for (int st = 0; st < 4; ++st) P = MFMA32(ld_nat(Kb[sblk] + 16 * st + 8 * hi), ld_nat(Qb[tblk] + 16 * st + 8 * hi), P);
#pragma unroll
        for (int r = 0; r < 16; ++r) { const int sidx = crow(r, hi) + 32 * sblk; P[r] = (sidx <= t) ? P[r] : 0.f; }
        MFMA_ASM_PAD();
        const bf16x8_t pa0 = pk4_frag(P, 0), pa1 = pk4_frag(P, 8);
        O = MFMA32(pa0, ld_nat(L.vt + r32 * VT_LD + 32 * sblk + 8 * hi), O);
        O = MFMA32(pa1, ld_nat(L.vt + r32 * VT_LD + 32 * sblk + 16 + 8 * hi), O);
      }
#pragma unroll
      for (int kblk = 0; kblk < 2; ++kblk)
#pragma unroll
        for (int s2 = 0; s2 < 2; ++s2) O = MFMA32(ld_perm(Qb[tblk] + 32 * kblk + 16 * s2, hi), acc_frag(S[kblk], s2), O);
#pragma unroll
      for (int r = 0; r < 16; ++r) Oout[(size_t)L.Trow[crow(r, hi) + 32 * tblk] * 32] = f2bf(O[r]);
    }
  }
  bf16x8_t I0, I1;
#pragma unroll
  for (int j = 0; j < 8; ++j) { I0[j] = (r32 == 8 * hi + j) ? (short)0x3F80 : (short)0; I1[j] = (r32 == 16 + 8 * hi + j) ? (short)0x3F80 : (short)0; }
#pragma unroll
  for (int kblk = 0; kblk < 2; ++kblk) {
    const float ek = eb[32 * kblk + r32];
#pragma unroll
    for (int r = 0; r < 16; ++r) S[kblk][r] *= L.Tg[crow(r, hi) + 32 * kblk];
#pragma unroll
    for (int sblk = 0; sblk < 2; ++sblk) {
      f32x16_t X;
#pragma unroll
      for (int r = 0; r < 16; ++r) X[r] = 0.f;
      X = MFMA32(ld_nat(Kb[sblk] + 32 * kblk + 8 * hi), I0, X);
      X = MFMA32(ld_nat(Kb[sblk] + 32 * kblk + 16 + 8 * hi), I1, X);
#pragma unroll
      for (int r = 0; r < 16; ++r) X[r] *= ek;
      S[kblk] = MFMA32(acc_frag(X, 0), ld_perm(L.vt + r32 * VT_LD + 32 * sblk, hi), S[kblk]);
      S[kblk] = MFMA32(acc_frag(X, 1), ld_perm(L.vt + r32 * VT_LD + 32 * sblk + 16, hi), S[kblk]);
    }
    dprod[kblk] *= ek;
  }
  WAVE_LDS_SYNC();
}
template <int PASS> __device__ __forceinline__ void gla_pass(const Params& p, unsigned char* lds) {
  const int lane = threadIdx.x & 63, wid = UNIFORM((int)(threadIdx.x >> 6)), r32 = lane & 31, hi = lane >> 5;
  WaveLds& L = *reinterpret_cast<WaveLds*>(lds + (size_t)wid * sizeof(WaveLds));
  const int nwaves = (int)gridDim.x * (NTHREADS / 64);
#pragma unroll 1
  for (int item = (int)blockIdx.x * (NTHREADS / 64) + wid; item < NB * GLA_H * 2 * 4 * NSEG; item += nwaves) {
    const int seg = item % NSEG, vs = (item / NSEG) % 4, dir = (item / (NSEG * 4)) % 2, h = (item / (NSEG * 8)) % GLA_H, b = item / (NSEG * 8 * GLA_H);
    if (PASS == 1 && seg == NSEG - 1) continue;
    int c0, nc; seg_range(seg, c0, nc);
    f32x16_t S[2]; float dprod[2] = {1.f, 1.f};
#pragma unroll
    for (int k = 0; k < 2; ++k)
#pragma unroll
      for (int r = 0; r < 16; ++r) S[k][r] = 0.f;
    float* stbase = p.scanst + (size_t)(item / NSEG) * (NSEG - 1) * GST_STRIDE;
    if (PASS == 2) {
#pragma unroll 1
      for (int j = 0; j < seg; ++j) { const float* st = stbase + (size_t)j * GST_STRIDE;
#pragma unroll
        for (int k = 0; k < 2; ++k)
#pragma unroll
          for (int r = 0; r < 16; ++r) S[k][r] = st[2048 + 32 * k + crow(r, hi)] * S[k][r] + st[(k * 16 + r) * 64 + lane]; }
    }
#pragma unroll 1
    for (int ci = 0; ci < nc; ++ci) gla_chunk<PASS == 2>(p, L, b, h, dir, vs, c0 + ci, S, dprod, lane);
    if (PASS == 1) { float* st = stbase + (size_t)seg * GST_STRIDE;
#pragma unroll
      for (int k = 0; k < 2; ++k) {
#pragma unroll
        for (int r = 0; r < 16; ++r) st[(k * 16 + r) * 64 + lane] = S[k][r];
        if (hi == 0) st[2048 + 32 * k + r32] = dprod[k]; } }
  }
}
}


namespace scan {
constexpr int GQ_LD = GLA_DK + 8;
constexpr int G_TILE = 64 * GQ_LD;
struct GPre { bf16x8_t tq[2], tk[2]; };
__device__ __forceinline__ void gla_prefetch(const Params& p, GPre& R, const int b, const int h, const int dir, const int pc, const int gt) {
  const int tlo = dir ? seq_token(pc * 64 + 63, dir) : seq_token(pc * 64, dir);
  const size_t m0 = (size_t)b * TB + tlo;
  const bf16_t* qb = gla_qp(p, dir) + m0 * GK + h * GLA_DK; const bf16_t* kb = gla_kp(p, dir) + m0 * GK + h * GLA_DK;
#pragma unroll
  for (int i = 0; i < 2; ++i) { const int j = gt + 256 * i, row = j >> 3; const unsigned off = (unsigned)((dir ? 63 - row : row) * GK + (j & 7) * 8); R.tq[i] = ld_nat(qb + off); R.tk[i] = ld_nat(kb + off); }
}
__device__ __forceinline__ void gla_tiles_to_lds(const GPre& R, bf16_t* Qt, bf16_t* Kt, const int gt) {
#pragma unroll
  for (int i = 0; i < 2; ++i) { const int j = gt + 256 * i, row = j >> 3, c8 = j & 7;
    *reinterpret_cast<bf16x8_t*>(Qt + row * GQ_LD + c8 * 8) = R.tq[i]; *reinterpret_cast<bf16x8_t*>(Kt + row * GQ_LD + c8 * 8) = R.tk[i]; }
}
template <bool FULL>
__device__ __forceinline__ void gla_chunk2(const Params& p, WaveLds& L, const bf16_t* Qt, const bf16_t* Kt, GPre& R, const int b, const int h, const int dir, const int vs, const int pc, const int pc_next,
                                           f32x16_t (&S)[2], float (&dprod)[2], const int gt, const int lane) {
  const int r32 = lane & 31, hi = lane >> 5;
  const int tok_l = seq_token(pc * 64 + lane, dir), mrow_l = b * TB + tok_l;
  const float* eb = gla_ebl(p) + (((size_t)dir * NB + b) * NCH + pc) * GK + h * GLA_DK;
  { const bf16_t* vr = p.Pb + (size_t)mrow_l * LDP + P1_GV + h * GLA_DV + vs * 32;
#pragma unroll
    for (int c = 0; c < 4; ++c) { const bf16x8_t v8 = ld_nat(vr + c * 8);
#pragma unroll
      for (int e = 0; e < 8; ++e) L.vt[(c * 8 + e) * VT_LD + lane] = (bf16_t)v8[e]; } }
  L.Tg[lane] = eb[lane];
  MFMA_ASM_PAD();
  const bool emit = FULL && pc >= CTX / 64;
  if (emit) L.Trow[lane] = b * SEQ + (tok_l - CTX);
  WAVE_LDS_SYNC();
  if (emit) {
    bf16_t* Oout = (dir ? p.Hb : p.Hf) + (size_t)(h * 4 + vs) * MLAT * 32 + r32;
#pragma unroll
    for (int tblk = 0; tblk < 2; ++tblk) {
      f32x16_t O;
#pragma unroll
      for (int r = 0; r < 16; ++r) O[r] = 0.f;
      const int t = r32 + 32 * tblk;
      const bf16_t* Qb = Qt + (32 * tblk + r32) * GQ_LD;
#pragma unroll
      for (int sblk = 0; sblk <= tblk; ++sblk) {
        const bf16_t* Kb = Kt + (32 * sblk + r32) * GQ_LD;
        f32x16_t P;
#pragma unroll
        for (int r = 0; r < 16; ++r) P[r] = 0.f;
#pragma unroll
        for (int st = 0; st < 4; ++st) P = MFMA32(ld_nat(Kb + 16 * st + 8 * hi), ld_nat(Qb + 16 * st + 8 * hi), P);
#pragma unroll
        for (int r = 0; r < 16; ++r) { const int sidx = crow(r, hi) + 32 * sblk; P[r] = (sidx <= t) ? P[r] : 0.f; }
        MFMA_ASM_PAD();
        const bf16x8_t pa0 = pk4_frag(P, 0), pa1 = pk4_frag(P, 8);
        O = MFMA32(pa0, ld_nat(L.vt + r32 * VT_LD + 32 * sblk + 8 * hi), O);
        O = MFMA32(pa1, ld_nat(L.vt + r32 * VT_LD + 32 * sblk + 16 + 8 * hi), O);
      }
#pragma unroll
      for (int kblk = 0; kblk < 2; ++kblk)
#pragma unroll
        for (int s2 = 0; s2 < 2; ++s2) O = MFMA32(ld_perm(Qb + 32 * kblk + 16 * s2, hi), acc_frag(S[kblk], s2), O);
#pragma unroll
      for (int r = 0; r < 16; ++r) Oout[(size_t)L.Trow[crow(r, hi) + 32 * tblk] * 32] = f2bf(O[r]);
    }
  }
  if (pc_next >= 0) gla_prefetch(p, R, b, h, dir, pc_next, gt);
  bf16x8_t I0, I1;
#pragma unroll
  for (int j = 0; j < 8; ++j) { I0[j] = (r32 == 8 * hi + j) ? (short)0x3F80 : (short)0; I1[j] = (r32 == 16 + 8 * hi + j) ? (short)0x3F80 : (short)0; }
#pragma unroll
  for (int kblk = 0; kblk < 2; ++kblk) {
    const float ek = eb[32 * kblk + r32];
#pragma unroll
    for (int r = 0; r < 16; ++r) S[kblk][r] *= L.Tg[crow(r, hi) + 32 * kblk];
#pragma unroll
    for (int sblk = 0; sblk < 2; ++sblk) {
      const bf16_t* Kb = Kt + (32 * sblk + r32) * GQ_LD;
      f32x16_t X;
#pragma unroll
      for (int r = 0; r < 16; ++r) X[r] = 0.f;
      X = MFMA32(ld_nat(Kb + 32 * kblk + 8 * hi), I0, X);
      X = MFMA32(ld_nat(Kb + 32 * kblk + 16 + 8 * hi), I1, X);
#pragma unroll
      for (int r = 0; r < 16; ++r) X[r] *= ek;
      S[kblk] = MFMA32(acc_frag(X, 0), ld_perm(L.vt + r32 * VT_LD + 32 * sblk, hi), S[kblk]);
      S[kblk] = MFMA32(acc_frag(X, 1), ld_perm(L.vt + r32 * VT_LD + 32 * sblk + 16, hi), S[kblk]);
    }
    dprod[kblk] *= ek;
  }
  WAVE_LDS_SYNC();
}
template <int PASS> __device__ __forceinline__ void gla_block(const Params& p, unsigned char* lds) {
  const int tid = threadIdx.x, lane = tid & 63, wid = UNIFORM(tid >> 6), r32 = lane & 31, hi = lane >> 5, grp = wid >> 2, vs = wid & 3, gt = tid & 255;
  WaveLds& L = *reinterpret_cast<WaveLds*>(lds + (size_t)wid * sizeof(WaveLds));
  bf16_t* Qt = reinterpret_cast<bf16_t*>(lds + OFF_TILES) + (size_t)grp * 2 * G_TILE; bf16_t* Kt = Qt + G_TILE;
  constexpr int NIT = NB * GLA_H * 2 * NSEG;
#pragma unroll 1
  for (int pidx = (int)blockIdx.x; pidx < NIT / 2; pidx += (int)gridDim.x) {
    const int it = 2 * pidx + grp, seg = it % NSEG, dir = (it / NSEG) % 2, h = (it / (NSEG * 2)) % GLA_H, b = it / (NSEG * 2 * GLA_H);
    int c0, nc, c0b, ncb; seg_range(seg, c0, nc); seg_range((2 * pidx + (grp ^ 1)) % NSEG, c0b, ncb);
    if (PASS == 1 && seg == NSEG - 1) nc = 0;
    if (PASS == 1 && (2 * pidx + (grp ^ 1)) % NSEG == NSEG - 1) ncb = 0;
    const int ncmax = nc > ncb ? nc : ncb;
    f32x16_t S[2]; float dprod[2] = {1.f, 1.f};
#pragma unroll
    for (int k = 0; k < 2; ++k)
#pragma unroll
      for (int r = 0; r < 16; ++r) S[k][r] = 0.f;
    float* stbase = p.scanst + (size_t)((((b * GLA_H + h) * 2 + dir) * 4 + vs)) * (NSEG - 1) * GST_STRIDE;
    if (PASS == 2) {
#pragma unroll 1
      for (int j = 0; j < seg; ++j) { const float* st = stbase + (size_t)j * GST_STRIDE; const float* sp = st;
#pragma unroll
        for (int k = 0; k < 2; ++k)
#pragma unroll
          for (int r = 0; r < 16; ++r) { S[k][r] = st[2048 + 32 * k + crow(r, hi)] * S[k][r] + sp[lane]; sp += 64; } }
    }
    GPre R;
    if (nc > 0) { gla_prefetch(p, R, b, h, dir, c0, gt); gla_tiles_to_lds(R, Qt, Kt, gt); }
    __syncthreads();
#pragma unroll 1
    for (int ci = 0; ci < ncmax; ++ci) {
      const bool act = ci < nc, more = ci + 1 < nc;
      if (act) gla_chunk2<PASS == 2>(p, L, Qt, Kt, R, b, h, dir, vs, c0 + ci, more ? c0 + ci + 1 : -1, S, dprod, gt, lane);
      __syncthreads();
      if (more) gla_tiles_to_lds(R, Qt, Kt, gt);
      __syncthreads();
    }
    if (PASS == 1 && nc > 0) { float* st = stbase + (size_t)seg * GST_STRIDE; float* sp = st;
#pragma unroll
      for (int k = 0; k < 2; ++k) {
#pragma unroll
        for (int r = 0; r < 16; ++r) { sp[lane] = S[k][r]; sp += 64; }
        if (hi == 0) st[2048 + 32 * k + r32] = dprod[k]; } }
  }
}
}

namespace na {
constexpr int VP = 144, WLDS = 64 * VP;
static_assert(NA_D == 64 && NA_KW == 16 && NA_KH == 8 && CTX % 64 == 0, "NA geometry");
__device__ __forceinline__ unsigned char* wave_lds(unsigned char* lds, int wid) { return lds + (size_t)wid * WLDS; }
template <int GRP> __device__ __forceinline__ void pv_group(f32x4_t (&O)[4], const int vb, const bf16x8_t pf) {
  const s16x4_t a0 = TR_READ(vb, GRP * 32 * VP + 0), b0 = TR_READ(vb, GRP * 32 * VP + 4 * VP + 0), a1 = TR_READ(vb, GRP * 32 * VP + 32), b1 = TR_READ(vb, GRP * 32 * VP + 4 * VP + 32);
  const s16x4_t a2 = TR_READ(vb, GRP * 32 * VP + 64), b2 = TR_READ(vb, GRP * 32 * VP + 4 * VP + 64), a3 = TR_READ(vb, GRP * 32 * VP + 96), b3 = TR_READ(vb, GRP * 32 * VP + 4 * VP + 96);
  LGKM_WAIT(); SBAR();
#define PKV(L, H) (bf16x8_t){L[0], L[1], L[2], L[3], H[0], H[1], H[2], H[3]}
  O[0] = MFMA16(pf, PKV(a0, b0), O[0]); O[1] = MFMA16(pf, PKV(a1, b1), O[1]); O[2] = MFMA16(pf, PKV(a2, b2), O[2]); O[3] = MFMA16(pf, PKV(a3, b3), O[3]);
#undef PKV
}
__device__ __forceinline__ bf16x8_t p_frag(const float (&pv)[8]) {
  u32x4_t w = {cvtpk(pv[0], pv[1]), cvtpk(pv[2], pv[3]), cvtpk(pv[4], pv[5]), cvtpk(pv[6], pv[7])}; return __builtin_bit_cast(bf16x8_t, w);
}
template <int PART>
__device__ __forceinline__ void na_part(const Params& p, unsigned char* wl, const bf16_t* __restrict__ Pbb, const int h, const int r, const int rs, const int cb, const int cs, const int qc, const int g0ctx,
                                        const bf16x8_t (&qf)[2], f32x4_t (&O)[4], float& mrun, float& lrun, const bool first, const int lane) {
  const int qi = lane & 15, g = lane >> 4;
  const int kap0 = 8 * (qi >> 2) + (qi & 3);
  float sv[8][8];
#pragma unroll
  for (int half = 0; half < 2; ++half) {
    bf16x8_t kf[4][2][2]; float bias[4][8];
#pragma unroll
    for (int q4 = 0; q4 < 4; ++q4) { const int gi = half * 4 + q4;
      const int tokbase = PART == 0 ? CTX + (rs + gi) * GW + cb : 32 * (g0ctx + gi);
#pragma unroll
      for (int T = 0; T < 2; ++T) { const bf16_t* kr = Pbb + (size_t)(tokbase + kap0 + 4 * T) * LDP + P1_NK + h * NA_D + 8 * g;
        kf[q4][T][0] = *reinterpret_cast<const bf16x8_t*>(kr); kf[q4][T][1] = *reinterpret_cast<const bf16x8_t*>(kr + 32);
#pragma unroll
        for (int e = 0; e < 4; ++e) { bias[q4][4 * T + e] = 0.f;
          if (PART == 0) { const int kcol = cb + 8 * g + 4 * T + e; const bool valid = kcol >= cs && kcol < cs + NA_KW;
            const int bi = (h * (2 * NA_KH - 1) + (rs + gi - r + NA_KH - 1)) * (2 * NA_KW - 1) + (valid ? kcol - qc + NA_KW - 1 : 0);
            bias[q4][4 * T + e] = valid ? p.rpb[bi] : -1e30f; } } } }
#pragma unroll
    for (int q4 = 0; q4 < 4; ++q4) { const int gi = half * 4 + q4;
#pragma unroll
      for (int T = 0; T < 2; ++T) {
        f32x4_t acc = {0.f, 0.f, 0.f, 0.f};
        acc = MFMA16(kf[q4][T][0], qf[0], acc); acc = MFMA16(kf[q4][T][1], qf[1], acc);
#pragma unroll
        for (int e = 0; e < 4; ++e) { const float sc = acc[e] * 0.125f; sv[gi][4 * T + e] = (PART == 0) ? (bias[q4][4 * T + e] < -1e29f ? -1e30f : sc + bias[q4][4 * T + e]) : sc; }
      } }
  }
  float mx = sv[0][0];
#pragma unroll
  for (int gi = 0; gi < 8; ++gi)
#pragma unroll
    for (int e = 0; e < 8; ++e) mx = fmaxf(mx, sv[gi][e]);
  mx = fmaxf(mx, __shfl_xor(mx, 16)); mx = fmaxf(mx, __shfl_xor(mx, 32));
  const float mn = first ? mx : fmaxf(mrun, mx), alpha = first ? 0.f : fast_exp(mrun - mn);
  float ls = 0.f;
#pragma unroll
  for (int gi = 0; gi < 8; ++gi)
#pragma unroll
    for (int e = 0; e < 8; ++e) { const float pe = fast_exp(sv[gi][e] - mn); sv[gi][e] = pe; ls += pe; }
  ls += __shfl_xor(ls, 16); ls += __shfl_xor(ls, 32);
  lrun = lrun * alpha + ls; mrun = mn;
  if (!first) {
#pragma unroll
    for (int e = 0; e < 4; ++e) { const float f = __shfl(alpha, 4 * g + e);
#pragma unroll
      for (int dt = 0; dt < 4; ++dt) O[dt][e] *= f; }
  }
  const int vb = LDS_ADDR(wl) + (8 * g + (qi >> 2)) * VP + 8 * (qi & 3);
#pragma unroll
  for (int c = 0; c < 4; ++c) {
#pragma unroll
    for (int it = 0; it < 8; ++it) { const int row = it * 8 + (lane >> 3), grp = row >> 5, kk = row & 31;
      const int tok = PART == 0 ? CTX + (rs + 2 * c + grp) * GW + cb + kk : 32 * (g0ctx + 2 * c + grp) + kk;
      *reinterpret_cast<u32x4_t*>(wl + row * VP + (lane & 7) * 16) = *reinterpret_cast<const u32x4_t*>(Pbb + (size_t)tok * LDP + P1_NV + h * NA_D + (lane & 7) * 8); }
    WAVE_LDS_SYNC();
    pv_group<0>(O, vb, p_frag(sv[2 * c]));
    pv_group<1>(O, vb, p_frag(sv[2 * c + 1]));
    WAVE_LDS_SYNC();
  }
}
__device__ __forceinline__ void fp_na(const Params& p, unsigned char* lds) {
  const int lane = threadIdx.x & 63, wid = UNIFORM((int)(threadIdx.x >> 6)), qi = lane & 15, g = lane >> 4;
  unsigned char* wl = wave_lds(lds, wid);
  const int nwaves = (int)gridDim.x * (NTHREADS / 64);
#pragma unroll 1
  for (int item = (int)blockIdx.x * (NTHREADS / 64) + wid; item < NB * NA_H * GROWS * 4; item += nwaves) {
    const int cg = item & 3, r = (item >> 2) % GROWS, h = (item / (4 * GROWS)) % NA_H, b = item / (4 * GROWS * NA_H);
    const int qc = cg * 16 + qi;
    int rs = r - NA_KH / 2; rs = rs < 0 ? 0 : (rs > GROWS - NA_KH ? GROWS - NA_KH : rs);
    int cb = cg * 16 - 8; cb = cb < 0 ? 0 : (cb > GW - 32 ? GW - 32 : cb);
    int cs = qc - NA_KW / 2; cs = cs < 0 ? 0 : (cs > GW - NA_KW ? GW - NA_KW : cs);
    const bf16_t* Pbb = p.Pb + (size_t)b * TB * LDP;
    const size_t tq = (size_t)CTX + r * GW + qc;
    bf16x8_t qf[2];
    qf[0] = *reinterpret_cast<const bf16x8_t*>(Pbb + tq * LDP + P1_NQ + h * NA_D + 8 * g);
    qf[1] = *reinterpret_cast<const bf16x8_t*>(Pbb + tq * LDP + P1_NQ + h * NA_D + 32 + 8 * g);
    f32x4_t O[4];
#pragma unroll
    for (int dt = 0; dt < 4; ++dt) O[dt] = (f32x4_t){0.f, 0.f, 0.f, 0.f};
    float mrun = -1e30f, lrun = 0.f;
    na_part<0>(p, wl, Pbb, h, r, rs, cb, cs, qc, 0, qf, O, mrun, lrun, true, lane);
#pragma unroll 1
    for (int g0 = 0; g0 < CTX / 32; g0 += 8) na_part<1>(p, wl, Pbb, h, r, rs, cb, cs, qc, g0, qf, O, mrun, lrun, false, lane);
    const float invl = 1.f / lrun;
#pragma unroll
    for (int e = 0; e < 4; ++e) {
      const float f = __shfl(invl, 4 * g + e);
      const size_t tl = (size_t)r * GW + cg * 16 + 4 * g + e, ml = (size_t)b * SEQ + tl;
      const bf16_t* zr = Pbb + ((size_t)CTX + tl) * LDP + P1_Z + BRC + h * NA_D + qi;
      bf16_t* orow = p.A0 + ml * LDA + BRC + h * NA_D + qi;
#pragma unroll
      for (int dt = 0; dt < 4; ++dt) orow[dt * 16] = f2bf(O[dt][e] * f * silu_f(bf2f(zr[dt * 16])));
    }
  }
}
}


namespace na2 {
constexpr int VP = 144, ROWB = 64 * VP, STG = 2 * ROWB;
constexpr int OFF_K = 0, OFF_V = 2 * STG, OFF_RPB = 4 * STG, NRPB = (2 * NA_KH - 1) * (2 * NA_KW - 1), LDS_NA = OFF_RPB + NRPB * 4;
template <int NG>
__device__ __forceinline__ void na_step(const float* rpl, const unsigned char* Kst, const unsigned char* Vst, const bool local, const int cb, const int r, const int krow0, const bool act0, const bool act1,
                                        const int cs, const int qc, const bf16x8_t (&qf)[2], f32x4_t (&O)[4], float& mrun, float& lrun, const int lane) {
  const int qi = lane & 15, g = lane >> 4, kap0 = 8 * (qi >> 2) + (qi & 3);
  float sv[NG][8];
#pragma unroll
  for (int gg = 0; gg < NG; ++gg) {
    const int k0 = local ? 64 * gg + cb : 32 * gg;
    const bool act = !local || (gg == 0 ? act0 : act1);
#pragma unroll
    for (int T = 0; T < 2; ++T) {
      const unsigned char* kr = Kst + (k0 + kap0 + 4 * T) * VP + 16 * g;
      f32x4_t acc = {0.f, 0.f, 0.f, 0.f};
      acc = MFMA16(*reinterpret_cast<const bf16x8_t*>(kr), qf[0], acc);
      acc = MFMA16(*reinterpret_cast<const bf16x8_t*>(kr + 64), qf[1], acc);
#pragma unroll
      for (int e = 0; e < 4; ++e) {
        float sc = acc[e] * 0.125f;
        if (local) { const int kcol = cb + 8 * g + 4 * T + e; const bool valid = act && kcol >= cs && kcol < cs + NA_KW;
          const int bi = (krow0 + gg - r + NA_KH - 1) * (2 * NA_KW - 1) + (valid ? kcol - qc + NA_KW - 1 : 0);
          sc = valid ? sc + rpl[valid ? bi : 0] : -1e30f; }
        sv[gg][4 * T + e] = sc;
      }
    }
  }
  float mx = sv[0][0];
#pragma unroll
  for (int gg = 0; gg < NG; ++gg)
#pragma unroll
    for (int e = 0; e < 8; ++e) mx = fmaxf(mx, sv[gg][e]);
  if (__any(mx > mrun + 8.f)) {
    mx = fmaxf(mx, __shfl_xor(mx, 16)); mx = fmaxf(mx, __shfl_xor(mx, 32));
    const float mn = fmaxf(mrun, mx), alpha = fast_exp(mrun - mn);
    lrun *= alpha; mrun = mn;
#pragma unroll
    for (int e = 0; e < 4; ++e) { const float f = __shfl(alpha, 4 * g + e);
#pragma unroll
      for (int dt = 0; dt < 4; ++dt) O[dt][e] *= f; }
  }
  float ls = 0.f;
#pragma unroll
  for (int gg = 0; gg < NG; ++gg)
#pragma unroll
    for (int e = 0; e < 8; ++e) { const float pe = fast_exp(sv[gg][e] - mrun); sv[gg][e] = pe; ls += pe; }
  lrun += ls;
#pragma unroll
  for (int gg = 0; gg < NG; ++gg) {
    const int k0 = local ? 64 * gg + cb : 32 * gg;
    const int vb = LDS_ADDR(Vst) + (k0 + 8 * g + (qi >> 2)) * VP + 8 * (qi & 3);
    na::pv_group<0>(O, vb, na::p_frag(sv[gg]));
  }
}
__device__ __forceinline__ void fp_na2(const Params& p, unsigned char* lds) {
  const int tid = threadIdx.x, lane = tid & 63, wid = UNIFORM(tid >> 6), qi = lane & 15, g = lane >> 4;
  const int skk = tid >> 3, sc16 = tid & 7;
  constexpr int NU = NB * NA_H * (GROWS / 2), NCS = CTX / 128;
  static_assert(CTX % 128 == 0, "context keys are staged 128 at a time");
  float* rpl = reinterpret_cast<float*>(lds + OFF_RPB);
  static_assert(NRPB <= NTHREADS, "bias table staging");
#pragma unroll 1
  for (int u = (int)blockIdx.x; u < NU; u += (int)gridDim.x) {
    const int rp = u % (GROWS / 2), h = (u / (GROWS / 2)) % NA_H, b = u / ((GROWS / 2) * NA_H);
    const int r = 2 * rp + (wid >> 2), cg = wid & 3, qc = cg * 16 + qi;
    int rs = r - NA_KH / 2; rs = rs < 0 ? 0 : (rs > GROWS - NA_KH ? GROWS - NA_KH : rs);
    int rlo = 2 * rp - NA_KH / 2; rlo = rlo < 0 ? 0 : (rlo > GROWS - NA_KH ? GROWS - NA_KH : rlo);
    int rhi = 2 * rp + 1 - NA_KH / 2; rhi = (rhi < 0 ? 0 : (rhi > GROWS - NA_KH ? GROWS - NA_KH : rhi)) + NA_KH - 1;
    const int nloc = (rhi - rlo + 2) / 2, nsteps = nloc + NCS;
    int cb = cg * 16 - 8; cb = cb < 0 ? 0 : (cb > GW - 32 ? GW - 32 : cb);
    int cs = qc - NA_KW / 2; cs = cs < 0 ? 0 : (cs > GW - NA_KW ? GW - NA_KW : cs);
    const bf16_t* Pbb = p.Pb + (size_t)b * TB * LDP;
    const size_t tq = (size_t)CTX + r * GW + qc;
    bf16x8_t qf[2];
    qf[0] = *reinterpret_cast<const bf16x8_t*>(Pbb + tq * LDP + P1_NQ + h * NA_D + 8 * g);
    qf[1] = *reinterpret_cast<const bf16x8_t*>(Pbb + tq * LDP + P1_NQ + h * NA_D + 32 + 8 * g);
    f32x4_t O[4];
#pragma unroll
    for (int dt = 0; dt < 4; ++dt) O[dt] = (f32x4_t){0.f, 0.f, 0.f, 0.f};
    float mrun = -1e30f, lrun = 0.f;
    static_assert(CTX / 128 + (NA_KH + 2) / 2 <= 7, "NA step unroll");
    u32x4_t ka0, va0, kb0, vb0_, ka1, va1, kb1, vb1_, ka2, va2, kb2, vb2_, ka3, va3, kb3, vb3_;
#define NA_LOAD(R_, s_) do { const int sl_ = (s_) < nsteps ? (s_) : nsteps - 1; \
    const int rowA_ = rlo + 2 * sl_, rowB_ = rowA_ + 1 > rhi ? rhi : rowA_ + 1; \
    const int tokA_ = sl_ < nloc ? CTX + rowA_ * GW : 128 * (sl_ - nloc), tokB_ = sl_ < nloc ? CTX + rowB_ * GW : 128 * (sl_ - nloc) + 64; \
    const bf16_t* sa_ = Pbb + (size_t)(tokA_ + skk) * LDP + h * NA_D + sc16 * 8; const bf16_t* sb_ = Pbb + (size_t)(tokB_ + skk) * LDP + h * NA_D + sc16 * 8; \
    ka##R_ = *reinterpret_cast<const u32x4_t*>(sa_ + P1_NK); va##R_ = *reinterpret_cast<const u32x4_t*>(sa_ + P1_NV); \
    kb##R_ = *reinterpret_cast<const u32x4_t*>(sb_ + P1_NK); vb##R_##_ = *reinterpret_cast<const u32x4_t*>(sb_ + P1_NV); } while (0)
#define NA_STORE(R_, buf_) do { unsigned char* kd_ = lds + OFF_K + (buf_) * STG + skk * VP + sc16 * 16; unsigned char* vd_ = lds + OFF_V + (buf_) * STG + skk * VP + sc16 * 16; \
    *reinterpret_cast<u32x4_t*>(kd_) = ka##R_; *reinterpret_cast<u32x4_t*>(vd_) = va##R_; *reinterpret_cast<u32x4_t*>(kd_ + ROWB) = kb##R_; *reinterpret_cast<u32x4_t*>(vd_ + ROWB) = vb##R_##_; } while (0)
#define NA_COMPUTE(s_, buf_) do { const unsigned char* Kst = lds + OFF_K + (buf_) * STG; const unsigned char* Vst = lds + OFF_V + (buf_) * STG; \
    if ((s_) < nloc) { const int kr0_ = rlo + 2 * (s_); const bool a0_ = kr0_ >= rs && kr0_ < rs + NA_KH, a1_ = kr0_ + 1 <= rhi && kr0_ + 1 >= rs && kr0_ + 1 < rs + NA_KH; \
      if (a0_ || a1_) na_step<2>(rpl, Kst, Vst, true, cb, r, kr0_, a0_, a1_, cs, qc, qf, O, mrun, lrun, lane); } \
    else if ((s_) < nsteps) na_step<4>(rpl, Kst, Vst, false, 0, r, 0, true, true, cs, qc, qf, O, mrun, lrun, lane); } while (0)
#define NA_STEP(s_, cur_, nxt_, buf_, nbuf_) do { NA_LOAD(cur_, (s_) + 4); NA_COMPUTE(s_, buf_); NA_STORE(nxt_, nbuf_); __syncthreads(); } while (0)
    NA_LOAD(0, 0); NA_LOAD(1, 1); NA_LOAD(2, 2); NA_LOAD(3, 3);
    if (tid < NRPB) rpl[tid] = p.rpb[(size_t)h * NRPB + tid];
    NA_STORE(0, 0);
    __syncthreads();
    NA_STEP(0, 0, 1, 0, 1);
    NA_STEP(1, 1, 2, 1, 0);
    NA_STEP(2, 2, 3, 0, 1);
    NA_STEP(3, 3, 0, 1, 0);
    NA_STEP(4, 0, 1, 0, 1);
    NA_STEP(5, 1, 2, 1, 0);
    NA_STEP(6, 2, 3, 0, 1);
#undef NA_STEP
#undef NA_COMPUTE
#undef NA_LOAD
#undef NA_STORE
    lrun += __shfl_xor(lrun, 16); lrun += __shfl_xor(lrun, 32);
    const float invl = 1.f / lrun;
#pragma unroll
    for (int e = 0; e < 4; ++e) {
      const float f = __shfl(invl, 4 * g + e);
      const size_t tl = (size_t)r * GW + cg * 16 + 4 * g + e, ml = (size_t)b * SEQ + tl;
      const bf16_t* zr = Pbb + ((size_t)CTX + tl) * LDP + P1_Z + BRC + h * NA_D + qi;
      bf16_t* orow = p.A0 + ml * LDA + BRC + h * NA_D + qi;
#pragma unroll
      for (int dt = 0; dt < 4; ++dt) orow[dt * 16] = f2bf(O[dt][e] * f * silu_f(bf2f(zr[dt * 16])));
    }
  }
}
}

__device__ __forceinline__ void fp_conv(const Params& p) {
  constexpr int CH8 = 2 * BRB / 8;
  for (long idx = gtid(); idx < (long)M * CH8; idx += gsize()) {
    const int c8 = (int)(idx % CH8), m = (int)(idx / CH8), t = m % TB, j0 = c8 * 8;
    const int lo = t < CTX ? 0 : CTX, hi = t < CTX ? CTX : TB;
    float y[8];
#pragma unroll
    for (int e = 0; e < 8; ++e) y[e] = p.conv_b[j0 + e];
#pragma unroll
    for (int tap = 0; tap < 3; ++tap) { const int tt = t + tap - 1;
      if (tt >= lo && tt < hi) { const bf16x8_t v = *reinterpret_cast<const bf16x8_t*>(p.Pb + (size_t)(m + tap - 1) * LDP + P0_MQ + j0);
#pragma unroll
        for (int e = 0; e < 8; ++e) y[e] += bf2f((bf16_t)v[e]) * p.conv_w[tap * 2 * BRB + j0 + e]; } }
    const float sc = j0 < BRB ? 0.08838834764831845f : 1.f;
#pragma unroll
    for (int e = 0; e < 8; ++e) y[e] = silu_f(y[e]) * sc;
    u32x4_t o; o.x = pk2bf(y[0], y[1]); o.y = pk2bf(y[2], y[3]); o.z = pk2bf(y[4], y[5]); o.w = pk2bf(y[6], y[7]);
    bf16_t* dst = j0 < BRB ? p.mqc + (size_t)m * BRB + j0 : p.mkc + (size_t)m * BRB + (j0 - BRB);
    *reinterpret_cast<u32x4_t*>(dst) = o;
  }
}
template <int LAYER> __device__ __forceinline__ void fp_comb(const Params& p) {
  static_assert(BRB == 512 && BRC == 512, "fp_comb: 4 heads x 128 channels");
  const int lane = threadIdx.x & 63, gw = (int)(gtid() >> 6), ngw = (int)(gsize() >> 6), c0 = lane * 8;
  const int NR = LAYER == 0 ? M : MLAT;
  for (int row = gw; row < NR; row += ngw) {
    const size_t m = LAYER == 0 ? (size_t)row : ((size_t)(row / SEQ) * TB + CTX + (row % SEQ));
    const bf16x8_t a = *reinterpret_cast<const bf16x8_t*>(p.Hf + hoff(c0, (size_t)row, (size_t)NR)), b = *reinterpret_cast<const bf16x8_t*>(p.Hb + hoff(c0, (size_t)row, (size_t)NR));
    const bf16x8_t z8 = *reinterpret_cast<const bf16x8_t*>(p.Pb + m * LDP + (LAYER == 0 ? P0_Z + BRA : P1_Z) + c0);
    float g[8]; float ss = 0.f;
    if (LAYER == 0) { const bf16x8_t mo = *reinterpret_cast<const bf16x8_t*>(p.Pb + m * LDP + P0_MO + c0);
#pragma unroll
      for (int e = 0; e < 8; ++e) g[e] = sigmoid_f(bf2f((bf16_t)mo[e])) * (bf2f((bf16_t)a[e]) + bf2f((bf16_t)b[e])); }
    else {
#pragma unroll
      for (int e = 0; e < 8; ++e) g[e] = bf2f((bf16_t)a[e]) + bf2f((bf16_t)b[e]); }
#pragma unroll
    for (int e = 0; e < 8; ++e) ss += g[e] * g[e];
    ss += __shfl_xor(ss, 1); ss += __shfl_xor(ss, 2); ss += __shfl_xor(ss, 4); ss += __shfl_xor(ss, 8);
    const float rstd = rsqrtf(ss * (1.f / 128.f) + EPS);
    const float* gain = (LAYER == 0 ? p.h_norm : p.gla_norm) + c0;
    float o[8];
#pragma unroll
    for (int e = 0; e < 8; ++e) o[e] = g[e] * rstd * gain[e] * silu_f(bf2f((bf16_t)z8[e]));
    u32x4_t w; w.x = pk2bf(o[0], o[1]); w.y = pk2bf(o[2], o[3]); w.z = pk2bf(o[4], o[5]); w.w = pk2bf(o[6], o[7]);
    *reinterpret_cast<u32x4_t*>(p.A0 + (size_t)row * LDA + (LAYER == 0 ? BRA : 0) + c0) = w;
  }
}

#ifndef NA_PHASE
#define NA_PHASE 10
#endif
constexpr int NPHASE = 15;
constexpr int DMP = (DM + 255) / 256 * 256, QWP = (QW + 255) / 256 * 256, KVWP = (KVW + 255) / 256 * 256;
constexpr bool FAST_OK = (TB % 256 == 0) && (CTX == 256) && (DM % 128 == 0) && (DM >= 256) && (QR % 128 == 0) && (KVR % 128 == 0) && (CW0 % 128 == 0) && (CW1 % 128 == 0);
template <int ph> __device__ __forceinline__ void run_phase_t(const Params& p, unsigned char* lds) {
  switch (ph) {
    case 0:
      if (FAST_OK) {
        fp_wt<0>(p.l0_w_in, nullptr, p.Wt0, DM, N0, LDP); fp_wt<1>(p.l1_w_in, nullptr, p.Wt1, DM, N1, LDP);
        fp_wt<2>(p.l0_w_out, nullptr, p.Wo0, CW0, DM, DMP); fp_wt<2>(p.l1_w_out, nullptr, p.Wo1, CW1, DM, DMP);
        fp_wt<2>(p.w_uq, p.q_norm, p.Wq, QR, QW, QWP); fp_wt<2>(p.w_ukv, p.kv_norm, p.Wkv, KVR, KVW, KVWP);
      }
      if (USE_FAST(0)) { fp_mod(p, (float*)lds); fp_zero(p); } else nv_mod(p);
      break;
    case 1:
      if (USE_FAST(1)) { fp_sw(p, (float*)lds); fp_prep0(p); } else { nv_prep0(p); nv_sw(p); }
      fp_gm1(p);
      break;
    case 2:
      if (USE_FAST(2)) run_gemm(lds, p.A0, LDA, p.Wt0, DM, M, LDP, DM, EpiIn<0>{p.Pb, p.ssq0, p.sw, p.ssq_q, p.ssq_kv, p.ropet});
      else nv_gemm_in<0>(p);
      break;
    case 3:
      if (USE_FAST(3)) { run_gemm(lds, p.Pb + P0_CQ, LDP, p.Wq, QR, M, QWP, QR, EpiQ{p.qb, p.ssq_q, p.ropet});
                         run_gemm(lds, p.Pb + P0_CKV, LDP, p.Wkv, KVR, M, KVWP, KVR, EpiKV{p.kn, p.vb, p.ssq_kv}); }
      else { nv_uq(p); nv_ukv(p); }
      if (USE_FAST(12)) fp_conv(p); else nv_conv(p);
      break;
    case 4:
      if (USE_FAST(13)) scan::mlstm_block<1>(p, lds); else nv_mlstm(p);
      if (USE_FAST(4)) { __syncthreads(); fp_attn(p, lds); } else nv_attn_mla(p);
      break;
    case 5: if (USE_FAST(13)) scan::mlstm_block<2>(p, lds); break;
    case 6: if (USE_FAST(5)) fp_comb<0>(p); else nv_comb0(p); break;
    case 7:
      if (USE_FAST(6)) run_gemm(lds, p.A0, LDA, p.Wo0, CW0, M, DMP, CW0, EpiOut0{p.x, p.ctx, p.modv, p.gm1, p.out, p.A1, p.ssq1});
      else nv_out0(p);
      break;
    case 8:
      if (USE_FAST(7)) run_gemm(lds, p.A1, LDA, p.Wt1, DM, M, LDP, DM, EpiIn<1>{p.Pb, p.ssq1, p.sw + (size_t)NV * LDP, nullptr, nullptr, nullptr});
      else nv_gemm_in<1>(p);
      break;
    case 9:
      if (USE_FAST(8)) scan::gla_prepass(p, lds); else nv_gla(p);
      if (NA_PHASE == 9) { if (USE_FAST(14)) { __syncthreads(); na2::fp_na2(p, lds); } else nv_na(p); }
      break;
    case 10:
      if (NA_PHASE == 10) { if (USE_FAST(14)) { na2::fp_na2(p, lds); __syncthreads(); } else nv_na(p); }
      if (USE_FAST(8)) scan::gla_block<1>(p, lds);
      break;
    case 11: if (USE_FAST(8)) scan::gla_block<2>(p, lds); break;
    case 12: if (USE_FAST(9)) fp_comb<1>(p); else nv_comb1(p); break;
    case 13:
      if (USE_FAST(10)) run_gemm(lds, p.A0, LDA, p.Wo1, CW1, MLAT, DMP, CW1, EpiOut1{p.modv, p.out, p.ssq2});
      else nv_out1(p);
      break;
    case 14: if (USE_FAST(11)) fp_final(p); else nv_final(p); break;
    default: break;
  }
}

#ifdef HOST_TEST
constexpr int TEST_THREADS = 512, TEST_GRID = 3;
static int phase_threads(int ph) {
  auto F = [](int b) { return (g_fastmask >> b) & 1; };
  switch (ph) {
    case 0: return F(0) ? 512 : 0;  case 1: return F(1) ? 512 : 0;  case 2: return F(2) ? 512 : 0;  case 3: return (F(3) || F(12)) ? 512 : 0;
    case 4: return (F(4) || F(13)) ? 512 : 128;  case 5: return 512;  case 6: return F(5) ? 512 : 0;  case 7: return F(6) ? 512 : 0;  case 8: return F(7) ? 512 : 0;
    case 9: return (F(8) || F(14)) ? 512 : 128;  case 10: return 512;  case 11: return 512;  case 12: return F(9) ? 512 : 0;  case 13: return F(10) ? 512 : 0;  case 14: return F(11) ? 512 : 0;
  }
  return 512;
}
#endif
constexpr size_t al256(size_t x) { return (x + 255) / 256 * 256; }
constexpr size_t WS_PB = 0;
constexpr size_t WS_A0 = WS_PB + al256((size_t)M * LDP * 2);
constexpr size_t WS_A1 = WS_A0 + al256((size_t)M * LDA * 2);
constexpr size_t WS_H = WS_A1 + al256((size_t)M * (LDA > 2 * BRB ? LDA : 2 * BRB) * 2);
constexpr size_t WS_SMALL = WS_H + al256((size_t)M * BRB * 2 * 2);
constexpr size_t WS_MODV = WS_SMALL;
constexpr size_t WS_SW = WS_MODV + al256((size_t)2 * NV * 3 * DM * 4);
constexpr size_t WS_SSQ = WS_SW + al256((size_t)2 * NV * LDP * 4);
constexpr size_t WS_GM1 = WS_SSQ + al256((size_t)5 * M * 4);
constexpr size_t WS_ROPE = WS_GM1 + al256((size_t)NV * DM * 4);
constexpr size_t WS_WT0 = WS_ROPE + al256((size_t)RPOS * 16 * 4);
constexpr size_t WS_WT1 = WS_WT0 + al256((size_t)LDP * DM * 2);
constexpr size_t WS_WO0 = WS_WT1 + al256((size_t)LDP * DM * 2);
constexpr size_t WS_WO1 = WS_WO0 + al256((size_t)DMP * CW0 * 2);
constexpr size_t WS_WQ = WS_WO1 + al256((size_t)DMP * CW1 * 2);
constexpr size_t WS_WKV = WS_WQ + al256((size_t)QWP * QR * 2);
constexpr size_t WS_SCAN = WS_WKV + al256((size_t)KVWP * KVR * 2);
constexpr size_t WS_END0 = WS_SCAN + al256((size_t)NB * ML_H * 2 * 4 * 7 * (4096 + 128 + 8) * 4);
constexpr bool QKV_IN_OUT = (size_t)M * (QW + 2 * BRA) * 2 <= (size_t)MLAT * DM * 4;
constexpr size_t WS_BAR = WS_END0;
constexpr size_t WS_BAR_BYTES = 16384;
constexpr size_t WS_QKV = WS_BAR + WS_BAR_BYTES;
constexpr size_t WS_END = WS_QKV + (QKV_IN_OUT ? 0 : al256((size_t)M * (QW + 2 * BRA) * 2));

__host__ __device__ inline void carve(Params& p, unsigned char* ws, float* out) {
  p.out = out;
  p.Pb = (bf16_t*)(ws + WS_PB); p.A0 = (bf16_t*)(ws + WS_A0); p.A1 = (bf16_t*)(ws + WS_A1);
  p.mqc = p.A1; p.mkc = p.A1 + (size_t)M * BRB;
  p.Hf = (bf16_t*)(ws + WS_H); p.Hb = p.Hf + (size_t)M * BRB;
  p.modv = (float*)(ws + WS_MODV); p.sw = (float*)(ws + WS_SW);
  float* s = (float*)(ws + WS_SSQ); p.ssq0 = s; p.ssq1 = s + M; p.ssq_q = s + 2 * M; p.ssq_kv = s + 3 * M; p.ssq2 = s + 4 * M;
  p.gm1 = (float*)(ws + WS_GM1); p.ropet = (float*)(ws + WS_ROPE); p.scanst = (float*)(ws + WS_SCAN);
  p.Wt0 = (bf16_t*)(ws + WS_WT0); p.Wt1 = (bf16_t*)(ws + WS_WT1); p.Wo0 = (bf16_t*)(ws + WS_WO0); p.Wo1 = (bf16_t*)(ws + WS_WO1); p.Wq = (bf16_t*)(ws + WS_WQ); p.Wkv = (bf16_t*)(ws + WS_WKV);
  p.qb = QKV_IN_OUT ? (bf16_t*)out : (bf16_t*)(ws + WS_QKV); p.kn = p.qb + (size_t)M * QW; p.vb = p.kn + (size_t)M * BRA;
}
__host__ __device__ inline void set_inputs(Params& p, void* const* d_in) {
  const float* const* in = (const float* const*)d_in;
  p.x = in[0]; p.c = in[1]; p.ctx = in[2]; p.c_ctx = in[3];
  p.l0_norm = in[4]; p.l0_w_mod = in[5]; p.l0_b_mod = in[6]; p.l0_w_in = in[7]; p.q_norm = in[8]; p.w_uq = in[9]; p.kv_norm = in[10]; p.w_ukv = in[11];
  p.conv_w = in[12]; p.conv_b = in[13]; p.b_i = in[14]; p.b_f = in[15]; p.h_norm = in[16]; p.l0_w_out = in[17];
  p.l1_norm = in[18]; p.l1_w_mod = in[19]; p.l1_b_mod = in[20]; p.l1_w_in = in[21]; p.w_gate = in[22]; p.b_gate = in[23]; p.gla_norm = in[24]; p.rpb = in[25];
  p.l1_w_out = in[26]; p.final_norm = in[27];
}


#ifndef HOST_TEST
#define LAS __attribute__((address_space(3)))
#define XB_TMO      128
#define XB_XCNT(j)  (256  + 64 * (j))
#define XB_XSUB(j)  (1280 + 64 * (j))
#define XB_XGEN(j)  (2304 + 64 * (j))
#define XB_TOP      3328
#define XB_TOPGEN   3392
#define XCD_BAR_WORDS 3456
#define XB_SPIN_CAP (1u << 18)

__device__ __forceinline__ unsigned xb_ld(unsigned* p)              { return __hip_atomic_load(p, __ATOMIC_RELAXED, __HIP_MEMORY_SCOPE_AGENT); }
__device__ __forceinline__ unsigned xb_add(unsigned* p, unsigned v) { return __hip_atomic_fetch_add(p, v, __ATOMIC_RELAXED, __HIP_MEMORY_SCOPE_AGENT); }
__device__ __forceinline__ unsigned xb_xcc_id() { return (unsigned)__builtin_amdgcn_s_getreg((3 << 11) | 20) & 0xFu; }
#define XB_SPIN(cond, bar) do { unsigned _sp = 0; while (cond) { __builtin_amdgcn_s_sleep(1); \
    if ((++_sp & 255u) == 0u) { if (xb_ld(&(bar)[XB_TMO])) break; if (_sp > XB_SPIN_CAP) { atomicAdd(&(bar)[XB_TMO], 1u); break; } } } } while (0)

struct XcdBarrier {
    unsigned* bar; unsigned x;
    volatile LAS unsigned* st;
};

__device__ __forceinline__ XcdBarrier xcd_barrier_post(unsigned* bar, volatile LAS unsigned* st) {
    XcdBarrier b; b.bar = bar; b.x = xb_xcc_id(); b.st = st;
    if (threadIdx.x == 0) (void)xb_add(&bar[XB_XCNT(b.x)], 1u);
    return b;
}
__device__ __forceinline__ void xcd_barrier_complete(unsigned* bar, unsigned x, unsigned& nloc, unsigned& nx) {
    const unsigned G = gridDim.x * gridDim.y * gridDim.z;
    unsigned sum, cnt, mine, sp = 0u;
    for (;;) {
        sum = 0u; cnt = 0u; mine = 0u;
#pragma unroll
        for (unsigned j = 0; j < 16; ++j) { const unsigned c = xb_ld(&bar[XB_XCNT(j)]); sum += c; cnt += (c > 0u) ? 1u : 0u; mine = (j == x) ? c : mine; }
        if (sum == G) break;
        __builtin_amdgcn_s_sleep(1);
        if ((++sp & 255u) == 0u) { if (xb_ld(&bar[XB_TMO])) break; if (sp > XB_SPIN_CAP) { atomicAdd(&bar[XB_TMO], 1u); break; } }
    }
    nloc = mine > 0u ? mine : 1u; nx = cnt > 0u ? cnt : 1u;
}

__device__ __forceinline__ void xcd_barrier(const XcdBarrier& b) {
    asm volatile("s_waitcnt vmcnt(0)" ::: "memory");
    __syncthreads();
    if (threadIdx.x == 0) {
        unsigned* bar = b.bar;
        __builtin_amdgcn_s_waitcnt(0);
        unsigned nloc = b.st[0], nx = b.st[1];
        if (nloc == 0u) { xcd_barrier_complete(bar, b.x, nloc, nx); b.st[0] = nloc; b.st[1] = nx; }
        const unsigned old = xb_add(&bar[XB_XSUB(b.x)], 1u);
        const unsigned gen = old / nloc;
        if (old + 1u == (gen + 1u) * nloc) {
            __builtin_amdgcn_fence(__ATOMIC_RELEASE, "agent");
            asm volatile("s_waitcnt vmcnt(0)" ::: "memory");
            const unsigned og = xb_add(&bar[XB_TOP], 1u);
            const unsigned tg = og / nx;
            if (og + 1u == (tg + 1u) * nx) xb_add(&bar[XB_TOPGEN], 1u);
            else XB_SPIN(xb_ld(&bar[XB_TOPGEN]) == tg, bar);
            __builtin_amdgcn_fence(__ATOMIC_ACQUIRE, "agent");
            xb_add(&bar[XB_XGEN(b.x)], 1u);
            asm volatile("s_waitcnt vmcnt(0)" ::: "memory");
        } else {
            XB_SPIN(xb_ld(&bar[XB_XGEN(b.x)]) == gen, bar);
            __builtin_amdgcn_fence(__ATOMIC_ACQUIRE, "agent");
            asm volatile("s_waitcnt vmcnt(0)" ::: "memory");
        }
    }
    __syncthreads();
}
#endif
struct KArgs { const float* in[28]; float* out; unsigned char* ws; int ph_lo, ph_hi; };
template <int ph> __device__ __forceinline__ void phase_scoped(const KArgs& a, unsigned char* lds) {
  Params p; set_inputs(p, (void* const*)a.in); carve(p, a.ws, a.out); p.ph_lo = 0; p.ph_hi = 0;
  run_phase_t<ph>(p, lds);
}
#ifdef HOST_TEST
static void run_phase(const KArgs& a, int ph, unsigned char* lds) {
  switch (ph) { case 0: phase_scoped<0>(a, lds); break; case 1: phase_scoped<1>(a, lds); break; case 2: phase_scoped<2>(a, lds); break; case 3: phase_scoped<3>(a, lds); break;
    case 4: phase_scoped<4>(a, lds); break; case 5: phase_scoped<5>(a, lds); break; case 6: phase_scoped<6>(a, lds); break; case 7: phase_scoped<7>(a, lds); break;
    case 8: phase_scoped<8>(a, lds); break; case 9: phase_scoped<9>(a, lds); break; case 10: phase_scoped<10>(a, lds); break; case 11: phase_scoped<11>(a, lds); break; case 12: phase_scoped<12>(a, lds); break; case 13: phase_scoped<13>(a, lds); break; case 14: phase_scoped<14>(a, lds); break; default: break; }
}
#endif

#ifndef HOST_TEST
constexpr int LDS_BYTES = 151552;
__global__ void __launch_bounds__(NTHREADS, 2) mega(KArgs a) {
  extern __shared__ __attribute__((aligned(16))) unsigned char lds[];
  cg::grid_group grid = cg::this_grid();
  volatile LAS unsigned* bst = (volatile LAS unsigned*)((LAS unsigned char*)lds + (LDS_BYTES - 64));
  if (threadIdx.x < 2) bst[threadIdx.x] = 0u;
  __syncthreads();
  const XcdBarrier bar = xcd_barrier_post((unsigned*)(a.ws + WS_BAR), bst);
#ifndef DUPMASK
#define DUPMASK 0
#endif
#define PHASE(k) if (a.ph_lo <= (k) && (k) < a.ph_hi) { if ((DUPMASK >> (k)) & 1) { phase_scoped<k>(a, lds); xcd_barrier(bar); } phase_scoped<k>(a, lds); if ((k) + 1 < a.ph_hi) { if ((k) == 0) { asm volatile("s_waitcnt vmcnt(0) lgkmcnt(0)" ::: "memory"); grid.sync(); } else xcd_barrier(bar); } }
  PHASE(0) PHASE(1) PHASE(2) PHASE(3) PHASE(4) PHASE(5) PHASE(6) PHASE(7) PHASE(8) PHASE(9) PHASE(10) PHASE(11) PHASE(12) PHASE(13) PHASE(14)
#undef PHASE
}

extern "C" void kernel_launch(void* const* d_in, const int* in_sizes, int n_in, void* d_out, int out_size, void* d_ws, size_t ws_size, hipStream_t stream) {
  static int grid = 0;
  if (grid == 0) {
    int dev = 0, cus = 0, per_cu = 0;
    (void)hipGetDevice(&dev);
    (void)hipDeviceGetAttribute(&cus, hipDeviceAttributeMultiprocessorCount, dev);
    (void)hipFuncSetAttribute((const void*)mega, hipFuncAttributeMaxDynamicSharedMemorySize, LDS_BYTES);
    (void)hipOccupancyMaxActiveBlocksPerMultiprocessor(&per_cu, (const void*)mega, NTHREADS, LDS_BYTES);
    fprintf(stderr, "kernel_launch: cus=%d per_cu=%d ws_size=%zu need=%zu n_in=%d out_size=%d\n", cus, per_cu, ws_size, (size_t)WS_END, n_in, out_size);
    grid = cus;
    if (n_in != 28 || ws_size < WS_END || out_size != MLAT * DM || per_cu < 1) { fprintf(stderr, "kernel_launch: unexpected shapes / workspace; nothing launched\n"); grid = -1; }
  }
  if (grid < 0) return;
  if (hipMemsetAsync((unsigned char*)d_ws + WS_BAR, 0, WS_BAR_BYTES, stream) != hipSuccess) { fprintf(stderr, "kernel_launch: memset of the barrier words failed\n"); return; }
  KArgs a{};
  for (int i = 0; i < 28; ++i) a.in[i] = (const float*)d_in[i];
  a.out = (float*)d_out; a.ws = (unsigned char*)d_ws; a.ph_lo = 0; a.ph_hi = NPHASE;
  void* args[] = {&a};
  hipError_t e = hipLaunchCooperativeKernel((const void*)mega, dim3(grid), dim3(NTHREADS), args, LDS_BYTES, stream);
  if (e != hipSuccess) fprintf(stderr, "cooperative launch failed: %s (grid %d)\n", hipGetErrorString(e), grid);
}
#endif
```

```cpp
#ifndef HOST_TEST
#include <hip/hip_runtime.h>
#include <hip/hip_cooperative_groups.h>
#include <cstdio>
#include <cstdint>
namespace cg = cooperative_groups;
#endif

#if defined(SMALL_CFG)
constexpr int DM = 128, NB = 2, SEQ = 256, GW = 16, CTX = 64, MLA_H = 2, QR = 48, KVR = 32, ML_H = 2, GLA_H = 2, NA_H = 2;
#elif defined(MED_CFG)
constexpr int DM = 256, NB = 1, SEQ = 1024, GW = 64, CTX = 256, MLA_H = 8, QR = 384, KVR = 256, ML_H = 4, GLA_H = 4, NA_H = 8;
#else
constexpr int DM = 1024, NB = 8, SEQ = 4096, GW = 64, CTX = 256, MLA_H = 8, QR = 384, KVR = 256, ML_H = 4, GLA_H = 4, NA_H = 8;
#endif
constexpr int NOPE = 64, ROPE = 32, VD = 64, QD = 96, ML_D = 128, GLA_DK = 64, GLA_DV = 128, GRANK = 16, NA_D = 64, NA_KH = 8, NA_KW = 16;
constexpr float EPS = 1e-6f;
constexpr int BRA = MLA_H * VD, BRB = ML_H * ML_D, BRC = GLA_H * GLA_DV, BRD = NA_H * NA_D;
constexpr int TB = CTX + SEQ, M = NB * TB, MLAT = NB * SEQ, NV = NB + 1, GROWS = SEQ / GW;
constexpr int QW = MLA_H * QD, KVW = MLA_H * (NOPE + VD);
constexpr int S0_CQ = 0, S0_CKV = QR, S0_KR = QR + KVR, S0_MQ = S0_KR + ROPE, S0_MK = S0_MQ + BRB, S0_MV = S0_MK + BRB, S0_MO = S0_MV + BRB,
              S0_G = S0_MO + BRB, S0_Z = S0_G + 4 * ML_H, N0 = S0_Z + BRA + BRB;
constexpr int P0_CQ = 0, P0_CKV = QR, P0_MQ = QR + KVR, P0_MK = P0_MQ + BRB, P0_MV = P0_MK + BRB, P0_MO = P0_MV + BRB, P0_Z = P0_MO + BRB,
              P0_KR = P0_Z + BRA + BRB, P0_G = P0_KR + ROPE;
static_assert(P0_G + 4 * ML_H == N0, "layer-0 column map");
constexpr int S1_GQ = 0, S1_GK = GLA_H * GLA_DK, S1_GV = 2 * GLA_H * GLA_DK, S1_GA = S1_GV + BRC, S1_NQ = S1_GA + 2 * GRANK, S1_NK = S1_NQ + BRD,
              S1_NV = S1_NK + BRD, S1_Z = S1_NV + BRD, N1 = S1_Z + BRC + BRD;
constexpr int P1_GQ = 0, P1_GK = S1_GK, P1_GV = S1_GV, P1_NQ = S1_GA, P1_NK = P1_NQ + BRD, P1_NV = P1_NK + BRD, P1_Z = P1_NV + BRD, P1_GA = P1_Z + BRC + BRD;
static_assert(P1_GA + 2 * GRANK == N1, "layer-1 column map");
constexpr int NMAX = N0 > N1 ? N0 : N1;
constexpr int LDP = (NMAX + 255) / 256 * 256;
constexpr float LOG2E = 1.4426950408889634f;
constexpr float C2Q = 0.10206207261596575f * LOG2E;
constexpr int NTHREADS = 512;
constexpr int RPOS = GW > GROWS ? GW : GROWS;
constexpr int CW0 = BRA + BRB, CW1 = BRC + BRD;
constexpr int LDA = (DM > CW0 ? (DM > CW1 ? DM : CW1) : (CW0 > CW1 ? CW0 : CW1));

__device__ __forceinline__ int l0_src(int j) {
  if (j < P0_MQ) return j;
  if (j < P0_Z) return S0_MQ + (j - P0_MQ);
  if (j < P0_KR) return S0_Z + (j - P0_Z);
  if (j < P0_G) return S0_KR + (j - P0_KR);
  if (j < N0) return S0_G + (j - P0_G);
  return -1;
}
__device__ __forceinline__ int l1_src(int j) {
  if (j < P1_NQ) return j;
  if (j < P1_Z) return S1_NQ + (j - P1_NQ);
  if (j < P1_GA) return S1_Z + (j - P1_Z);
  if (j < N1) return S1_GA + (j - P1_GA);
  return -1;
}

typedef unsigned short bf16_t;
#ifdef HOST_TEST
static inline float fast_exp(float x) { return expf(x); }
static inline float fast_log(float x) { return logf(x); }
#else
__device__ __forceinline__ float fast_exp(float x) { return __expf(x); }
__device__ __forceinline__ float fast_log(float x) { return __logf(x); }
#endif
__device__ __forceinline__ float bf2f(bf16_t h) { unsigned u = (unsigned)h << 16; float f; __builtin_memcpy(&f, &u, 4); return f; }
__device__ __forceinline__ bf16_t f2bf(float f) { unsigned u; __builtin_memcpy(&u, &f, 4); return (bf16_t)((u + 0x7fffu + ((u >> 16) & 1u)) >> 16); }
__device__ __forceinline__ float silu_f(float x) { return x / (1.f + fast_exp(-x)); }
__device__ __forceinline__ float sigmoid_f(float x) { return 1.f / (1.f + fast_exp(-x)); }
__device__ __forceinline__ float log_sigmoid_f(float x) { return fminf(x, 0.f) - log1pf(fast_exp(-fabsf(x))); }

struct Params {
  const float *x, *c, *ctx, *c_ctx;
  const float *l0_norm, *l0_w_mod, *l0_b_mod, *l0_w_in, *q_norm, *w_uq, *kv_norm, *w_ukv, *conv_w, *conv_b, *b_i, *b_f, *h_norm, *l0_w_out;
  const float *l1_norm, *l1_w_mod, *l1_b_mod, *l1_w_in, *w_gate, *b_gate, *gla_norm, *rpb, *l1_w_out, *final_norm;
  float* out;
  float *modv;
  float *sw;
  float *ssq0, *ssq1;
  float *ssq_q, *ssq_kv;
  float *ssq2;
  float *gm1;
  float *ropet;
  float *scanst;
  bf16_t *Wt0, *Wt1, *Wo0, *Wo1, *Wq, *Wkv;
  bf16_t *A0;
  bf16_t *A1;
  bf16_t *mqc, *mkc;
  bf16_t *Pb;
  bf16_t *qb, *kn, *vb;
  bf16_t *Hf, *Hb;
  int ph_lo, ph_hi;
};

__device__ __forceinline__ long gtid() { return (long)blockIdx.x * blockDim.x + threadIdx.x; }
__device__ __forceinline__ long gsize() { return (long)gridDim.x * blockDim.x; }

__device__ __forceinline__ size_t hoff(int c, size_t row, size_t NR) { return ((size_t)(c >> 5) * NR + row) * 32 + (c & 31); }
__device__ __forceinline__ int row_variant(int m) { const int b = m / TB, t = m % TB; return t < CTX ? NB : b; }
__device__ __forceinline__ const float* row_input(const Params& p, int m) {
  const int b = m / TB, t = m % TB;
  return t < CTX ? p.ctx + ((size_t)b * CTX + t) * DM : p.x + ((size_t)b * SEQ + (t - CTX)) * DM;
}
__device__ __forceinline__ float rope_inv(int i) { return exp2f(-(float)i * (13.287712379549449f / 8.f)); }

__device__ __forceinline__ void nv_mod_l(const Params& p, const int l, const float* __restrict__ w, const float* __restrict__ b) {
  for (long idx = gtid(); idx < (long)NV * 3 * DM; idx += gsize()) {
    const int v = (int)(idx / (3 * DM)), j = (int)(idx % (3 * DM));
    const float* cv = p.c + (size_t)(v < NB ? v : 0) * DM;
    float acc = b[j];
    for (int k = 0; k < DM; ++k) { const float cc = v < NB ? cv[k] : p.c_ctx[k]; acc += silu_f(cc) * w[(size_t)k * 3 * DM + j]; }
    p.modv[(size_t)l * NV * 3 * DM + idx] = acc;
  }
}
__device__ __forceinline__ void nv_mod(const Params& p) {
  nv_mod_l(p, 0, p.l0_w_mod, p.l0_b_mod);
  nv_mod_l(p, 1, p.l1_w_mod, p.l1_b_mod);
  for (long i = gtid(); i < M; i += gsize()) { p.ssq_q[i] = 0.f; p.ssq_kv[i] = 0.f; p.ssq1[i] = 0.f; p.ssq0[i] = 0.f; if (i < MLAT) p.ssq2[i] = 0.f; }
}
__device__ __forceinline__ void nv_prep0(const Params& p) {
  for (long m = gtid(); m < M; m += gsize()) {
    const float* xr = row_input(p, (int)m); const int v = row_variant((int)m);
    const float* sc = p.modv + ((size_t)0 * NV + v) * 3 * DM + DM;
    float ss = 0.f;
    for (int k = 0; k < DM; ++k) { const float xv = xr[k]; ss += xv * xv; p.A0[(size_t)m * LDA + k] = f2bf(xv * p.l0_norm[k] * (1.f + sc[k])); }
    p.ssq0[m] = ss;
  }
}
template <int L> __device__ __forceinline__ void nv_sw_l(const Params& p, const float* __restrict__ w) {
  constexpr int NO = L ? N1 : N0;
  for (long idx = gtid(); idx < (long)NV * LDP; idx += gsize()) {
    const int v = (int)(idx / LDP), j = (int)(idx % LDP);
    const int src = L ? l1_src(j) : l0_src(j);
    const float* sh = p.modv + ((size_t)L * NV + v) * 3 * DM;
    float acc = 0.f;
    if (src >= 0) for (int k = 0; k < DM; ++k) acc += sh[k] * w[(size_t)k * NO + src];
    p.sw[(size_t)L * NV * LDP + idx] = acc;
  }
}
__device__ __forceinline__ void nv_sw(const Params& p) { nv_sw_l<0>(p, p.l0_w_in); nv_sw_l<1>(p, p.l1_w_in); }
template <int l> __device__ __forceinline__ void nv_gemm_in(const Params& p) {
  constexpr int NO = l ? N1 : N0; const float* __restrict__ w = l ? p.l1_w_in : p.l0_w_in; const bf16_t* __restrict__ A = l ? p.A1 : p.A0; const float* __restrict__ ssq = l ? p.ssq1 : p.ssq0;
  for (long idx = gtid(); idx < (long)(M / 4) * NO; idx += gsize()) {
    const int j = (int)(idx % NO), mg = (int)(idx / NO);
    const int src = l ? l1_src(j) : l0_src(j);
    const bool rope = (l == 0) && j >= P0_KR && j < P0_KR + ROPE && ((mg * 4) % TB) >= CTX;
    int jj = 0, src2 = src; if (rope) { jj = j - P0_KR; src2 = ((jj & 15) < 8) ? src + 8 : src - 8; }
    float acc[4] = {0.f, 0.f, 0.f, 0.f}, acc2[4] = {0.f, 0.f, 0.f, 0.f};
    for (int k = 0; k < DM; ++k) {
      const float wv = w[(size_t)k * NO + src], wv2 = w[(size_t)k * NO + src2];
#pragma unroll
      for (int r = 0; r < 4; ++r) { const float a = bf2f(A[(size_t)(mg * 4 + r) * LDA + k]); acc[r] += a * wv; acc2[r] += a * wv2; }
    }
#pragma unroll
    for (int r = 0; r < 4; ++r) {
      const int m = mg * 4 + r, v = row_variant(m);
      const float rstd = rsqrtf(ssq[m] * (1.f / DM) + EPS);
      const float* swv = p.sw + ((size_t)l * NV + v) * LDP;
      float val = rstd * acc[r] + swv[j];
      if (rope) {
        const int j2 = ((jj & 15) < 8) ? j + 8 : j - 8;
        const float val2 = rstd * acc2[r] + swv[j2];
        const int tl = (m % TB) - CTX, pos = (jj < 16) ? tl / GW : tl % GW;
        const float ang = (float)pos * rope_inv(jj & 7); const float cs = cosf(ang), sn = sinf(ang);
        val = ((jj & 15) < 8) ? val * cs - val2 * sn : val * cs + val2 * sn;
      }
      p.Pb[(size_t)m * LDP + j] = f2bf(val);
      if (l == 0 && j < QR) atomicAdd(&p.ssq_q[m], val * val); else if (l == 0 && j < QR + KVR) atomicAdd(&p.ssq_kv[m], val * val);
    }
  }
}
__device__ __forceinline__ void nv_uq(const Params& p) {
  for (long idx = gtid(); idx < (long)M * QW; idx += gsize()) {
    const int j = (int)(idx % QW), m = (int)(idx / QW);
    const int jh = j % QD; const bool rope = jh >= NOPE && (m % TB) >= CTX;
    const int jj = jh - NOPE; const int j2 = rope ? (((jj & 15) < 8) ? j + 8 : j - 8) : j;
    float acc = 0.f, acc2 = 0.f;
    for (int k = 0; k < QR; ++k) { const float a = bf2f(p.Pb[(size_t)m * LDP + P0_CQ + k]) * p.q_norm[k]; acc += a * p.w_uq[(size_t)k * QW + j]; acc2 += a * p.w_uq[(size_t)k * QW + j2]; }
    const float rstd = rsqrtf(p.ssq_q[m] * (1.f / QR) + EPS);
    float val = acc * rstd;
    if (rope) {
      const float val2 = acc2 * rstd; const int tl = (m % TB) - CTX, pos = (jj < 16) ? tl / GW : tl % GW;
      const float ang = (float)pos * rope_inv(jj & 7); const float cs = cosf(ang), sn = sinf(ang);
      val = ((jj & 15) < 8) ? val * cs - val2 * sn : val * cs + val2 * sn;
    }
    p.qb[(size_t)m * QW + j] = f2bf(val * C2Q);
  }
}
__device__ __forceinline__ void nv_ukv(const Params& p) {
  for (long idx = gtid(); idx < (long)M * KVW; idx += gsize()) {
    const int j = (int)(idx % KVW), m = (int)(idx / KVW);
    float acc = 0.f;
    for (int k = 0; k < KVR; ++k) acc += bf2f(p.Pb[(size_t)m * LDP + P0_CKV + k]) * p.kv_norm[k] * p.w_ukv[(size_t)k * KVW + j];
    const float val = acc * rsqrtf(p.ssq_kv[m] * (1.f / KVR) + EPS);
    const int hh = j / (NOPE + VD), jj = j % (NOPE + VD);
    if (jj < NOPE) p.kn[(size_t)m * BRA + hh * NOPE + jj] = f2bf(val); else p.vb[(size_t)m * BRA + hh * VD + (jj - NOPE)] = f2bf(val);
  }
}
__device__ __forceinline__ void nv_conv(const Params& p) {
  for (long idx = gtid(); idx < (long)M * 2 * BRB; idx += gsize()) {
    const int j = (int)(idx % (2 * BRB)), m = (int)(idx / (2 * BRB)); const int t = m % TB;
    const int lo = t < CTX ? 0 : CTX, hi = t < CTX ? CTX : TB;
    float y = p.conv_b[j];
#pragma unroll
    for (int tap = 0; tap < 3; ++tap) { const int tt = t + tap - 1; if (tt >= lo && tt < hi) y += bf2f(p.Pb[(size_t)(m + tap - 1) * LDP + P0_MQ + j]) * p.conv_w[tap * 2 * BRB + j]; }
    y = silu_f(y);
    if (j < BRB) p.mqc[(size_t)m * BRB + j] = f2bf(y * 0.08838834764831845f); else p.mkc[(size_t)m * BRB + (j - BRB)] = f2bf(y);
  }
}
__device__ __forceinline__ void nv_attn_mla(const Params& p) {
  for (long idx = gtid(); idx < (long)NB * MLA_H * TB; idx += gsize()) {
    const int t = (int)(idx % TB), h = (int)((idx / TB) % MLA_H), b = (int)(idx / ((long)TB * MLA_H));
    const int m = b * TB + t; const int nkeys = t < CTX ? CTX : TB;
    float q[QD], o[VD];
#pragma unroll
    for (int d = 0; d < QD; ++d) q[d] = bf2f(p.qb[(size_t)m * QW + h * QD + d]);
#pragma unroll
    for (int d = 0; d < VD; ++d) o[d] = 0.f;
    float mx = -1e30f, l = 0.f;
    for (int key = 0; key < nkeys; ++key) {
      const size_t kk = (size_t)b * TB + key; float s = 0.f;
#pragma unroll
      for (int d = 0; d < NOPE; ++d) s += q[d] * bf2f(p.kn[kk * BRA + h * NOPE + d]);
#pragma unroll
      for (int d = 0; d < ROPE; ++d) s += q[NOPE + d] * bf2f(p.Pb[kk * LDP + P0_KR + d]);
      const float mn = fmaxf(mx, s), alpha = exp2f(mx - mn), pp = exp2f(s - mn);
      l = l * alpha + pp; mx = mn;
#pragma unroll
      for (int d = 0; d < VD; ++d) o[d] = o[d] * alpha + pp * bf2f(p.vb[kk * BRA + h * VD + d]);
    }
    const float il = 1.f / l;
#pragma unroll
    for (int d = 0; d < VD; ++d) p.A0[(size_t)m * LDA + h * VD + d] = f2bf(o[d] * il * silu_f(bf2f(p.Pb[(size_t)m * LDP + P0_Z + h * VD + d])));
  }
}
__device__ __forceinline__ int seq_token(int s, int dir) {
  if (dir == 0) return s;
  return s < CTX ? CTX - 1 - s : TB - 1 - (s - CTX);
}
__device__ __forceinline__ void nv_mlstm(const Params& p) {
  __shared__ float qs[ML_D], ks[ML_D], red[ML_D];
  const int j = threadIdx.x;
  for (int item = blockIdx.x; item < NB * ML_H * 2; item += gridDim.x) {
    const int dir = item & 1, h = (item >> 1) % ML_H, b = item / (2 * ML_H);
    float C[ML_D]; float nj = 0.f, mst = 0.f;
#pragma unroll
    for (int d = 0; d < ML_D; ++d) C[d] = 0.f;
    bf16_t* Hout = dir ? p.Hb : p.Hf;
    for (int s = 0; s < TB; ++s) {
      const int t = seq_token(s, dir); const size_t m = (size_t)b * TB + t;
      const float ig = bf2f(p.Pb[m * LDP + P0_G + dir * 2 * ML_H + h]) + p.b_i[dir * ML_H + h];
      const float lf = log_sigmoid_f(bf2f(p.Pb[m * LDP + P0_G + dir * 2 * ML_H + ML_H + h]) + p.b_f[dir * ML_H + h]);
      const float mn = fmaxf(lf + mst, ig), decay = fast_exp(lf + mst - mn), iw = fast_exp(ig - mn); mst = mn;
      float vj = 0.f;
      if (j < ML_D) { qs[j] = bf2f(p.mqc[m * BRB + h * ML_D + j]); ks[j] = bf2f(p.mkc[m * BRB + h * ML_D + j]); vj = bf2f(p.Pb[m * LDP + P0_MV + h * ML_D + j]); }
      __syncthreads();
      float num = 0.f;
      if (j < ML_D) {
#pragma unroll
        for (int d = 0; d < ML_D; ++d) { C[d] = decay * C[d] + iw * ks[d] * vj; num += qs[d] * C[d]; }
        nj = decay * nj + iw * ks[j]; red[j] = qs[j] * nj;
      }
      __syncthreads();
      if (j < ML_D) {
        float den = 0.f;
        for (int d = 0; d < ML_D; ++d) den += red[d];
        Hout[hoff(h * ML_D + j, m, M)] = f2bf(num / fmaxf(fabsf(den), fast_exp(-mst)));
      }
      __syncthreads();
    }
  }
}
__device__ __forceinline__ void nv_comb0(const Params& p) {
  for (long idx = gtid(); idx < (long)M * ML_H; idx += gsize()) {
    const int hh = (int)(idx % ML_H); const size_t m = (size_t)(idx / ML_H);
    float ss = 0.f;
    for (int d = 0; d < ML_D; ++d) { const int c = hh * ML_D + d;
      const float g = sigmoid_f(bf2f(p.Pb[m * LDP + P0_MO + c])) * (bf2f(p.Hf[hoff(c, m, M)]) + bf2f(p.Hb[hoff(c, m, M)])); ss += g * g; }
    const float rstd = rsqrtf(ss * (1.f / ML_D) + EPS);
    for (int d = 0; d < ML_D; ++d) { const int c = hh * ML_D + d;
      const float g = sigmoid_f(bf2f(p.Pb[m * LDP + P0_MO + c])) * (bf2f(p.Hf[hoff(c, m, M)]) + bf2f(p.Hb[hoff(c, m, M)]));
      p.A0[m * LDA + BRA + c] = f2bf(g * rstd * p.h_norm[c] * silu_f(bf2f(p.Pb[m * LDP + P0_Z + BRA + c]))); }
  }
}
__device__ __forceinline__ void nv_out0(const Params& p) {
  for (long idx = gtid(); idx < (long)(M / 4) * DM; idx += gsize()) {
    const int j = (int)(idx % DM), mg = (int)(idx / DM);
    float acc[4] = {0.f, 0.f, 0.f, 0.f};
    for (int k = 0; k < BRA + BRB; ++k) { const float wv = p.l0_w_out[(size_t)k * DM + j];
#pragma unroll
      for (int r = 0; r < 4; ++r) acc[r] += bf2f(p.A0[(size_t)(mg * 4 + r) * LDA + k]) * wv; }
#pragma unroll
    for (int r = 0; r < 4; ++r) {
      const int m = mg * 4 + r, v = row_variant(m), b = m / TB, t = m % TB;
      const float gate = p.modv[((size_t)0 * NV + v) * 3 * DM + 2 * DM + j];
      const float h1 = row_input(p, m)[j] + gate * acc[r];
      if (t >= CTX) p.out[((size_t)b * SEQ + (t - CTX)) * DM + j] = h1;
      atomicAdd(&p.ssq1[m], h1 * h1);
      p.A1[(size_t)m * LDA + j] = f2bf(h1 * p.l1_norm[j] * (1.f + p.modv[((size_t)1 * NV + v) * 3 * DM + DM + j]));
    }
  }
}
__device__ __forceinline__ void nv_gla(const Params& p) {
  __shared__ float qs[GLA_DK], ks[GLA_DK], al[GLA_DK];
  const int j = threadIdx.x;
  for (int item = blockIdx.x; item < NB * GLA_H * 2; item += gridDim.x) {
    const int dir = item & 1, h = (item >> 1) % GLA_H, b = item / (2 * GLA_H);
    float S[GLA_DK];
#pragma unroll
    for (int d = 0; d < GLA_DK; ++d) S[d] = 0.f;
    bf16_t* Oout = dir ? p.Hb : p.Hf;
    for (int s = 0; s < TB; ++s) {
      const int t = seq_token(s, dir); const size_t m = (size_t)b * TB + t;
      if (j < GLA_DK) {
        float g = p.b_gate[dir * GLA_H * GLA_DK + h * GLA_DK + j];
        for (int r = 0; r < GRANK; ++r) g += bf2f(p.Pb[m * LDP + P1_GA + dir * GRANK + r]) * p.w_gate[((size_t)dir * GRANK + r) * GLA_H * GLA_DK + h * GLA_DK + j];
        al[j] = fast_exp(log_sigmoid_f(g) * (1.f / 16.f));
        qs[j] = bf2f(p.Pb[m * LDP + P1_GQ + h * GLA_DK + j]) * 0.125f; ks[j] = bf2f(p.Pb[m * LDP + P1_GK + h * GLA_DK + j]);
      }
      float vj = 0.f; if (j < GLA_DV) vj = bf2f(p.Pb[m * LDP + P1_GV + h * GLA_DV + j]);
      __syncthreads();
      if (j < GLA_DV) {
        float o = 0.f;
#pragma unroll
        for (int d = 0; d < GLA_DK; ++d) { S[d] = al[d] * S[d] + ks[d] * vj; o += qs[d] * S[d]; }
        if (t >= CTX) Oout[hoff(h * GLA_DV + j, (size_t)b * SEQ + (t - CTX), MLAT)] = f2bf(o);
      }
      __syncthreads();
    }
  }
}
__device__ __forceinline__ void nv_na(const Params& p) {
  for (long idx = gtid(); idx < (long)NB * NA_H * SEQ; idx += gsize()) {
    const int tl = (int)(idx % SEQ), h = (int)((idx / SEQ) % NA_H), b = (int)(idx / ((long)SEQ * NA_H));
    const int r = tl / GW, c = tl % GW; const size_t m = (size_t)b * TB + CTX + tl;
    int rs = r - NA_KH / 2; rs = rs < 0 ? 0 : (rs > GROWS - NA_KH ? GROWS - NA_KH : rs);
    int cs = c - NA_KW / 2; cs = cs < 0 ? 0 : (cs > GW - NA_KW ? GW - NA_KW : cs);
    float q[NA_D], o[NA_D];
#pragma unroll
    for (int d = 0; d < NA_D; ++d) { q[d] = bf2f(p.Pb[m * LDP + P1_NQ + h * NA_D + d]) * 0.125f; o[d] = 0.f; }
    float mx = -1e30f, l = 0.f;
    for (int key = 0; key < NA_KH * NA_KW + CTX; ++key) {
      size_t kk; float bias = 0.f;
      if (key < NA_KH * NA_KW) { const int i = key / NA_KW, jc = key % NA_KW; kk = (size_t)b * TB + CTX + (rs + i) * GW + cs + jc;
        bias = p.rpb[((size_t)h * (2 * NA_KH - 1) + (rs + i - r + NA_KH - 1)) * (2 * NA_KW - 1) + (cs + jc - c + NA_KW - 1)]; }
      else kk = (size_t)b * TB + (key - NA_KH * NA_KW);
      float s = 0.f;
#pragma unroll
      for (int d = 0; d < NA_D; ++d) s += q[d] * bf2f(p.Pb[kk * LDP + P1_NK + h * NA_D + d]);
      s += bias;
      const float mn = fmaxf(mx, s), alpha = fast_exp(mx - mn), pp = fast_exp(s - mn);
      l = l * alpha + pp; mx = mn;
#pragma unroll
      for (int d = 0; d < NA_D; ++d) o[d] = o[d] * alpha + pp * bf2f(p.Pb[kk * LDP + P1_NV + h * NA_D + d]);
    }
    const float il = 1.f / l; const size_t ml = (size_t)b * SEQ + tl;
#pragma unroll
    for (int d = 0; d < NA_D; ++d) p.A0[ml * LDA + BRC + h * NA_D + d] = f2bf(o[d] * il * silu_f(bf2f(p.Pb[m * LDP + P1_Z + BRC + h * NA_D + d])));
  }
}
__device__ __forceinline__ void nv_comb1(const Params& p) {
  for (long idx = gtid(); idx < (long)MLAT * GLA_H; idx += gsize()) {
    const int hh = (int)(idx % GLA_H); const size_t ml = (size_t)(idx / GLA_H); const size_t m = (ml / SEQ) * TB + CTX + (ml % SEQ);
    float ss = 0.f;
    for (int d = 0; d < GLA_DV; ++d) { const int c = hh * GLA_DV + d; const float g = bf2f(p.Hf[hoff(c, ml, MLAT)]) + bf2f(p.Hb[hoff(c, ml, MLAT)]); ss += g * g; }
    const float rstd = rsqrtf(ss * (1.f / GLA_DV) + EPS);
    for (int d = 0; d < GLA_DV; ++d) { const int c = hh * GLA_DV + d; const float g = bf2f(p.Hf[hoff(c, ml, MLAT)]) + bf2f(p.Hb[hoff(c, ml, MLAT)]);
      p.A0[ml * LDA + c] = f2bf(g * rstd * p.gla_norm[c] * silu_f(bf2f(p.Pb[m * LDP + P1_Z + c]))); }
  }
}
__device__ __forceinline__ void nv_out1(const Params& p) {
  for (long idx = gtid(); idx < (long)(MLAT / 4) * DM; idx += gsize()) {
    const int j = (int)(idx % DM), mg = (int)(idx / DM);
    float acc[4] = {0.f, 0.f, 0.f, 0.f};
    for (int k = 0; k < BRC + BRD; ++k) { const float wv = p.l1_w_out[(size_t)k * DM + j];
#pragma unroll
      for (int r = 0; r < 4; ++r) acc[r] += bf2f(p.A0[(size_t)(mg * 4 + r) * LDA + k]) * wv; }
#pragma unroll
    for (int r = 0; r < 4; ++r) { const size_t ml = (size_t)mg * 4 + r; const int b = (int)(ml / SEQ);
      p.out[ml * DM + j] += p.modv[((size_t)1 * NV + b) * 3 * DM + 2 * DM + j] * acc[r]; }
  }
}
__device__ __forceinline__ void nv_final(const Params& p) {
  for (long ml = gtid(); ml < MLAT; ml += gsize()) {
    float* r = p.out + (size_t)ml * DM; float ss = 0.f;
    for (int k = 0; k < DM; ++k) ss += r[k] * r[k];
    const float rstd = rsqrtf(ss * (1.f / DM) + EPS);
    for (int k = 0; k < DM; ++k) r[k] = r[k] * rstd * p.final_norm[k];
  }
}


#ifdef HOST_TEST
#define UNIFORM(x) (x)
#define WAVE_LDS_SYNC() wave_barrier()
static int g_fastmask = 0;
#define USE_FAST(k) ((g_fastmask >> (k)) & 1)
#else
#define UNIFORM(x) __builtin_amdgcn_readfirstlane(x)
#define WAVE_LDS_SYNC() asm volatile("s_waitcnt lgkmcnt(0)" ::: "memory")
#ifndef FASTMASK
#define FASTMASK 0x7FFF
#endif
#define USE_FAST(k) ((FASTMASK >> (k)) & 1)
#endif

#ifndef HOST_TEST
namespace pg8 {
#define PG8_LAS __attribute__((address_space(3)))
typedef unsigned short bf16_t;
typedef short bf16x8 __attribute__((ext_vector_type(8)));
typedef float f32x4 __attribute__((ext_vector_type(4)));
typedef unsigned u32x4 __attribute__((ext_vector_type(4)));
constexpr int BM = 256, BK = 64, HALF = 128, HTB = HALF * BK * 2  , STAGE_BYTES = 8 * HTB, NXCD = 8, WGM = 8;

__host__ __device__ __forceinline__ int lds_byte(int r, int c) { const int st = (r >> 4) * 2 + (c >> 5), rr = r & 15, cc = c & 31, ob = rr * 64 + cc * 2; return st * 1024 + (ob ^ (((ob >> 9) & 1) << 5)); }
__host__ __device__ __forceinline__ void stage_rc(int b, int& R, int& C) { const int st = b / 1024, sb = b % 1024, swz = sb ^ (((sb >> 9) & 1) << 5); R = (st >> 1) * 16 + swz / 64; C = (st & 1) * 32 + (swz % 64) / 2; }
__host__ __device__ __forceinline__ int perm32(int rho) { const int n = rho >> 4, i = rho & 15; return 8 * (i >> 2) + 4 * n + (i & 3); }

struct Unit { int pm, pn; };
struct Gemm { const bf16_t* A; const bf16_t* Bt; int M, N, K, lda, ldb; };

struct StaticOrder {
    int nM, nN, nwg, G, c;
    __host__ __device__ void init(int M, int N, int G_, int c_) { nM = M / BM; nN = N / BM; nwg = nM * nN; G = G_; c = c_; }
    __host__ __device__ bool next(int i, Unit& u) const {
        const long L = (long)i * G + c; if (L >= nwg) return false;
        int wgid = (int)L; { const int q = nwg / NXCD, r = nwg % NXCD, xcd = wgid % NXCD, off = wgid / NXCD; wgid = (xcd < r ? xcd * (q + 1) : r * (q + 1) + (xcd - r) * q) + off; }
        const int nig = WGM * nN, gid = wgid / nig, fm = gid * WGM, gsz = (nM - fm) < WGM ? (nM - fm) : WGM;
        u.pm = fm + ((wgid % nig) % gsz); u.pn = (wgid % nig) / gsz; return true;
    }
    __device__ __forceinline__ void a_ready(const Unit&) const {}
    __device__ __forceinline__ void done(const Unit&) const {}
};
__device__ __forceinline__ unsigned cvt_pk_bf16(float lo, float hi) { unsigned r; asm volatile("v_cvt_pk_bf16_f32 %0, %1, %2" : "=v"(r) : "v"(lo), "v"(hi)); return r; }
template <class Epi, class Sched, bool ALIGN_EPI = false, bool SP2 = false>
__device__ __forceinline__ void gemm_phase(PG8_LAS unsigned char* lds, const Gemm g, const Sched& S, const Epi& E) {
    const int tid = threadIdx.x, wid = __builtin_amdgcn_readfirstlane(tid >> 6), lane = tid & 63, wr = wid >> 2, wc = wid & 3, fr = lane & 15, fq = lane >> 4;
    const int K = g.K, nt = K / BK;
    unsigned voffA[2], voffB[2];
#pragma unroll
    for (int i = 0; i < 2; ++i) { int R, C; stage_rc(tid * 16 + i * 8192, R, C); const int Rb = Epi::PERM ? ((R & ~31) + perm32(R & 31)) : R;
        voffA[i] = (unsigned)(R * g.lda + C) * 2u; voffB[i] = (unsigned)(Rb * g.ldb + C) * 2u; }
    const size_t kstep = (size_t)(BK * 2);
    const size_t hstepA = (size_t)HALF * g.lda * 2, hstepB = (size_t)HALF * g.ldb * 2;
    const size_t tstepA = 2 * hstepA, tstepB = 2 * hstepB;
    const unsigned ldsw = (unsigned)wid * 1024u;
    const int aoff = lds_byte(wr * 64 + fr, fq * 8), boff = lds_byte(wc * 32 + fr, fq * 8);
#define PG8_SA(b, h) (((b) * 2 + (h)) * HTB)
#define PG8_SB(b, h) ((4 + (b) * 2 + (h)) * HTB)
#define PG8_STAGE(bufoff, gbase, voff) do { _Pragma("unroll") for (int _i = 0; _i < 2; ++_i) \
        __builtin_amdgcn_global_load_lds((const unsigned*)((const char*)(gbase) + (voff)[_i]), (PG8_LAS unsigned*)(lds + (bufoff) + ldsw + _i * 8192), 16, 0, 0); } while (0)
#define PG8_LDA(dst, b, h) do { _Pragma("unroll") for (int m = 0; m < 4; ++m) _Pragma("unroll") for (int k = 0; k < 2; ++k) dst[m][k] = *(const PG8_LAS bf16x8*)(lds + PG8_SA(b, h) + aoff + m * 2048 + k * 1024); } while (0)
#define PG8_LDB(dst, b, h) do { _Pragma("unroll") for (int n = 0; n < 2; ++n) _Pragma("unroll") for (int k = 0; k < 2; ++k) dst[n][k] = *(const PG8_LAS bf16x8*)(lds + PG8_SB(b, h) + boff + n * 2048 + k * 1024); } while (0)
#define PG8_MMA(ai, bj, At, Bt) do { __builtin_amdgcn_s_setprio(1); _Pragma("unroll") for (int m = 0; m < 4; ++m) _Pragma("unroll") for (int n = 0; n < 2; ++n) _Pragma("unroll") for (int k = 0; k < 2; ++k) \
        acc[ai][bj][m][n] = __builtin_amdgcn_mfma_f32_16x16x32_bf16(Bt[n][k], At[m][k], acc[ai][bj][m][n], 0, 0, 0); __builtin_amdgcn_s_setprio(0); } while (0)
#define PG8_WAIT_V(n) asm volatile("s_waitcnt vmcnt(" #n ")" ::: "memory")
#define PG8_WAIT_L(n) asm volatile("s_waitcnt lgkmcnt(" #n ")" ::: "memory")
#define PG8_BAR __builtin_amdgcn_s_barrier()
#define PG8_SCHED __builtin_amdgcn_sched_barrier(0)
    Unit cur, nxt; int ui = 0;
    if (!S.next(0, cur)) return;
    f32x4 acc[2][2][4][2];
#pragma unroll
    for (int a = 0; a < 2; ++a)
#pragma unroll
        for (int b = 0; b < 2; ++b)
#pragma unroll
            for (int m = 0; m < 4; ++m)
#pragma unroll
                for (int n = 0; n < 2; ++n) acc[a][b][m][n] = (f32x4){0.f, 0.f, 0.f, 0.f};
    bf16x8 At[4][2], B0[2][2], B1[2][2];
    const char* cA = (const char*)g.A + (size_t)cur.pm * tstepA; const char* cB = (const char*)g.Bt + (size_t)cur.pn * tstepB;
    S.a_ready(cur);
    if constexpr (SP2) {
        PG8_STAGE(PG8_SB(0, 0), cB, voffB); PG8_STAGE(PG8_SB(0, 1), cB + hstepB, voffB); PG8_STAGE(PG8_SA(0, 0), cA, voffA); PG8_STAGE(PG8_SA(0, 1), cA + hstepA, voffA);
        if (wr == 1) PG8_BAR;
        PG8_WAIT_V(2); PG8_BAR;
        PG8_STAGE(PG8_SB(1, 0), cB + kstep, voffB); PG8_STAGE(PG8_SA(1, 0), cA + kstep, voffA); PG8_STAGE(PG8_SB(1, 1), cB + hstepB + kstep, voffB);
        PG8_WAIT_V(6); PG8_BAR;
    } else {
        PG8_STAGE(PG8_SB(0, 0), cB, voffB); PG8_STAGE(PG8_SA(0, 0), cA, voffA); PG8_STAGE(PG8_SB(0, 1), cB + hstepB, voffB); PG8_STAGE(PG8_SA(0, 1), cA + hstepA, voffA);
        if (wr == 1) PG8_BAR;
        PG8_WAIT_V(4); PG8_BAR;
        PG8_STAGE(PG8_SB(1, 0), cB + kstep, voffB); PG8_STAGE(PG8_SA(1, 0), cA + kstep, voffA); PG8_STAGE(PG8_SB(1, 1), cB + hstepB + kstep, voffB);
        PG8_WAIT_V(6); PG8_BAR;
    }
    for (;;) {
        const bool has_next = S.next(ui + 1, nxt);
        const char* nA = has_next ? (const char*)g.A + (size_t)nxt.pm * tstepA : cA; const char* nB = has_next ? (const char*)g.Bt + (size_t)nxt.pn * tstepB : cB;
#pragma unroll 1
        for (int t = 0; t < nt; t += 2) {
            const bool last = (t == nt - 2);
            const char* a1 = cA + (size_t)(t + 1) * kstep;
            const char* a2 = last ? nA : cA + (size_t)(t + 2) * kstep; const char* b2 = last ? nB : cB + (size_t)(t + 2) * kstep;
            const char* a3 = a2 + kstep; const char* b3 = b2 + kstep;
            if (last && has_next) S.a_ready(nxt);
            if constexpr (SP2) {
            PG8_LDB(B0, 0, 0); PG8_LDB(B1, 0, 1); PG8_SCHED; PG8_LDA(At, 0, 0); PG8_STAGE(PG8_SA(1, 1), a1 + hstepA, voffA);
            PG8_WAIT_V(8); PG8_WAIT_L(0); PG8_BAR; PG8_MMA(0, 0, At, B0); PG8_MMA(0, 1, At, B1); PG8_BAR; PG8_SCHED;
            PG8_LDA(At, 0, 1); PG8_STAGE(PG8_SB(0, 0), b2, voffB); PG8_STAGE(PG8_SB(0, 1), b2 + hstepB, voffB); PG8_STAGE(PG8_SA(0, 0), a2, voffA);
            PG8_WAIT_V(8); PG8_WAIT_L(0); PG8_BAR; PG8_MMA(1, 0, At, B0); PG8_MMA(1, 1, At, B1); PG8_BAR; PG8_SCHED;
            PG8_LDB(B0, 1, 0); PG8_LDB(B1, 1, 1); PG8_SCHED; PG8_LDA(At, 1, 0); PG8_STAGE(PG8_SA(0, 1), a2 + hstepA, voffA);
            PG8_WAIT_V(8); PG8_WAIT_L(0); PG8_BAR; PG8_MMA(0, 0, At, B0); PG8_MMA(0, 1, At, B1); PG8_BAR; PG8_SCHED;
            PG8_LDA(At, 1, 1); PG8_STAGE(PG8_SB(1, 0), b3, voffB); PG8_STAGE(PG8_SB(1, 1), b3 + hstepB, voffB); PG8_STAGE(PG8_SA(1, 0), a3, voffA);
            PG8_WAIT_V(8); PG8_WAIT_L(0); PG8_BAR; PG8_MMA(1, 0, At, B0); PG8_MMA(1, 1, At, B1); PG8_BAR; PG8_SCHED;
            } else {
            PG8_LDB(B0, 0, 0); PG8_SCHED; PG8_LDA(At, 0, 0); PG8_STAGE(PG8_SA(1, 1), a1 + hstepA, voffA);
            PG8_WAIT_L(8); PG8_BAR; PG8_WAIT_L(0); PG8_MMA(0, 0, At, B0); PG8_BAR; PG8_SCHED;
            PG8_LDB(B1, 0, 1); PG8_STAGE(PG8_SB(0, 0), b2, voffB);
            PG8_BAR; PG8_WAIT_L(0); PG8_MMA(0, 1, At, B1); PG8_BAR;
            PG8_LDA(At, 0, 1); PG8_STAGE(PG8_SA(0, 0), a2, voffA);
            PG8_BAR; PG8_WAIT_L(0); PG8_MMA(1, 0, At, B0); PG8_BAR; PG8_SCHED;
            PG8_STAGE(PG8_SB(0, 1), b2 + hstepB, voffB);
            PG8_WAIT_V(6); PG8_BAR; PG8_MMA(1, 1, At, B1); PG8_BAR;
            PG8_LDB(B0, 1, 0); PG8_SCHED; PG8_LDA(At, 1, 0); PG8_STAGE(PG8_SA(0, 1), a2 + hstepA, voffA);
            PG8_WAIT_L(8); PG8_BAR; PG8_WAIT_L(0); PG8_MMA(0, 0, At, B0); PG8_BAR; PG8_SCHED;
            PG8_LDB(B1, 1, 1); PG8_STAGE(PG8_SB(1, 0), b3, voffB);
            PG8_BAR; PG8_WAIT_L(0); PG8_MMA(0, 1, At, B1); PG8_BAR;
            PG8_LDA(At, 1, 1); PG8_STAGE(PG8_SA(1, 0), a3, voffA);
            PG8_BAR; PG8_WAIT_L(0); PG8_MMA(1, 0, At, B0); PG8_BAR; PG8_SCHED;
            PG8_STAGE(PG8_SB(1, 1), b3 + hstepB, voffB);
            PG8_WAIT_V(6); PG8_BAR; PG8_MMA(1, 1, At, B1); PG8_BAR;
            }
        }
        if constexpr (ALIGN_EPI) { if (wr == 0) PG8_BAR; }
        if constexpr (!Epi::AFTER_DRAIN) { E(acc, cur, wr, wc, fr, fq); S.done(cur); }
        if (!has_next) break;
#pragma unroll
        for (int a = 0; a < 2; ++a)
#pragma unroll
            for (int b = 0; b < 2; ++b)
#pragma unroll
                for (int m = 0; m < 4; ++m)
#pragma unroll
                    for (int n = 0; n < 2; ++n) acc[a][b][m][n] = (f32x4){0.f, 0.f, 0.f, 0.f};
        cur = nxt; cA = nA; cB = nB; ++ui;
        if constexpr (ALIGN_EPI) { if (wr == 1) PG8_BAR; }
    }
    PG8_WAIT_V(0);
    if constexpr (!ALIGN_EPI) { if (wr == 0) PG8_BAR; }
    PG8_BAR;
    if constexpr (Epi::AFTER_DRAIN) { E.fused(acc, cur, wr, wc, fr, fq, lds, wid, lane); S.done(cur); }
#undef PG8_SA
#undef PG8_SB
#undef PG8_STAGE
#undef PG8_LDA
#undef PG8_LDB
#undef PG8_MMA
#undef PG8_WAIT_V
#undef PG8_WAIT_L
#undef PG8_BAR
#undef PG8_SCHED
}
}
#else
namespace pg8 {
typedef unsigned short bf16_t;
constexpr int BM = 256, BK = 64, HALF = 128, STAGE_BYTES = 131072, NXCD = 8, WGM = 8;
struct Unit { int pm, pn; };
struct Gemm { const bf16_t* A; const bf16_t* Bt; int M, N, K, lda, ldb; };
struct StaticOrder {
    int nM, nN, nwg, G, c;
    void init(int M, int N, int G_, int c_) { nM = M / BM; nN = N / BM; nwg = nM * nN; G = G_; c = c_; }
    bool next(int i, Unit& u) const {
        const long L = (long)i * G + c; if (L >= nwg) return false;
        int wgid = (int)L; { const int q = nwg / NXCD, r = nwg % NXCD, xcd = wgid % NXCD, off = wgid / NXCD; wgid = (xcd < r ? xcd * (q + 1) : r * (q + 1) + (xcd - r) * q) + off; }
        const int nig = WGM * nN, gid = wgid / nig, fm = gid * WGM, gsz = (nM - fm) < WGM ? (nM - fm) : WGM;
        u.pm = fm + ((wgid % nig) % gsz); u.pn = (wgid % nig) / gsz; return true;
    }
};
template <class Epi, class Sched, bool ALIGN_EPI = false, bool SP2 = false>
static void gemm_phase(unsigned char*, const Gemm g, const Sched& S, const Epi& E) {
    const int tid = threadIdx.x, wid = tid >> 6, lane = tid & 63, wr = wid >> 2, wc = wid & 3, fr = lane & 15, fq = lane >> 4;
    Unit cur;
    for (int ui = 0; S.next(ui, cur); ++ui) {
        f32x4 acc[2][2][4][2];
        for (int ai = 0; ai < 2; ++ai) for (int bj = 0; bj < 2; ++bj) for (int m = 0; m < 4; ++m) for (int n = 0; n < 2; ++n) for (int e = 0; e < 4; ++e) {
            const int row = cur.pm * 256 + ai * 128 + wr * 64 + m * 16 + fr;
            const int col = cur.pn * 256 + bj * 128 + wc * 32 + (Epi::PERM ? 8 * fq + 4 * n + e : 16 * n + 4 * fq + e);
            float sum = 0.f; for (int k = 0; k < g.K; ++k) sum += bf2f(g.A[(size_t)row * g.lda + k]) * bf2f(g.Bt[(size_t)col * g.ldb + k]);
            acc[ai][bj][m][n][e] = sum; }
        E(acc, cur, wr, wc, fr, fq);
    }
}
}
#define PG8_LAS
#endif
typedef float f32x4_t __attribute__((ext_vector_type(4)));
typedef unsigned u32x4_t __attribute__((ext_vector_type(4)));
typedef unsigned u32x2_t __attribute__((ext_vector_type(2)));
#ifdef HOST_TEST
__device__ __forceinline__ unsigned pk2bf(float lo, float hi) { return (unsigned)f2bf(lo) | ((unsigned)f2bf(hi) << 16); }
#else
__device__ __forceinline__ unsigned pk2bf(float lo, float hi) { unsigned r; asm volatile("v_cvt_pk_bf16_f32 %0, %1, %2" : "=v"(r) : "v"(lo), "v"(hi)); return r; }
#endif

template <int MODE>
__device__ __forceinline__ void fp_wt(const float* __restrict__ W, const float* __restrict__ kscale, bf16_t* __restrict__ Wt, const int K, const int NO, const int NP) {
  for (long idx = gtid(); idx < (long)NP * (K / 8); idx += gsize()) {
    const int n = (int)(idx % NP), kc = (int)(idx / NP);
    const int src = MODE == 0 ? l0_src(n) : (MODE == 1 ? l1_src(n) : (n < NO ? n : -1));
    float v[8];
#pragma unroll
    for (int i = 0; i < 8; ++i) { v[i] = src >= 0 ? W[(size_t)(kc * 8 + i) * NO + src] : 0.f; if (MODE == 2 && kscale) v[i] *= kscale[kc * 8 + i]; }
    u32x4_t o; o.x = pk2bf(v[0], v[1]); o.y = pk2bf(v[2], v[3]); o.z = pk2bf(v[4], v[5]); o.w = pk2bf(v[6], v[7]);
    *(u32x4_t*)(Wt + (size_t)n * K + kc * 8) = o;
  }
}
__device__ __forceinline__ void fp_mod(const Params& p, float* ldsf) {
  float* sc = ldsf;
  float* red = ldsf + NV * DM;
  const int tid = threadIdx.x, jl = tid & 63, ks = tid >> 6;
  for (int i = tid; i < NV * DM; i += NTHREADS) sc[i] = silu_f(i < NB * DM ? p.c[i] : p.c_ctx[i - NB * DM]);
  __syncthreads();
  constexpr int NJB = 3 * DM / 64, KS = DM / 8;
  for (int item = blockIdx.x; item < 2 * NJB; item += gridDim.x) {
    const int l = item / NJB, j = (item % NJB) * 64 + jl;
    const float* w = l ? p.l1_w_mod : p.l0_w_mod; const float* bm = l ? p.l1_b_mod : p.l0_b_mod;
    float acc[NV];
#pragma unroll
    for (int v = 0; v < NV; ++v) acc[v] = 0.f;
    for (int k = ks * KS; k < (ks + 1) * KS; ++k) { const float wv = w[(size_t)k * 3 * DM + j];
#pragma unroll
      for (int v = 0; v < NV; ++v) acc[v] += sc[v * DM + k] * wv; }
#pragma unroll
    for (int v = 0; v < NV; ++v) red[(ks * NV + v) * 64 + jl] = acc[v];
    __syncthreads();
    for (int o = tid; o < NV * 64; o += NTHREADS) { const int v = o / 64, jj = o % 64; float t = bm[(item % NJB) * 64 + jj];
#pragma unroll
      for (int q = 0; q < 8; ++q) t += red[(q * NV + v) * 64 + jj];
      p.modv[((size_t)l * NV + v) * 3 * DM + (item % NJB) * 64 + jj] = t; }
    __syncthreads();
  }
}

template <int L> __device__ __forceinline__ void fp_sw_l(const Params& p, float* ldsf, const float* __restrict__ w) {
  float* sh = ldsf;
  float* red = ldsf + NV * DM;
  const int tid = threadIdx.x, jl = tid & 63, ks = tid >> 6;
  for (int i = tid; i < NV * DM; i += NTHREADS) { const int v = i / DM, k = i % DM; sh[i] = p.modv[((size_t)L * NV + v) * 3 * DM + k]; }
  __syncthreads();
  constexpr int NJB = LDP / 64, KS = DM / 8, NO = L ? N1 : N0;
  for (int item = blockIdx.x; item < NJB; item += gridDim.x) {
    const int j = item * 64 + jl;
    const int src = L ? l1_src(j) : l0_src(j);
    float acc[NV];
#pragma unroll
    for (int v = 0; v < NV; ++v) acc[v] = 0.f;
    if (src >= 0) {
#pragma unroll 8
      for (int k = ks * KS; k < (ks + 1) * KS; ++k) { const float wv = w[(size_t)k * NO + src];
#pragma unroll
        for (int v = 0; v < NV; ++v) acc[v] += sh[v * DM + k] * wv; } }
#pragma unroll
    for (int v = 0; v < NV; ++v) red[(ks * NV + v) * 64 + jl] = acc[v];
    __syncthreads();
    for (int o = tid; o < NV * 64; o += NTHREADS) { const int v = o / 64, jj = o % 64; float t = 0.f;
#pragma unroll
      for (int q = 0; q < 8; ++q) t += red[(q * NV + v) * 64 + jj];
      p.sw[((size_t)L * NV + v) * LDP + item * 64 + jj] = t; }
    __syncthreads();
  }
  __syncthreads();
}
__device__ __forceinline__ void fp_sw(const Params& p, float* ldsf) { fp_sw_l<0>(p, ldsf, p.l0_w_in); fp_sw_l<1>(p, ldsf, p.l1_w_in); }
__device__ __forceinline__ void fp_zero(const Params& p) {
  for (long i = gtid(); i < (long)RPOS * 8; i += gsize()) { const int pos = (int)(i / 8), e = (int)(i % 8); float sn, cs; sincosf((float)pos * rope_inv(e), &sn, &cs); p.ropet[i] = cs; p.ropet[RPOS * 8 + i] = sn; }
  for (long i = gtid(); i < M; i += gsize()) { p.ssq_q[i] = 0.f; p.ssq_kv[i] = 0.f; p.ssq1[i] = 0.f; p.ssq0[i] = 0.f; if (i < MLAT) p.ssq2[i] = 0.f; }
}
__device__ __forceinline__ float wave_sum(float v) {
#pragma unroll
  for (int o = 1; o < 64; o <<= 1) v += __shfl_xor(v, o);
  return v;
}
__device__ __forceinline__ void fp_prep0(const Params& p) {
  const int lane = threadIdx.x & 63, gw = (int)(gtid() >> 6), ngw = (int)(gsize() >> 6);
  for (int m = gw; m < M; m += ngw) {
    const float* xr = row_input(p, m); const int v = row_variant(m);
    const float* sc = p.modv + ((size_t)0 * NV + v) * 3 * DM + DM;
    float ss = 0.f;
    for (int c = lane * 4; c < DM; c += 256) {
      const f32x4_t xv = *(const f32x4_t*)(xr + c), g = *(const f32x4_t*)(p.l0_norm + c), s1 = *(const f32x4_t*)(sc + c);
      ss += xv.x * xv.x + xv.y * xv.y + xv.z * xv.z + xv.w * xv.w;
      u32x2_t o; o.x = pk2bf(xv.x * g.x * (1.f + s1.x), xv.y * g.y * (1.f + s1.y)); o.y = pk2bf(xv.z * g.z * (1.f + s1.z), xv.w * g.w * (1.f + s1.w));
      *(u32x2_t*)(p.A0 + (size_t)m * LDA + c) = o; }
    ss = wave_sum(ss);
    if (lane == 0) p.ssq0[m] = ss;
  }
}
__device__ __forceinline__ void fp_gm1(const Params& p) {
  for (long idx = gtid(); idx < (long)NV * DM; idx += gsize()) { const int v = (int)(idx / DM), k = (int)(idx % DM);
    p.gm1[idx] = p.l1_norm[k] * (1.f + p.modv[((size_t)1 * NV + v) * 3 * DM + DM + k]); }
}

__device__ __forceinline__ void rope8(const float* __restrict__ ropet, f32x4_t& v0, f32x4_t& v1, const int fq, const int tl) {
  const int pos = fq < 2 ? tl / GW : tl % GW; const bool first = (fq & 1) == 0;
  const f32x4_t c0 = *(const f32x4_t*)(ropet + pos * 8), c1 = *(const f32x4_t*)(ropet + pos * 8 + 4), s0 = *(const f32x4_t*)(ropet + RPOS * 8 + pos * 8), s1 = *(const f32x4_t*)(ropet + RPOS * 8 + pos * 8 + 4);
#pragma unroll
  for (int e = 0; e < 8; ++e) {
    const float own = e < 4 ? v0[e & 3] : v1[e & 3]; const float oth = __shfl_xor(own, 16);
    const float cs = e < 4 ? c0[e & 3] : c1[e & 3], sn = e < 4 ? s0[e & 3] : s1[e & 3];
    const float r = first ? own * cs - oth * sn : own * cs + oth * sn;
    if (e < 4) v0[e & 3] = r; else v1[e & 3] = r;
  }
}
template <int L> struct EpiIn {
  static constexpr bool PERM = true, AFTER_DRAIN = false;
  bf16_t* Pb; const float* ssq; const float* sw; float* ssq_q; float* ssq_kv; const float* ropet;
  __device__ __forceinline__ void operator()(const f32x4_t (&acc)[2][2][4][2], const pg8::Unit& u, int wr, int wc, int fr, int fq) const {
    const int r0 = u.pm * 256, tt = r0 % TB, b = r0 / TB; const bool latent = tt >= CTX; const int v = latent ? b : NB;
    const float* swv = sw + (size_t)v * LDP;
    float rstd[2][4];
#pragma unroll
    for (int ai = 0; ai < 2; ++ai)
#pragma unroll
      for (int m = 0; m < 4; ++m) rstd[ai][m] = rsqrtf(ssq[r0 + ai * 128 + wr * 64 + m * 16 + fr] * (1.f / DM) + EPS);
#pragma unroll
    for (int bj = 0; bj < 2; ++bj) {
      const int cg = u.pn * 256 + bj * 128 + wc * 32, c0 = cg + 8 * fq;
      const f32x4_t s0 = *(const f32x4_t*)(swv + c0), s1 = *(const f32x4_t*)(swv + c0 + 4);
      const bool is_rope = L == 0 && cg == P0_KR && latent;
      const int seg = L == 0 ? (cg < QR ? 1 : (cg < QR + KVR ? 2 : 0)) : 0;
#pragma unroll
      for (int ai = 0; ai < 2; ++ai)
#pragma unroll
        for (int m = 0; m < 4; ++m) {
          const int row = r0 + ai * 128 + wr * 64 + m * 16 + fr;
          f32x4_t v0 = acc[ai][bj][m][0] * rstd[ai][m] + s0, v1 = acc[ai][bj][m][1] * rstd[ai][m] + s1;
          if (seg) { float q = v0.x * v0.x + v0.y * v0.y + v0.z * v0.z + v0.w * v0.w + v1.x * v1.x + v1.y * v1.y + v1.z * v1.z + v1.w * v1.w;
            q += __shfl_xor(q, 16); q += __shfl_xor(q, 32); if (fq == 0) atomicAdd(seg == 1 ? &ssq_q[row] : &ssq_kv[row], q); }
          if (is_rope) rope8(ropet, v0, v1, fq, tt - CTX + ai * 128 + wr * 64 + m * 16 + fr);
          u32x4_t o; o.x = pk2bf(v0.x, v0.y); o.y = pk2bf(v0.z, v0.w); o.z = pk2bf(v1.x, v1.y); o.w = pk2bf(v1.z, v1.w);
          *(u32x4_t*)(Pb + (size_t)row * LDP + c0) = o;
        }
    }
  }
};
struct EpiQ {
  static constexpr bool PERM = true, AFTER_DRAIN = false;
  bf16_t* qb; const float* ssq_q; const float* ropet;
  __device__ __forceinline__ void operator()(const f32x4_t (&acc)[2][2][4][2], const pg8::Unit& u, int wr, int wc, int fr, int fq) const {
    const int r0 = u.pm * 256, tt = r0 % TB; const bool latent = tt >= CTX;
    float rsv[2][4];
#pragma unroll
    for (int ai = 0; ai < 2; ++ai)
#pragma unroll
      for (int m = 0; m < 4; ++m) rsv[ai][m] = rsqrtf(ssq_q[r0 + ai * 128 + wr * 64 + m * 16 + fr] * (1.f / QR) + EPS);
#pragma unroll
    for (int bj = 0; bj < 2; ++bj) {
      const int cg = u.pn * 256 + bj * 128 + wc * 32, c0 = cg + 8 * fq;
      const bool is_rope = latent && ((cg / 32) % 3 == 2);
#pragma unroll
      for (int ai = 0; ai < 2; ++ai)
#pragma unroll
        for (int m = 0; m < 4; ++m) {
          const int row = r0 + ai * 128 + wr * 64 + m * 16 + fr;
          const float rs = rsv[ai][m];
          f32x4_t v0 = acc[ai][bj][m][0] * rs, v1 = acc[ai][bj][m][1] * rs;
          if (is_rope) rope8(ropet, v0, v1, fq, tt - CTX + ai * 128 + wr * 64 + m * 16 + fr);
          v0 = v0 * C2Q; v1 = v1 * C2Q;
          u32x4_t o; o.x = pk2bf(v0.x, v0.y); o.y = pk2bf(v0.z, v0.w); o.z = pk2bf(v1.x, v1.y); o.w = pk2bf(v1.z, v1.w);
          if (c0 < QW) *(u32x4_t*)(qb + (size_t)row * QW + c0) = o;
        }
    }
  }
};
struct EpiKV {
  static constexpr bool PERM = true, AFTER_DRAIN = false;
  bf16_t* kn; bf16_t* vb; const float* ssq_kv;
  __device__ __forceinline__ void operator()(const f32x4_t (&acc)[2][2][4][2], const pg8::Unit& u, int wr, int wc, int fr, int fq) const {
    const int r0 = u.pm * 256;
    float rsv[2][4];
#pragma unroll
    for (int ai = 0; ai < 2; ++ai)
#pragma unroll
      for (int m = 0; m < 4; ++m) rsv[ai][m] = rsqrtf(ssq_kv[r0 + ai * 128 + wr * 64 + m * 16 + fr] * (1.f / KVR) + EPS);
#pragma unroll
    for (int bj = 0; bj < 2; ++bj) {
      const int cg = u.pn * 256 + bj * 128 + wc * 32, G = cg / 32, hh = G / 4, part = G % 4;
      bf16_t* dst = (part < 2 ? kn : vb) + hh * 64 + (part & 1) * 32 + 8 * fq;
#pragma unroll
      for (int ai = 0; ai < 2; ++ai)
#pragma unroll
        for (int m = 0; m < 4; ++m) {
          const int row = r0 + ai * 128 + wr * 64 + m * 16 + fr;
          const float rs = rsv[ai][m];
          const f32x4_t v0 = acc[ai][bj][m][0] * rs, v1 = acc[ai][bj][m][1] * rs;
          u32x4_t o; o.x = pk2bf(v0.x, v0.y); o.y = pk2bf(v0.z, v0.w); o.z = pk2bf(v1.x, v1.y); o.w = pk2bf(v1.z, v1.w);
          if (cg < KVW) *(u32x4_t*)(dst + (size_t)row * BRA) = o;
        }
    }
  }
};
#ifndef EPI_MB
#define EPI_MB 2
#endif
struct EpiOut0 {
  static constexpr bool PERM = false, AFTER_DRAIN = false;
  const float* x; const float* ctx; const float* modv; const float* gm1; float* out; bf16_t* A1; float* ssq1;
  __device__ __forceinline__ void operator()(const f32x4_t (&acc)[2][2][4][2], const pg8::Unit& u, int wr, int wc, int fr, int fq) const {
    const int r0 = u.pm * 256, tt = r0 % TB, b = r0 / TB; const bool latent = tt >= CTX; const int v = latent ? b : NB;
    const float* gate = modv + ((size_t)0 * NV + v) * 3 * DM + 2 * DM; const float* gm = gm1 + (size_t)v * DM;
    const int cb = u.pn * 256 + wc * 32 + fq * 4;
    f32x4_t gt[2][2], gv[2][2];
#pragma unroll
    for (int bj = 0; bj < 2; ++bj)
#pragma unroll
      for (int n = 0; n < 2; ++n) { gt[bj][n] = *(const f32x4_t*)(gate + cb + bj * 128 + n * 16); gv[bj][n] = *(const f32x4_t*)(gm + cb + bj * 128 + n * 16); }
    const float* xb = latent ? x + ((size_t)b * SEQ + (tt - CTX)) * DM : ctx + ((size_t)b * CTX + tt) * DM;
    float* ob = latent ? out + ((size_t)b * SEQ + (tt - CTX)) * DM : out;
#pragma unroll
    for (int ai = 0; ai < 2; ++ai)
#pragma unroll
      for (int mb = 0; mb < 4; mb += EPI_MB) {
        f32x4_t xv[EPI_MB][2][2];
#pragma unroll
        for (int mm = 0; mm < EPI_MB; ++mm)
#pragma unroll
          for (int bj = 0; bj < 2; ++bj)
#pragma unroll
            for (int n = 0; n < 2; ++n) xv[mm][bj][n] = *(const f32x4_t*)(xb + (unsigned)((ai * 128 + wr * 64 + (mb + mm) * 16 + fr) * DM + cb + bj * 128 + n * 16));
#pragma unroll
        for (int mm = 0; mm < EPI_MB; ++mm) {
          const int m = mb + mm, rl = ai * 128 + wr * 64 + m * 16 + fr, row = r0 + rl; float q = 0.f;
#pragma unroll
          for (int bj = 0; bj < 2; ++bj)
#pragma unroll
            for (int n = 0; n < 2; ++n) {
              const int co = cb + bj * 128 + n * 16;
              const f32x4_t h1 = xv[mm][bj][n] + gt[bj][n] * acc[ai][bj][m][n];
              q += h1.x * h1.x + h1.y * h1.y + h1.z * h1.z + h1.w * h1.w;
              if (latent) *(f32x4_t*)(ob + (unsigned)(rl * DM + co)) = h1;
              const f32x4_t a = h1 * gv[bj][n];
              u32x2_t o; o.x = pk2bf(a.x, a.y); o.y = pk2bf(a.z, a.w);
              *(u32x2_t*)(A1 + (size_t)row * LDA + co) = o;
            }
          q += __shfl_xor(q, 16); q += __shfl_xor(q, 32); if (fq == 0) atomicAdd(&ssq1[row], q);
        }
      }
  }
};
struct EpiOut1 {
  static constexpr bool PERM = false, AFTER_DRAIN = false;
  const float* modv; float* out; float* ssq2;
  __device__ __forceinline__ void operator()(const f32x4_t (&acc)[2][2][4][2], const pg8::Unit& u, int wr, int wc, int fr, int fq) const {
    const int r0 = u.pm * 256, b = r0 / SEQ;
    const float* gate = modv + ((size_t)1 * NV + b) * 3 * DM + 2 * DM;
    const int cb = u.pn * 256 + wc * 32 + fq * 4;
    f32x4_t gt[2][2];
#pragma unroll
    for (int bj = 0; bj < 2; ++bj)
#pragma unroll
      for (int n = 0; n < 2; ++n) gt[bj][n] = *(const f32x4_t*)(gate + cb + bj * 128 + n * 16);
    float* ob = out + (size_t)r0 * DM;
#pragma unroll
    for (int ai = 0; ai < 2; ++ai)
#pragma unroll
      for (int mb = 0; mb < 4; mb += EPI_MB) {
        f32x4_t xv[EPI_MB][2][2];
#pragma unroll
        for (int mm = 0; mm < EPI_MB; ++mm)
#pragma unroll
          for (int bj = 0; bj < 2; ++bj)
#pragma unroll
            for (int n = 0; n < 2; ++n) xv[mm][bj][n] = *(const f32x4_t*)(ob + (unsigned)((ai * 128 + wr * 64 + (mb + mm) * 16 + fr) * DM + cb + bj * 128 + n * 16));
#pragma unroll
        for (int mm = 0; mm < EPI_MB; ++mm) {
          const int m = mb + mm, rl = ai * 128 + wr * 64 + m * 16 + fr; float q = 0.f;
#pragma unroll
          for (int bj = 0; bj < 2; ++bj)
#pragma unroll
            for (int n = 0; n < 2; ++n) {
              const f32x4_t h2 = xv[mm][bj][n] + gt[bj][n] * acc[ai][bj][m][n];
              q += h2.x * h2.x + h2.y * h2.y + h2.z * h2.z + h2.w * h2.w;
              *(f32x4_t*)(ob + (unsigned)(rl * DM + cb + bj * 128 + n * 16)) = h2;
            }
          q += __shfl_xor(q, 16); q += __shfl_xor(q, 32); if (fq == 0) atomicAdd(&ssq2[r0 + rl], q);
        }
      }
  }
};
template <class Epi> __device__ __forceinline__ void run_gemm(unsigned char* lds, const bf16_t* A, int lda, const bf16_t* Bt, int ldb, int Mr, int N, int K, const Epi& E) {
  pg8::Gemm g{A, Bt, Mr, N, K, lda, ldb}; pg8::StaticOrder S; S.init(Mr, N, (int)gridDim.x, (int)blockIdx.x);
  pg8::gemm_phase<Epi, pg8::StaticOrder, true, true>((PG8_LAS unsigned char*)lds, g, S, E);
}
__device__ __forceinline__ void fp_final(const Params& p) {
  const int lane = threadIdx.x & 63, gw = (int)(gtid() >> 6), ngw = (int)(gsize() >> 6);
  for (int ml = gw; ml < MLAT; ml += ngw) {
    const float rstd = rsqrtf(p.ssq2[ml] * (1.f / DM) + EPS); float* r = p.out + (size_t)ml * DM;
    for (int c = lane * 4; c < DM; c += 256) { const f32x4_t h = *(const f32x4_t*)(r + c), g = *(const f32x4_t*)(p.final_norm + c); *(f32x4_t*)(r + c) = h * rstd * g; }
  }
}


typedef short bf16x8_t __attribute__((ext_vector_type(8)));
typedef short s16x4_t __attribute__((ext_vector_type(4)));
typedef float f32x16_t __attribute__((ext_vector_type(16)));
#ifdef HOST_TEST
#define SBAR()
#define MFMA_ASM_PAD()
#define LGKM_WAIT()
#define VM_WAIT3()
#define VM_WAIT0()
__device__ __forceinline__ unsigned cvtpk(float lo, float hi) { return pk2bf(lo, hi); }
#define MFMA32(a, b, c) shim_mfma_32x32x16(a, b, c)
#define MFMA16(a, b, c) shim_mfma_16x16x32(a, b, c)
#define TR_READ(vb, OFF) shim_tr_read((vb) + (OFF))
#define LDS_ADDR(ptr) ((int)((const unsigned char*)(ptr) - g_lds_base))
#define EXP2F(x) exp2f(x)
#define RCPF(x) (1.f / (x))
#else
#define SBAR() __builtin_amdgcn_sched_barrier(0)
#define MFMA_ASM_PAD() do { __builtin_amdgcn_sched_barrier(0); asm volatile("s_nop 15\n\ts_nop 3" ::: "memory"); __builtin_amdgcn_sched_barrier(0); } while (0)
#define LGKM_WAIT() asm volatile("s_waitcnt lgkmcnt(0)" ::: "memory")
#define VM_WAIT3() asm volatile("s_waitcnt vmcnt(3)" ::: "memory")
#define VM_WAIT0() asm volatile("s_waitcnt vmcnt(0)" ::: "memory")
__device__ __forceinline__ unsigned cvtpk(float lo, float hi) { unsigned r; asm volatile("v_cvt_pk_bf16_f32 %0, %1, %2" : "=v"(r) : "v"(lo), "v"(hi)); return r; }
#define MFMA32(a, b, c) __builtin_amdgcn_mfma_f32_32x32x16_bf16(a, b, c, 0, 0, 0)
#define MFMA16(a, b, c) __builtin_amdgcn_mfma_f32_16x16x32_bf16(a, b, c, 0, 0, 0)
template <int OFF> __device__ __forceinline__ s16x4_t tr_read_dev(int vb) { s16x4_t r; asm volatile("ds_read_b64_tr_b16 %0, %1 offset:%2" : "=&v"(r) : "v"(vb), "i"(OFF) : "memory"); return r; }
#define TR_READ(vb, OFF) tr_read_dev<OFF>(vb)
#define LDS_ADDR(ptr) ((int)(uintptr_t)(ptr))
#define EXP2F(x) __builtin_amdgcn_exp2f(x)
#define RCPF(x) __builtin_amdgcn_rcpf(x)
#endif
namespace att {
constexpr int NW = 8, QBLK = 32, KVBLK = 64;
constexpr int SHM_K = KVBLK * 256, SHM_V = KVBLK * 128 * 2;
constexpr int NBUF = 3;
constexpr int OFF_V = 0, OFF_K = NBUF * SHM_V, OFF_WS = NBUF * SHM_V + NBUF * SHM_K, LDS_ATT = OFF_WS + NW * 64 * 4;
constexpr float THR2 = 11.5f;
#define KSWZ(row, colB) ((row) * 256 + ((colB) ^ (((row) & 7) << 4)))
__device__ __forceinline__ int crow(int r, int hi) { return (r & 3) + 8 * (r >> 2) + 4 * hi; }
__device__ __forceinline__ void partialSM(f32x16_t& p0, f32x16_t& p1, float& m_reg, float& mn, float& alpha) {
  float pmax = p0[0];
#pragma unroll
  for (int r = 1; r < 16; ++r) pmax = fmaxf(pmax, p0[r]);
#pragma unroll
  for (int r = 0; r < 16; ++r) pmax = fmaxf(pmax, p1[r]);
  { auto rr = __builtin_amdgcn_permlane32_swap(__builtin_bit_cast(unsigned, pmax), __builtin_bit_cast(unsigned, pmax), false, false);
    pmax = fmaxf(__builtin_bit_cast(float, (unsigned)rr[0]), __builtin_bit_cast(float, (unsigned)rr[1])); }
  if (__all(pmax - m_reg <= THR2)) { mn = m_reg; alpha = 1.f; }
  else { mn = fmaxf(m_reg, pmax); alpha = EXP2F(m_reg - mn); m_reg = mn; }
#pragma unroll
  for (int r = 0; r < 16; ++r) { p0[r] -= mn; p1[r] -= mn; }
#pragma unroll
  for (int r = 0; r < 16; ++r) p0[r] = EXP2F(p0[r]);
}
__device__ __forceinline__ void finishSM(f32x16_t& p0, f32x16_t& p1, float alpha, float& l_reg, bf16x8_t& pa0, bf16x8_t& pa1, bf16x8_t& pa2, bf16x8_t& pa3) {
#pragma unroll
  for (int r = 0; r < 16; ++r) p1[r] = EXP2F(p1[r]);
  float ps = 0.f;
#pragma unroll
  for (int r = 0; r < 16; ++r) ps += p0[r];
#pragma unroll
  for (int r = 0; r < 16; ++r) ps += p1[r];
  { auto rr = __builtin_amdgcn_permlane32_swap(__builtin_bit_cast(unsigned, ps), __builtin_bit_cast(unsigned, ps), false, false);
    ps = __builtin_bit_cast(float, (unsigned)rr[0]) + __builtin_bit_cast(float, (unsigned)rr[1]); }
  l_reg = l_reg * alpha + ps;
#define PK4(P, BASE, OUT) do { unsigned a0 = cvtpk(P[BASE + 0], P[BASE + 1]), a1 = cvtpk(P[BASE + 2], P[BASE + 3]);   \
    unsigned b0 = cvtpk(P[BASE + 4], P[BASE + 5]), b1 = cvtpk(P[BASE + 6], P[BASE + 7]);                              \
    auto r0 = __builtin_amdgcn_permlane32_swap(a0, b0, false, false); auto r1 = __builtin_amdgcn_permlane32_swap(a1, b1, false, false); \
    u32x4_t w = {(unsigned)r0[0], (unsigned)r1[0], (unsigned)r0[1], (unsigned)r1[1]}; OUT = __builtin_bit_cast(bf16x8_t, w); } while (0)
  PK4(p0, 0, pa0); PK4(p0, 8, pa1); PK4(p1, 0, pa2); PK4(p1, 8, pa3);
#undef PK4
}
__device__ __forceinline__ void qkt(f32x16_t& p0, f32x16_t& p1, const unsigned char* Ks, const bf16x8_t* qr, int r32, int hi) {
#pragma unroll
  for (int r = 0; r < 16; ++r) { p0[r] = 0.f; p1[r] = 0.f; }
#pragma unroll
  for (int d0 = 0; d0 < 6; ++d0) { const int cb = (d0 * 16 + hi * 8) * 2;
    const bf16x8_t b0 = *reinterpret_cast<const bf16x8_t*>(Ks + KSWZ(r32, cb));
    const bf16x8_t b1 = *reinterpret_cast<const bf16x8_t*>(Ks + KSWZ(32 + r32, cb));
    p0 = MFMA32(b0, qr[d0], p0); p1 = MFMA32(b1, qr[d0], p1); }
}
__device__ __forceinline__ int v_st(int k, int c) { const int kk = (k & ~0xC) | ((k & 4) << 1) | ((k & 8) >> 1); return ((kk >> 3) * 4 + (c >> 5)) * 512 + ((kk & 7) * 32 + (c & 31)) * 2; }
__device__ __forceinline__ int v_rd_base(int lane) { return ((lane & 3) << 3) | (((lane >> 2) & 3) << 6) | (((lane >> 4) & 1) << 5) | (((lane >> 5) & 1) << 8); }
constexpr int v_rd_off(int d0, int ks, int half) { return d0 * 512 + ks * 4096 + half * 2048; }
template <int D0> __device__ __forceinline__ void pv_one(f32x16_t& od, int vb, bf16x8_t pa0, bf16x8_t pa1, bf16x8_t pa2, bf16x8_t pa3) {
  const s16x4_t l0 = TR_READ(vb, v_rd_off(D0, 0, 0)), h0 = TR_READ(vb, v_rd_off(D0, 0, 1)), l1 = TR_READ(vb, v_rd_off(D0, 1, 0)), h1 = TR_READ(vb, v_rd_off(D0, 1, 1));
  const s16x4_t l2 = TR_READ(vb, v_rd_off(D0, 2, 0)), h2 = TR_READ(vb, v_rd_off(D0, 2, 1)), l3 = TR_READ(vb, v_rd_off(D0, 3, 0)), h3 = TR_READ(vb, v_rd_off(D0, 3, 1));
  LGKM_WAIT(); SBAR();
#define PKV(L, H) (bf16x8_t){L[0], L[1], L[2], L[3], H[0], H[1], H[2], H[3]}
  od = MFMA32(pa0, PKV(l0, h0), od); od = MFMA32(pa1, PKV(l1, h1), od); od = MFMA32(pa2, PKV(l2, h2), od); od = MFMA32(pa3, PKV(l3, h3), od);
#undef PKV
}
__device__ __forceinline__ void pv_d0(f32x16_t* o, int vb, bf16x8_t pa0, bf16x8_t pa1, bf16x8_t pa2, bf16x8_t pa3) {
  pv_one<0>(o[0], vb, pa0, pa1, pa2, pa3); pv_one<1>(o[1], vb, pa0, pa1, pa2, pa3);
}
__device__ __forceinline__ void attn_unit(const bf16_t* __restrict__ Qb, const bf16_t* __restrict__ Kn, const bf16_t* __restrict__ Kr, const bf16_t* __restrict__ Vh, const int nkeys,
                                          bf16_t* __restrict__ Ob, const bf16_t* __restrict__ Zb, unsigned char* lds) {
  const int tid = threadIdx.x, wid = tid >> 6, lane = tid & 63, r32 = lane & 31, hi = lane >> 5;
  unsigned char* V_lds = lds + OFF_V; unsigned char* K_lds = lds + OFF_K;
  float* wsf = (float*)(lds + OFF_WS) + wid * 64; float* li_l = wsf; float* al_l = wsf + 32;
  float m_reg = -1e30f, l_reg = 0.f; f32x16_t o[2]; bf16x8_t qr[6];
#pragma unroll
  for (int r = 0; r < 16; ++r) { o[0][r] = 0.f; o[1][r] = 0.f; }
  { const unsigned offq = (unsigned)((wid * QBLK + r32) * QW + hi * 8);
#pragma unroll
    for (int d0 = 0; d0 < 6; ++d0) qr[d0] = *reinterpret_cast<const bf16x8_t*>(Qb + offq + d0 * 16); }
  const int vb0 = LDS_ADDR(V_lds) + v_rd_base(lane);
  bf16x8_t sA_kn, sA_kr, sA_v, sB_kn, sB_kr, sB_v;
#ifdef HOST_TEST
#define OPAQUE_TID() const int t_ = tid
#else
#define OPAQUE_TID() int t_ = tid; asm volatile("" : "+v"(t_))
#endif
#define SLOAD(S, k0) do { OPAQUE_TID(); const int srow_ = t_ >> 3, sc8_ = t_ & 7, rrow_ = (t_ & 255) >> 2, cr_ = t_ & 3; \
    const unsigned offn_ = (unsigned)(srow_ * BRA + sc8_ * 8), offr_ = (unsigned)(rrow_ * LDP + cr_ * 8); \
    const bf16_t* kn_t = Kn + (size_t)(k0) * BRA; const bf16_t* kr_t = Kr + (size_t)(k0) * LDP; const bf16_t* v_t = Vh + (size_t)(k0) * BRA; \
    S##_kn = *reinterpret_cast<const bf16x8_t*>(kn_t + offn_); S##_kr = *reinterpret_cast<const bf16x8_t*>(kr_t + offr_); S##_v = *reinterpret_cast<const bf16x8_t*>(v_t + offn_); } while (0)
#define SWRITE(b, S) do { OPAQUE_TID(); const int srow_ = t_ >> 3, sc8_ = t_ & 7, rrow_ = (t_ & 255) >> 2, cr_ = t_ & 3; \
    *reinterpret_cast<bf16x8_t*>(K_lds + (b) * SHM_K + KSWZ(srow_, sc8_ * 16)) = S##_kn; *reinterpret_cast<bf16x8_t*>(K_lds + (b) * SHM_K + KSWZ(rrow_, (8 + cr_) * 16)) = S##_kr; \
    *reinterpret_cast<bf16x8_t*>(V_lds + (b) * SHM_V + v_st(srow_, sc8_ * 8)) = S##_v; } while (0)
#define RESC(a) do { if (__any((a) < 1.f)) { if (hi == 0) al_l[r32] = (a); WAVE_LDS_SYNC(); \
    _Pragma("unroll") for (int r = 0; r < 16; ++r) { const float f = al_l[crow(r, hi)]; o[0][r] *= f; o[1][r] *= f; } WAVE_LDS_SYNC(); } } while (0)
  f32x16_t pA0, pA1, pB0, pB1; float mnA, mnB, alA, alB; bf16x8_t pa0, pa1, pa2, pa3; const int NT = nkeys / KVBLK;
  SLOAD(sA, 0); VM_WAIT0(); SWRITE(0, sA); __syncthreads();
  qkt(pA0, pA1, K_lds, qr, r32, hi); partialSM(pA0, pA1, m_reg, mnA, alA);
  SLOAD(sB, KVBLK); if (2 < NT) SLOAD(sA, 2 * KVBLK);
  VM_WAIT3(); SWRITE(1, sB); __syncthreads();
  int bc = 0, bn = 1, bw = 2;
#define ROT() do { const int t_ = bc; bc = bn; bn = bw; bw = t_; } while (0)
#pragma unroll 1
  for (int j = 1; j + 1 < NT; j += 2) {
    SBAR(); qkt(pB0, pB1, K_lds + bn * SHM_K, qr, r32, hi);
    finishSM(pA0, pA1, alA, l_reg, pa0, pa1, pa2, pa3); SBAR();
    SLOAD(sB, (j + 2) * KVBLK); SBAR();
    pv_d0(o, vb0 + bc * SHM_V, pa0, pa1, pa2, pa3); partialSM(pB0, pB1, m_reg, mnB, alB);
    VM_WAIT3(); SWRITE(bw, sA);
    RESC(alB); __syncthreads(); ROT();
    SBAR(); qkt(pA0, pA1, K_lds + bn * SHM_K, qr, r32, hi);
    finishSM(pB0, pB1, alB, l_reg, pa0, pa1, pa2, pa3); SBAR();
    if (j + 3 < NT) SLOAD(sA, (j + 3) * KVBLK); SBAR();
    pv_d0(o, vb0 + bc * SHM_V, pa0, pa1, pa2, pa3); partialSM(pA0, pA1, m_reg, mnA, alA);
    VM_WAIT3(); SWRITE(bw, sB);
    RESC(alA); __syncthreads(); ROT();
  }
  SBAR(); qkt(pB0, pB1, K_lds + bn * SHM_K, qr, r32, hi);
  finishSM(pA0, pA1, alA, l_reg, pa0, pa1, pa2, pa3); SBAR();
  pv_d0(o, vb0 + bc * SHM_V, pa0, pa1, pa2, pa3); partialSM(pB0, pB1, m_reg, mnB, alB);
  RESC(alB);
  finishSM(pB0, pB1, alB, l_reg, pa0, pa1, pa2, pa3); SBAR();
  pv_d0(o, vb0 + bn * SHM_V, pa0, pa1, pa2, pa3);
  __syncthreads();
#undef ROT
  if (hi == 0) li_l[r32] = l_reg;
  WAVE_LDS_SYNC();
  float rli[16];
#pragma unroll
  for (int r = 0; r < 16; ++r) rli[r] = RCPF(li_l[crow(r, hi)]);
  WAVE_LDS_SYNC();
#pragma unroll
  for (int r = 0; r < 16; ++r) { const unsigned orow = (unsigned)(wid * QBLK + crow(r, hi));
#pragma unroll
    for (int d0 = 0; d0 < 2; ++d0) { const unsigned col = (unsigned)(d0 * 32 + r32); const float z = bf2f(Zb[orow * LDP + col]);
      Ob[orow * LDA + col] = f2bf(o[d0][r] * rli[r] * silu_f(z)); } }
#undef SLOAD
#undef SWRITE
#undef RESC
#undef OPAQUE_TID
}
}
__device__ __forceinline__ void fp_attn(const Params& p, unsigned char* lds) {
  const int G = (int)gridDim.x, bx = (int)blockIdx.x; const int vcu = (G % 8 == 0) ? (bx % 8) * (G / 8) + bx / 8 : bx;
  constexpr int QPB = SEQ / 256, NLAT = NB * MLA_H * QPB, NCTXU = NB * MLA_H;
#pragma unroll 1
  for (int u = vcu; u < NLAT + NCTXU; u += G) {
    int b, h, t0, nkeys;
    if (u < NLAT) { const int bh = u / QPB, qblk = u % QPB; b = bh / MLA_H; h = bh % MLA_H; t0 = CTX + qblk * 256; nkeys = TB; }
    else { const int bh = u - NLAT; b = bh / MLA_H; h = bh % MLA_H; t0 = 0; nkeys = CTX; }
    const size_t m0 = (size_t)b * TB + t0, k0 = (size_t)b * TB;
    att::attn_unit(p.qb + m0 * QW + h * QD, p.kn + k0 * BRA + h * NOPE, p.Pb + k0 * LDP + P0_KR, p.vb + k0 * BRA + h * VD, nkeys,
                   p.A0 + m0 * LDA + h * VD, p.Pb + m0 * LDP + P0_Z + h * VD, lds);
  }
}


namespace scan {
constexpr int VT_LD = 72;
constexpr int NSEG = 8;
struct WaveLds { bf16_t vt[32 * VT_LD]; float Tg[64], Te1[64], Te2[64], Tw2[64], Tden[64], Tinv[64]; int Trow[64]; float Tn[128]; };
static_assert(sizeof(WaveLds) % 16 == 0, "per-wave LDS block alignment");
constexpr int ST_STRIDE = 4096 + 128 + 8;
__device__ __forceinline__ float wave_psum(float v, int lane) {
#pragma unroll
  for (int d = 1; d < 64; d <<= 1) { const float o = __shfl_up(v, d); if (lane >= d) v += o; }
  return v;
}
__device__ __forceinline__ float wave_pmax(float v, int lane) {
#pragma unroll
  for (int d = 1; d < 64; d <<= 1) { const float o = __shfl_up(v, d); if (lane >= d) v = fmaxf(v, o); }
  return v;
}
__device__ __forceinline__ int crow(int r, int hi) { return (r & 3) + 8 * (r >> 2) + 4 * hi; }
__device__ __forceinline__ bf16x8_t acc_frag(const f32x16_t& x, int s) {
  u32x4_t w = {cvtpk(x[8 * s + 0], x[8 * s + 1]), cvtpk(x[8 * s + 2], x[8 * s + 3]), cvtpk(x[8 * s + 4], x[8 * s + 5]), cvtpk(x[8 * s + 6], x[8 * s + 7])};
  return __builtin_bit_cast(bf16x8_t, w);
}
__device__ __forceinline__ bf16x8_t pk4_frag(const f32x16_t& P, int base) {
  const unsigned a0 = cvtpk(P[base + 0], P[base + 1]), a1 = cvtpk(P[base + 2], P[base + 3]), b0 = cvtpk(P[base + 4], P[base + 5]), b1 = cvtpk(P[base + 6], P[base + 7]);
  auto r0 = __builtin_amdgcn_permlane32_swap(a0, b0, false, false); auto r1 = __builtin_amdgcn_permlane32_swap(a1, b1, false, false);
  u32x4_t w = {(unsigned)r0[0], (unsigned)r1[0], (unsigned)r0[1], (unsigned)r1[1]}; return __builtin_bit_cast(bf16x8_t, w);
}
typedef short s16x4v __attribute__((ext_vector_type(4)));
__device__ __forceinline__ bf16x8_t ld_nat(const bf16_t* p) { return *reinterpret_cast<const bf16x8_t*>(p); }
__device__ __forceinline__ bf16x8_t ld_perm(const bf16_t* p, int hi) {
  const s16x4v a = *reinterpret_cast<const s16x4v*>(p + 4 * hi), b = *reinterpret_cast<const s16x4v*>(p + 8 + 4 * hi);
  return (bf16x8_t){a[0], a[1], a[2], a[3], b[0], b[1], b[2], b[3]};
}
__device__ __forceinline__ void seg_range(int seg, int& c0, int& nc) { constexpr int nch = TB / 64, base = nch / NSEG, rem = nch % NSEG; c0 = seg * base + (seg < rem ? seg : rem); nc = base + (seg < rem ? 1 : 0); }

template <bool FULL>
__device__ __forceinline__ void mlstm_chunk(const Params& p, WaveLds& L, const int b, const int h, const int dir, const int vs, const int pc,
                                            f32x16_t (&C)[4], float (&nk)[4], float& m, float& bsum, const int lane) {
  const int r32 = lane & 31, hi = lane >> 5;
  const int mrow_l = b * TB + seq_token(pc * 64 + lane, dir);
  const int mr[2] = {b * TB + seq_token(pc * 64 + r32, dir), b * TB + seq_token(pc * 64 + 32 + r32, dir)};
  const bf16_t* Kb[2] = {p.mkc + (size_t)mr[0] * BRB + h * ML_D, p.mkc + (size_t)mr[1] * BRB + h * ML_D};
  const bf16_t* Qb[2] = {p.mqc + (size_t)mr[0] * BRB + h * ML_D, p.mqc + (size_t)mr[1] * BRB + h * ML_D};
  const bf16_t* pg = p.Pb + (size_t)mrow_l * LDP + P0_G + dir * 2 * ML_H + h;
  const float ig = bf2f(pg[0]) + p.b_i[dir * ML_H + h];
  const float lf = log_sigmoid_f(bf2f(pg[ML_H]) + p.b_f[dir * ML_H + h]);
  const float bc = wave_psum(lf, lane), g = ig - bc, pm = wave_pmax(g, lane);
  const float pm63 = __shfl(pm, 63), blast = __shfl(bc, 63), mm63 = fmaxf(m, pm63);
  { const bf16_t* vr = p.Pb + (size_t)mrow_l * LDP + P0_MV + h * ML_D + vs * 32;
#pragma unroll
    for (int c = 0; c < 4; ++c) { const bf16x8_t v8 = ld_nat(vr + c * 8);
#pragma unroll
      for (int e = 0; e < 8; ++e) L.vt[(c * 8 + e) * VT_LD + lane] = (bf16_t)v8[e]; } }
  L.Tw2[lane] = fast_exp(g - mm63);
  MFMA_ASM_PAD();
  float qn = 0.f, expmt = 0.f;
  if (FULL) {
    const float mm = fmaxf(m, pm);
    L.Tg[lane] = g; L.Te1[lane] = fast_exp(pm - mm); L.Te2[lane] = fast_exp(m - mm); L.Trow[lane] = mrow_l; expmt = fast_exp(-(bc + mm));
    const bf16_t* qrow = p.mqc + (size_t)mrow_l * BRB + h * ML_D;
#pragma unroll 4
    for (int c = 0; c < 16; ++c) { const bf16x8_t q8 = ld_nat(qrow + c * 8);
#pragma unroll
      for (int e = 0; e < 8; ++e) qn += bf2f((bf16_t)q8[e]) * L.Tn[c * 8 + e]; }
  }
  WAVE_LDS_SYNC();
  if (FULL) {
    f32x16_t O[2], Y[2];
#pragma unroll
    for (int tblk = 0; tblk < 2; ++tblk) {
#pragma unroll
      for (int r = 0; r < 16; ++r) { O[tblk][r] = 0.f; Y[tblk][r] = 0.f; }
      const int t = r32 + 32 * tblk; const float pm_t = __shfl(pm, t); float denl = 0.f;
#pragma unroll
      for (int sblk = 0; sblk <= tblk; ++sblk) {
        f32x16_t S;
#pragma unroll
        for (int r = 0; r < 16; ++r) S[r] = 0.f;
#pragma unroll
        for (int st = 0; st < 8; ++st) S = MFMA32(ld_nat(Kb[sblk] + 16 * st + 8 * hi), ld_nat(Qb[tblk] + 16 * st + 8 * hi), S);
#pragma unroll
        for (int r = 0; r < 16; ++r) { const int sidx = crow(r, hi) + 32 * sblk; const float w = fast_exp(L.Tg[sidx] - pm_t); const float pr = (sidx <= t) ? S[r] * w : 0.f; S[r] = pr; denl += pr; }
        const bf16x8_t pa0 = pk4_frag(S, 0), pa1 = pk4_frag(S, 8);
        O[tblk] = MFMA32(pa0, ld_nat(L.vt + r32 * VT_LD + 32 * sblk + 8 * hi), O[tblk]);
        O[tblk] = MFMA32(pa1, ld_nat(L.vt + r32 * VT_LD + 32 * sblk + 16 + 8 * hi), O[tblk]);
      }
      denl += __shfl_xor(denl, 32);
      if (hi == 0) L.Tden[t] = denl;
#pragma unroll
      for (int kblk = 0; kblk < 4; ++kblk)
#pragma unroll
        for (int s2 = 0; s2 < 2; ++s2) Y[tblk] = MFMA32(ld_perm(Qb[tblk] + 32 * kblk + 16 * s2, hi), acc_frag(C[kblk], s2), Y[tblk]);
    }
    WAVE_LDS_SYNC();
    { const float den = L.Te1[lane] * L.Tden[lane] + L.Te2[lane] * qn; L.Tinv[lane] = 1.f / fmaxf(fabsf(den), expmt); }
    WAVE_LDS_SYNC();
    bf16_t* Hout = (dir ? p.Hb : p.Hf) + (size_t)(h * 4 + vs) * M * 32 + r32;
#pragma unroll
    for (int tblk = 0; tblk < 2; ++tblk)
#pragma unroll
      for (int r = 0; r < 16; ++r) { const int t = crow(r, hi) + 32 * tblk;
        Hout[(size_t)L.Trow[t] * 32] = f2bf((L.Te1[t] * O[tblk][r] + L.Te2[t] * Y[tblk][r]) * L.Tinv[t]); }
  }
  const float a = fast_exp(m - mm63);
  bf16x8_t I0, I1;
#pragma unroll
  for (int j = 0; j < 8; ++j) { I0[j] = (r32 == 8 * hi + j) ? (short)0x3F80 : (short)0; I1[j] = (r32 == 16 + 8 * hi + j) ? (short)0x3F80 : (short)0; }
#pragma unroll
  for (int kblk = 0; kblk < 4; ++kblk) {
#pragma unroll
    for (int r = 0; r < 16; ++r) C[kblk][r] *= a;
    float nsum = 0.f;
#pragma unroll
    for (int sblk = 0; sblk < 2; ++sblk) {
      f32x16_t X;
#pragma unroll
      for (int r = 0; r < 16; ++r) X[r] = 0.f;
      X = MFMA32(ld_nat(Kb[sblk] + 32 * kblk + 8 * hi), I0, X);
      X = MFMA32(ld_nat(Kb[sblk] + 32 * kblk + 16 + 8 * hi), I1, X);
#pragma unroll
      for (int r = 0; r < 16; ++r) { X[r] *= L.Tw2[crow(r, hi) + 32 * sblk]; nsum += X[r]; }
      C[kblk] = MFMA32(acc_frag(X, 0), ld_perm(L.vt + r32 * VT_LD + 32 * sblk, hi), C[kblk]);
      C[kblk] = MFMA32(acc_frag(X, 1), ld_perm(L.vt + r32 * VT_LD + 32 * sblk + 16, hi), C[kblk]);
    }
    nsum += __shfl_xor(nsum, 32);
    nk[kblk] = a * nk[kblk] + nsum;
  }
  m = blast + mm63; bsum += blast;
  WAVE_LDS_SYNC();
  if (FULL && hi == 0) {
#pragma unroll
    for (int kblk = 0; kblk < 4; ++kblk) L.Tn[kblk * 32 + r32] = nk[kblk];
  }
  WAVE_LDS_SYNC();
}
template <int PASS> __device__ __forceinline__ void mlstm_pass(const Params& p, unsigned char* lds) {
  const int lane = threadIdx.x & 63, wid = UNIFORM((int)(threadIdx.x >> 6)), r32 = lane & 31, hi = lane >> 5;
  WaveLds& L = *reinterpret_cast<WaveLds*>(lds + (size_t)wid * sizeof(WaveLds));
  const int nwaves = (int)gridDim.x * (NTHREADS / 64);
#pragma unroll 1
  for (int item = (int)blockIdx.x * (NTHREADS / 64) + wid; item < NB * ML_H * 2 * 4 * NSEG; item += nwaves) {
    const int seg = item % NSEG, vs = (item / NSEG) % 4, dir = (item / (NSEG * 4)) % 2, h = (item / (NSEG * 8)) % ML_H, b = item / (NSEG * 8 * ML_H);
    if (PASS == 1 && seg == NSEG - 1) continue;
    int c0, nc; seg_range(seg, c0, nc);
    f32x16_t C[4]; float nk[4] = {0.f, 0.f, 0.f, 0.f}; float m = (PASS == 1) ? -1e30f : 0.f, bsum = 0.f;
#pragma unroll
    for (int k = 0; k < 4; ++k)
#pragma unroll
      for (int r = 0; r < 16; ++r) C[k][r] = 0.f;
    float* stbase = p.scanst + (size_t)(item / NSEG) * (NSEG - 1) * ST_STRIDE;
    if (PASS == 2) {
#pragma unroll 1
      for (int j = 0; j < seg; ++j) {
        const float* st = stbase + (size_t)j * ST_STRIDE;
        const float m2 = st[4096 + 128], B2 = st[4096 + 129];
        const float mn = fmaxf(B2 + m, m2), fa = fast_exp(B2 + m - mn), fb = fast_exp(m2 - mn);
#pragma unroll
        for (int k = 0; k < 4; ++k) {
#pragma unroll
          for (int r = 0; r < 16; ++r) C[k][r] = fa * C[k][r] + fb * st[(k * 16 + r) * 64 + lane];
          nk[k] = fa * nk[k] + fb * st[4096 + k * 32 + r32]; }
        m = mn;
      }
      if (hi == 0) {
#pragma unroll
        for (int k = 0; k < 4; ++k) L.Tn[k * 32 + r32] = nk[k]; }
      WAVE_LDS_SYNC();
    }
#pragma unroll 1
    for (int ci = 0; ci < nc; ++ci) mlstm_chunk<PASS == 2>(p, L, b, h, dir, vs, c0 + ci, C, nk, m, bsum, lane);
    if (PASS == 1) {
      float* st = stbase + (size_t)seg * ST_STRIDE;
#pragma unroll
      for (int k = 0; k < 4; ++k) {
#pragma unroll
        for (int r = 0; r < 16; ++r) st[(k * 16 + r) * 64 + lane] = C[k][r];
        if (hi == 0) st[4096 + k * 32 + r32] = nk[k]; }
      if (lane == 0) { st[4096 + 128] = m; st[4096 + 129] = bsum; }
    }
  }
}
}


namespace scan {
constexpr int OFF_TILES = 8 * (int)sizeof(WaveLds);
struct Pre { bf16x8_t tq[4], tk[4], v[4]; float g0, g1; };
constexpr int MQ_LD = ML_D + 8;
constexpr int M_TILE = 64 * MQ_LD;
template <bool LIGHT>
__device__ __forceinline__ void mlstm_prefetch(const Params& p, Pre& R, const int b, const int h, const int dir, const int vs, const int pc, const int gt, const int lane) {
  const int tlo = dir ? seq_token(pc * 64 + 63, dir) : seq_token(pc * 64, dir);
  const size_t m0 = (size_t)b * TB + tlo;
  const bf16_t* qb = p.mqc + m0 * BRB + h * ML_D; const bf16_t* kb = p.mkc + m0 * BRB + h * ML_D;
#pragma unroll
  for (int i = 0; i < 4; ++i) { const int j = gt + 256 * i, row = j >> 4; const unsigned off = (unsigned)((dir ? 63 - row : row) * BRB + (j & 15) * 8); if (!LIGHT) R.tq[i] = ld_nat(qb + off); R.tk[i] = ld_nat(kb + off); }
  if (LIGHT) {
    const unsigned voff = (unsigned)((dir ? 63 - lane : lane) * LDP);
    const bf16_t* vr = p.Pb + m0 * LDP + P0_MV + h * ML_D + vs * 32 + voff;
#pragma unroll
    for (int c = 0; c < 4; ++c) R.v[c] = ld_nat(vr + c * 8);
    const bf16_t* pg = p.Pb + m0 * LDP + P0_G + dir * 2 * ML_H + h + voff;
    R.g0 = bf2f(pg[0]); R.g1 = bf2f(pg[ML_H]);
  }
}
template <bool LIGHT>
__device__ __forceinline__ void mlstm_tiles_to_lds(const Pre& R, bf16_t* Qt, bf16_t* Kt, const int gt) {
#pragma unroll
  for (int i = 0; i < 4; ++i) { const int j = gt + 256 * i, row = j >> 4, c16 = j & 15;
    if (!LIGHT) *reinterpret_cast<bf16x8_t*>(Qt + row * MQ_LD + c16 * 8) = R.tq[i]; *reinterpret_cast<bf16x8_t*>(Kt + row * MQ_LD + c16 * 8) = R.tk[i]; }
}
template <bool FULL>
__device__ __forceinline__ void mlstm_chunk2(const Params& p, WaveLds& L, const bf16_t* Qt, const bf16_t* Kt, Pre& R, const int b, const int h, const int dir, const int vs, const int pc, const int pc_next,
                                             f32x16_t (&C)[4], float (&nk)[4], float& m, float& bsum, const int gt_in, const int lane_in) {
  int lane = lane_in, gt = gt_in;
#ifndef HOST_TEST
  asm volatile("" : "+v"(lane), "+v"(gt));
#endif
  const int r32 = lane & 31, hi = lane >> 5;
  const int mrow_l = b * TB + seq_token(pc * 64 + lane, dir);
  const bf16_t* prow = p.Pb + (size_t)mrow_l * LDP;
  const float ig = (FULL ? bf2f(prow[P0_G + dir * 2 * ML_H + h]) : R.g0) + p.b_i[dir * ML_H + h];
  const float lf = log_sigmoid_f((FULL ? bf2f(prow[P0_G + dir * 2 * ML_H + ML_H + h]) : R.g1) + p.b_f[dir * ML_H + h]);
  { const bf16_t* vr = prow + P0_MV + h * ML_D + vs * 32;
#pragma unroll
    for (int c = 0; c < 4; ++c) { const bf16x8_t v8 = FULL ? ld_nat(vr + c * 8) : R.v[c];
#pragma unroll
      for (int e = 0; e < 8; ++e) L.vt[(c * 8 + e) * VT_LD + lane] = (bf16_t)v8[e]; } }
  if (!FULL && pc_next >= 0) mlstm_prefetch<true>(p, R, b, h, dir, vs, pc_next, gt, lane);
  const float bc = wave_psum(lf, lane), g = ig - bc, pm = wave_pmax(g, lane);
  const float pm63 = __shfl(pm, 63), blast = __shfl(bc, 63), mm63 = fmaxf(m, pm63);
  L.Tw2[lane] = fast_exp(g - mm63);
  MFMA_ASM_PAD();
  float qn = 0.f, expmt = 0.f;
  if (FULL) {
    const float mm = fmaxf(m, pm);
    L.Tg[lane] = g; L.Te2[lane] = fast_exp(m - mm); L.Trow[lane] = mrow_l; expmt = fast_exp(-(bc + mm));
    const bf16_t* qrow = Qt + lane * MQ_LD;
#pragma unroll 4
    for (int c = 0; c < 16; ++c) { const bf16x8_t q8 = ld_nat(qrow + c * 8);
#pragma unroll
      for (int e = 0; e < 8; ++e) qn += bf2f((bf16_t)q8[e]) * L.Tn[c * 8 + e]; }
  }
  WAVE_LDS_SYNC();
  if (FULL) {
    bf16_t* Hout = (dir ? p.Hb : p.Hf) + (size_t)(h * 4 + vs) * M * 32 + r32;
    const float mm_l = fmaxf(m, pm);
#pragma unroll
    for (int tblk = 0; tblk < 2; ++tblk) {
      asm volatile("" ::: "memory");
      f32x16_t A;
#pragma unroll
      for (int r = 0; r < 16; ++r) A[r] = 0.f;
      const int t = r32 + 32 * tblk; const float mm_t = __shfl(mm_l, t); float denl = 0.f;
      const bf16_t* Qb = Qt + (32 * tblk + r32) * MQ_LD;
#pragma unroll
      for (int kblk = 0; kblk < 4; ++kblk)
#pragma unroll
        for (int s2 = 0; s2 < 2; ++s2) A = MFMA32(ld_perm(Qb + 32 * kblk + 16 * s2, hi), acc_frag(C[kblk], s2), A);
#pragma unroll
      for (int r = 0; r < 16; ++r) A[r] *= L.Te2[crow(r, hi) + 32 * tblk];
#pragma unroll
      for (int sblk = 0; sblk <= tblk; ++sblk) {
        asm volatile("" ::: "memory");
        const bf16_t* Kb = Kt + (32 * sblk + r32) * MQ_LD;
        f32x16_t S;
#pragma unroll
        for (int r = 0; r < 16; ++r) S[r] = 0.f;
#pragma unroll
        for (int st = 0; st < 8; ++st) S = MFMA32(ld_nat(Kb + 16 * st + 8 * hi), ld_nat(Qb + 16 * st + 8 * hi), S);
#pragma unroll
        for (int r = 0; r < 16; ++r) { const int sidx = crow(r, hi) + 32 * sblk; const float w = fast_exp(L.Tg[sidx] - mm_t); const float pr = (sidx <= t) ? S[r] * w : 0.f; S[r] = pr; denl += pr; }
        const bf16x8_t pa0 = pk4_frag(S, 0), pa1 = pk4_frag(S, 8);
        A = MFMA32(pa0, ld_nat(L.vt + r32 * VT_LD + 32 * sblk + 8 * hi), A);
        A = MFMA32(pa1, ld_nat(L.vt + r32 * VT_LD + 32 * sblk + 16 + 8 * hi), A);
      }
      denl += __shfl_xor(denl, 32);
      if (hi == 0) L.Tden[t] = denl;
      WAVE_LDS_SYNC();
      if ((lane >> 5) == tblk) { const float den = L.Tden[lane] + L.Te2[lane] * qn; L.Tinv[lane] = 1.f / fmaxf(fabsf(den), expmt); }
      WAVE_LDS_SYNC();
#pragma unroll
      for (int r = 0; r < 16; ++r) { const int tt = crow(r, hi) + 32 * tblk; Hout[(size_t)L.Trow[tt] * 32] = f2bf(A[r] * L.Tinv[tt]); }
    }
  }
  asm volatile("" ::: "memory");
  if (FULL && pc_next >= 0) mlstm_prefetch<false>(p, R, b, h, dir, vs, pc_next, gt, lane);
  const float a = fast_exp(m - mm63);
  bf16x8_t I0, I1;
#pragma unroll
  for (int j = 0; j < 8; ++j) { I0[j] = (r32 == 8 * hi + j) ? (short)0x3F80 : (short)0; I1[j] = (r32 == 16 + 8 * hi + j) ? (short)0x3F80 : (short)0; }
#pragma unroll
  for (int kblk = 0; kblk < 4; ++kblk) {
    asm volatile("" ::: "memory");
#pragma unroll
    for (int r = 0; r < 16; ++r) C[kblk][r] *= a;
    float nsum = 0.f;
#pragma unroll
    for (int sblk = 0; sblk < 2; ++sblk) {
      const bf16_t* Kb = Kt + (32 * sblk + r32) * MQ_LD;
      f32x16_t X;
#pragma unroll
      for (int r = 0; r < 16; ++r) X[r] = 0.f;
      X = MFMA32(ld_nat(Kb + 32 * kblk + 8 * hi), I0, X);
      X = MFMA32(ld_nat(Kb + 32 * kblk + 16 + 8 * hi), I1, X);
#pragma unroll
      for (int r = 0; r < 16; ++r) { X[r] *= L.Tw2[crow(r, hi) + 32 * sblk]; nsum += X[r]; }
      C[kblk] = MFMA32(acc_frag(X, 0), ld_perm(L.vt + r32 * VT_LD + 32 * sblk, hi), C[kblk]);
      C[kblk] = MFMA32(acc_frag(X, 1), ld_perm(L.vt + r32 * VT_LD + 32 * sblk + 16, hi), C[kblk]);
    }
    nsum += __shfl_xor(nsum, 32);
    nk[kblk] = a * nk[kblk] + nsum;
  }
  m = blast + mm63; bsum += blast;
  WAVE_LDS_SYNC();
  if (FULL && hi == 0) {
#pragma unroll
    for (int kblk = 0; kblk < 4; ++kblk) L.Tn[kblk * 32 + r32] = nk[kblk];
  }
  WAVE_LDS_SYNC();
}
template <int PASS> __device__ __forceinline__ void mlstm_block(const Params& p, unsigned char* lds) {
  const int tid = threadIdx.x, lane = tid & 63, wid = UNIFORM(tid >> 6), r32 = lane & 31, hi = lane >> 5, grp = wid >> 2, vs = wid & 3, gt = tid & 255;
  WaveLds& L = *reinterpret_cast<WaveLds*>(lds + (size_t)wid * sizeof(WaveLds));
  bf16_t* Qt = reinterpret_cast<bf16_t*>(lds + OFF_TILES) + (size_t)grp * 2 * M_TILE; bf16_t* Kt = Qt + M_TILE;
  constexpr int NIT = NB * ML_H * 2 * NSEG;
#pragma unroll 1
  for (int pidx = (int)blockIdx.x; pidx < NIT / 2; pidx += (int)gridDim.x) {
    const int it = 2 * pidx + grp, seg = it % NSEG, dir = (it / NSEG) % 2, h = (it / (NSEG * 2)) % ML_H, b = it / (NSEG * 2 * ML_H);
    int c0, nc, c0b, ncb; seg_range(seg, c0, nc); seg_range((2 * pidx + (grp ^ 1)) % NSEG, c0b, ncb);
    if (PASS == 1 && seg == NSEG - 1) nc = 0;
    if (PASS == 1 && (2 * pidx + (grp ^ 1)) % NSEG == NSEG - 1) ncb = 0;
    const int ncmax = nc > ncb ? nc : ncb;
    f32x16_t C[4]; float nk[4] = {0.f, 0.f, 0.f, 0.f}; float m = (PASS == 1) ? -1e30f : 0.f, bsum = 0.f;
#pragma unroll
    for (int k = 0; k < 4; ++k)
#pragma unroll
      for (int r = 0; r < 16; ++r) C[k][r] = 0.f;
    float* stbase = p.scanst + (size_t)((((b * ML_H + h) * 2 + dir) * 4 + vs)) * (NSEG - 1) * ST_STRIDE;
    if (PASS == 2) {
#pragma unroll 1
      for (int j = 0; j < seg; ++j) {
        const float* st = stbase + (size_t)j * ST_STRIDE;
        const float m2 = st[4096 + 128], B2 = st[4096 + 129];
        const float mn = fmaxf(B2 + m, m2), fa = fast_exp(B2 + m - mn), fb = fast_exp(m2 - mn);
        const float* sp = st;
#pragma unroll
        for (int k = 0; k < 4; ++k) {
#pragma unroll
          for (int r = 0; r < 16; ++r) { C[k][r] = fa * C[k][r] + fb * sp[lane]; sp += 64; }
          nk[k] = fa * nk[k] + fb * st[4096 + k * 32 + r32]; }
        m = mn;
      }
      if (hi == 0) {
#pragma unroll
        for (int k = 0; k < 4; ++k) L.Tn[k * 32 + r32] = nk[k]; }
      WAVE_LDS_SYNC();
    }
    Pre R;
    if (nc > 0) { mlstm_prefetch<PASS == 1>(p, R, b, h, dir, vs, c0, gt, lane); mlstm_tiles_to_lds<PASS == 1>(R, Qt, Kt, gt); }
    __syncthreads();
#pragma unroll 1
    for (int ci = 0; ci < ncmax; ++ci) {
      const bool act = ci < nc, more = ci + 1 < nc;
      if (act) mlstm_chunk2<PASS == 2>(p, L, Qt, Kt, R, b, h, dir, vs, c0 + ci, more ? c0 + ci + 1 : -1, C, nk, m, bsum, gt, lane);
      __syncthreads();
      if (more) mlstm_tiles_to_lds<PASS == 1>(R, Qt, Kt, gt);
      __syncthreads();
    }
    if (PASS == 1 && nc > 0) {
      float* st = stbase + (size_t)seg * ST_STRIDE;
      float* sp = st;
#pragma unroll
      for (int k = 0; k < 4; ++k) {
#pragma unroll
        for (int r = 0; r < 16; ++r) { sp[lane] = C[k][r]; sp += 64; }
        if (hi == 0) st[4096 + k * 32 + r32] = nk[k]; }
      if (lane == 0) { st[4096 + 128] = m; st[4096 + 129] = bsum; }
    }
  }
}
}

namespace scan {
constexpr int GK = GLA_H * GLA_DK;
constexpr int NCH = TB / 64;
constexpr int GST_STRIDE = 2048 + 64 + 8;
static_assert(4 * GK <= LDA, "Q'|K' for both directions fit in the A1 region");
__device__ __forceinline__ bf16_t* gla_qp(const Params& p, int dir) { return p.A1 + (size_t)dir * M * GK; }
__device__ __forceinline__ bf16_t* gla_kp(const Params& p, int dir) { return p.A1 + (size_t)(2 + dir) * M * GK; }
__device__ __forceinline__ float* gla_ebl(const Params& p) { return p.scanst + (size_t)NB * GLA_H * 2 * 4 * (NSEG - 1) * GST_STRIDE; }
constexpr int PRE_WLDS = 2 * 64 * 64 * 2 + 64 * GRANK * 2;
__device__ __forceinline__ void gla_prepass(const Params& p, unsigned char* lds) {
  const int lane = threadIdx.x & 63, wid = UNIFORM((int)(threadIdx.x >> 6)), nwaves = (int)gridDim.x * (NTHREADS / 64);
  bf16_t* qt = reinterpret_cast<bf16_t*>(lds + (size_t)wid * PRE_WLDS); bf16_t* kt = qt + 64 * 64; bf16_t* gat = kt + 64 * 64;
#pragma unroll 1
  for (int item = (int)blockIdx.x * (NTHREADS / 64) + wid; item < NB * 2 * NCH * GLA_H; item += nwaves) {
    const int h = item % GLA_H, pc = (item / GLA_H) % NCH, dir = (item / (GLA_H * NCH)) % 2, b = item / (GLA_H * NCH * 2);
    const size_t m = (size_t)b * TB + seq_token(pc * 64 + lane, dir);
    const bf16_t* prow = p.Pb + m * LDP;
    { bf16x8_t qv[8], kv[8];
#pragma unroll
      for (int c = 0; c < 8; ++c) { qv[c] = ld_nat(prow + P1_GQ + h * GLA_DK + c * 8); kv[c] = ld_nat(prow + P1_GK + h * GLA_DK + c * 8); }
      const bf16x8_t g0 = ld_nat(prow + P1_GA + dir * GRANK), g1 = ld_nat(prow + P1_GA + dir * GRANK + 8);
#pragma unroll
      for (int c = 0; c < 8; ++c) { *reinterpret_cast<bf16x8_t*>(qt + lane * 64 + c * 8) = qv[c]; *reinterpret_cast<bf16x8_t*>(kt + lane * 64 + c * 8) = kv[c]; }
      *reinterpret_cast<bf16x8_t*>(gat + lane * GRANK) = g0; *reinterpret_cast<bf16x8_t*>(gat + lane * GRANK + 8) = g1; }
    float wg[GRANK];
#pragma unroll
    for (int r = 0; r < GRANK; ++r) wg[r] = p.w_gate[((size_t)dir * GRANK + r) * GK + h * GLA_DK + lane];
    const float bg = p.b_gate[dir * GK + h * GLA_DK + lane];
    WAVE_LDS_SYNC();
    float bc = 0.f;
#pragma unroll 4
    for (int i = 0; i < 64; ++i) {
      const bf16x8_t g0 = *reinterpret_cast<const bf16x8_t*>(gat + i * GRANK), g1 = *reinterpret_cast<const bf16x8_t*>(gat + i * GRANK + 8);
      float gp = bg;
#pragma unroll
      for (int r = 0; r < 8; ++r) gp += bf2f((bf16_t)g0[r]) * wg[r] + bf2f((bf16_t)g1[r]) * wg[8 + r];
      bc += (fminf(gp, 0.f) - fast_log(1.f + fast_exp(-fabsf(gp)))) * (1.f / 16.f);
      const float q = bf2f(qt[i * 64 + lane]) * 0.125f, k = bf2f(kt[i * 64 + lane]);
      qt[i * 64 + lane] = f2bf(q * fast_exp(bc)); kt[i * 64 + lane] = f2bf(k * fast_exp(-bc));
    }
    gla_ebl(p)[(((size_t)dir * NB + b) * NCH + pc) * GK + h * GLA_DK + lane] = fast_exp(bc);
    WAVE_LDS_SYNC();
    bf16_t* Qo = gla_qp(p, dir) + m * GK + h * GLA_DK; bf16_t* Ko = gla_kp(p, dir) + m * GK + h * GLA_DK;
#pragma unroll
    for (int c = 0; c < 8; ++c) { *reinterpret_cast<bf16x8_t*>(Qo + c * 8) = *reinterpret_cast<const bf16x8_t*>(qt + lane * 64 + c * 8);
      *reinterpret_cast<bf16x8_t*>(Ko + c * 8) = *reinterpret_cast<const bf16x8_t*>(kt + lane * 64 + c * 8); }
    WAVE_LDS_SYNC();
  }
}
template <bool FULL>
__device__ __forceinline__ void gla_chunk(const Params& p, WaveLds& L, const int b, const int h, const int dir, const int vs, const int pc, f32x16_t (&S)[2], float (&dprod)[2], const int lane) {
  const int r32 = lane & 31, hi = lane >> 5;
  const int tok_l = seq_token(pc * 64 + lane, dir), mrow_l = b * TB + tok_l;
  const int mr[2] = {b * TB + seq_token(pc * 64 + r32, dir), b * TB + seq_token(pc * 64 + 32 + r32, dir)};
  const bf16_t* Kb[2] = {gla_kp(p, dir) + (size_t)mr[0] * GK + h * GLA_DK, gla_kp(p, dir) + (size_t)mr[1] * GK + h * GLA_DK};
  const bf16_t* Qb[2] = {gla_qp(p, dir) + (size_t)mr[0] * GK + h * GLA_DK, gla_qp(p, dir) + (size_t)mr[1] * GK + h * GLA_DK};
  const float* eb = gla_ebl(p) + (((size_t)dir * NB + b) * NCH + pc) * GK + h * GLA_DK;
  { const bf16_t* vr = p.Pb + (size_t)mrow_l * LDP + P1_GV + h * GLA_DV + vs * 32;
#pragma unroll
    for (int c = 0; c < 4; ++c) { const bf16x8_t v8 = ld_nat(vr + c * 8);
#pragma unroll
      for (int e = 0; e < 8; ++e) L.vt[(c * 8 + e) * VT_LD + lane] = (bf16_t)v8[e]; } }
  L.Tg[lane] = eb[lane];
  MFMA_ASM_PAD();
  const bool emit = FULL && pc >= CTX / 64;
  if (emit) L.Trow[lane] = b * SEQ + (tok_l - CTX);
  WAVE_LDS_SYNC();
  if (emit) {
    bf16_t* Oout = (dir ? p.Hb : p.Hf) + (size_t)(h * 4 + vs) * MLAT * 32 + r32;
#pragma unroll
    for (int tblk = 0; tblk < 2; ++tblk) {
      f32x16_t O;
#pragma unroll
      for (int r = 0; r < 16; ++r) O[r] = 0.f;
      const int t = r32 + 32 * tblk;
#pragma unroll
      for (int sblk = 0; sblk <= tblk; ++sblk) {
        f32x16_t P;
#pragma unroll
        for (int r = 0; r < 16; ++r) P[r] = 0.f;
#pragma unroll
        for (int st = 0; st < 4; ++st) P = MFMA32(ld_nat(Kb[sblk] + 16 * st + 8 * hi), ld_nat(Qb[tblk] + 16 * st + 8 * hi), P);
#pragma unroll
        for (int r = 0; r < 16; ++r) { const int sidx = crow(r, hi) + 32 * sblk; P[r] = (sidx <= t) ? P[r] : 0.f; }
        MFMA_ASM_PAD();
        const bf16x8_t pa0 = pk4_frag(P, 0), pa1 = pk4_frag(P, 8);
        O = MFMA32(pa0, ld_nat(L.vt + r32 * VT_LD + 32 * sblk + 8 * hi), O);
        O = MFMA32(pa1, ld_nat(L.vt + r32 * VT_LD + 32 * sblk + 16 + 8 * hi), O);
      }
#pragma unroll
      for (int kblk = 0; kblk < 2; ++kblk)
#pragma unroll
        for (int s2 = 0; s2 < 2; ++s2) O = MFMA32(ld_perm(Qb[tblk] + 32 * kblk + 16 * s2, hi), acc_frag(S[kblk], s2), O);
#pragma unroll
      for (int r = 0; r < 16; ++r) Oout[(size_t)L.Trow[crow(r, hi) + 32 * tblk] * 32] = f2bf(O[r]);
    }
  }
  bf16x8_t I0, I1;
#pragma unroll
  for (int j = 0; j < 8; ++j) { I0[j] = (r32 == 8 * hi + j) ? (short)0x3F80 : (short)0; I1[j] = (r32 == 16 + 8 * hi + j) ? (short)0x3F80 : (short)0; }
#pragma unroll
  for (int kblk = 0; kblk < 2; ++kblk) {
    const float ek = eb[32 * kblk + r32];
#pragma unroll
    for (int r = 0; r < 16; ++r) S[kblk][r] *= L.Tg[crow(r, hi) + 32 * kblk];
#pragma unroll
    for (int sblk = 0; sblk < 2; ++sblk) {
      f32x16_t X;
#pragma unroll
      for (int r = 0; r < 16; ++r) X[r] = 0.f;
      X = MFMA32(ld_nat(Kb[sblk] + 32 * kblk + 8 * hi), I0, X);
      X = MFMA32(ld_nat(Kb[sblk] + 32 * kblk + 16 + 8 * hi), I1, X);
#pragma unroll
      for (int r = 0; r < 16; ++r) X[r] *= ek;
      S[kblk] = MFMA32(acc_frag(X, 0), ld_perm(L.vt + r32 * VT_LD + 32 * sblk, hi), S[kblk]);
      S[kblk] = MFMA32(acc_frag(X, 1), ld_perm(L.vt + r32 * VT_LD + 32 * sblk + 16, hi), S[kblk]);
    }
    dprod[kblk] *= ek;
  }
  WAVE_LDS_SYNC();
}
template <int PASS> __device__ __forceinline__ void gla_pass(const Params& p, unsigned char* lds) {
  const int lane = threadIdx.x & 63, wid = UNIFORM((int)(threadIdx.x >> 6)), r32 = lane & 31, hi = lane >> 5;
  WaveLds& L = *reinterpret_cast<WaveLds*>(lds + (size_t)wid * sizeof(WaveLds));
  const int nwaves = (int)gridDim.x * (NTHREADS / 64);
#pragma unroll 1
  for (int item = (int)blockIdx.x * (NTHREADS / 64) + wid; item < NB * GLA_H * 2 * 4 * NSEG; item += nwaves) {
    const int seg = item % NSEG, vs = (item / NSEG) % 4, dir = (item / (NSEG * 4)) % 2, h = (item / (NSEG * 8)) % GLA_H, b = item / (NSEG * 8 * GLA_H);
    if (PASS == 1 && seg == NSEG - 1) continue;
    int c0, nc; seg_range(seg, c0, nc);
    f32x16_t S[2]; float dprod[2] = {1.f, 1.f};
#pragma unroll
    for (int k = 0; k < 2; ++k)
#pragma unroll
      for (int r = 0; r < 16; ++r) S[k][r] = 0.f;
    float* stbase = p.scanst + (size_t)(item / NSEG) * (NSEG - 1) * GST_STRIDE;
    if (PASS == 2) {
#pragma unroll 1
      for (int j = 0; j < seg; ++j) { const float* st = stbase + (size_t)j * GST_STRIDE;
#pragma unroll
        for (int k = 0; k < 2; ++k)
#pragma unroll
          for (int r = 0; r < 16; ++r) S[k][r] = st[2048 + 32 * k + crow(r, hi)] * S[k][r] + st[(k * 16 + r) * 64 + lane]; }
    }
#pragma unroll 1
    for (int ci = 0; ci < nc; ++ci) gla_chunk<PASS == 2>(p, L, b, h, dir, vs, c0 + ci, S, dprod, lane);
    if (PASS == 1) { float* st = stbase + (size_t)seg * GST_STRIDE;
#pragma unroll
      for (int k = 0; k < 2; ++k) {
#pragma unroll
        for (int r = 0; r < 16; ++r) st[(k * 16 + r) * 64 + lane] = S[k][r];
        if (hi == 0) st[2048 + 32 * k + r32] = dprod[k]; } }
  }
}
}


namespace scan {
constexpr int GQ_LD = GLA_DK + 8;
constexpr int G_TILE = 64 * GQ_LD;
struct GPre { bf16x8_t tq[2], tk[2]; };
__device__ __forceinline__ void gla_prefetch(const Params& p, GPre& R, const int b, const int h, const int dir, const int pc, const int gt) {
  const int tlo = dir ? seq_token(pc * 64 + 63, dir) : seq_token(pc * 64, dir);
  const size_t m0 = (size_t)b * TB + tlo;
  const bf16_t* qb = gla_qp(p, dir) + m0 * GK + h * GLA_DK; const bf16_t* kb = gla_kp(p, dir) + m0 * GK + h * GLA_DK;
#pragma unroll
  for (int i = 0; i < 2; ++i) { const int j = gt + 256 * i, row = j >> 3; const unsigned off = (unsigned)((dir ? 63 - row : row) * GK + (j & 7) * 8); R.tq[i] = ld_nat(qb + off); R.tk[i] = ld_nat(kb + off); }
}
__device__ __forceinline__ void gla_tiles_to_lds(const GPre& R, bf16_t* Qt, bf16_t* Kt, const int gt) {
#pragma unroll
  for (int i = 0; i < 2; ++i) { const int j = gt + 256 * i, row = j >> 3, c8 = j & 7;
    *reinterpret_cast<bf16x8_t*>(Qt + row * GQ_LD + c8 * 8) = R.tq[i]; *reinterpret_cast<bf16x8_t*>(Kt + row * GQ_LD + c8 * 8) = R.tk[i]; }
}
template <bool FULL>
__device__ __forceinline__ void gla_chunk2(const Params& p, WaveLds& L, const bf16_t* Qt, const bf16_t* Kt, GPre& R, const int b, const int h, const int dir, const int vs, const int pc, const int pc_next,
                                           f32x16_t (&S)[2], float (&dprod)[2], const int gt, const int lane) {
  const int r32 = lane & 31, hi = lane >> 5;
  const int tok_l = seq_token(pc * 64 + lane, dir), mrow_l = b * TB + tok_l;
  const float* eb = gla_ebl(p) + (((size_t)dir * NB + b) * NCH + pc) * GK + h * GLA_DK;
  { const bf16_t* vr = p.Pb + (size_t)mrow_l * LDP + P1_GV + h * GLA_DV + vs * 32;
#pragma unroll
    for (int c = 0; c < 4; ++c) { const bf16x8_t v8 = ld_nat(vr + c * 8);
#pragma unroll
      for (int e = 0; e < 8; ++e) L.vt[(c * 8 + e) * VT_LD + lane] = (bf16_t)v8[e]; } }
  L.Tg[lane] = eb[lane];
  MFMA_ASM_PAD();
  const bool emit = FULL && pc >= CTX / 64;
  if (emit) L.Trow[lane] = b * SEQ + (tok_l - CTX);
  WAVE_LDS_SYNC();
  if (emit) {
    bf16_t* Oout = (dir ? p.Hb : p.Hf) + (size_t)(h * 4 + vs) * MLAT * 32 + r32;
#pragma unroll
    for (int tblk = 0; tblk < 2; ++tblk) {
      f32x16_t O;
#pragma unroll
      for (int r = 0; r < 16; ++r) O[r] = 0.f;
      const int t = r32 + 32 * tblk;
      const bf16_t* Qb = Qt + (32 * tblk + r32) * GQ_LD;
#pragma unroll
      for (int sblk = 0; sblk <= tblk; ++sblk) {
        const bf16_t* Kb = Kt + (32 * sblk + r32) * GQ_LD;
        f32x16_t P;
#pragma unroll
        for (int r = 0; r < 16; ++r) P[r] = 0.f;
#pragma unroll
        for (int st = 0; st < 4; ++st) P = MFMA32(ld_nat(Kb + 16 * st + 8 * hi), ld_nat(Qb + 16 * st + 8 * hi), P);
#pragma unroll
        for (int r = 0; r < 16; ++r) { const int sidx = crow(r, hi) + 32 * sblk; P[r] = (sidx <= t) ? P[r] : 0.f; }
        MFMA_ASM_PAD();
        const bf16x8_t pa0 = pk4_frag(P, 0), pa1 = pk4_frag(P, 8);
        O = MFMA32(pa0, ld_nat(L.vt + r32 * VT_LD + 32 * sblk + 8 * hi), O);
        O = MFMA32(pa1, ld_nat(L.vt + r32 * VT_LD + 32 * sblk + 16 + 8 * hi), O);
      }
#pragma unroll
      for (int kblk = 0; kblk < 2; ++kblk)
#pragma unroll
        for (int s2 = 0; s2 < 2; ++s2) O = MFMA32(ld_perm(Qb + 32 * kblk + 16 * s2, hi), acc_frag(S[kblk], s2), O);
#pragma unroll
      for (int r = 0; r < 16; ++r) Oout[(size_t)L.Trow[crow(r, hi) + 32 * tblk] * 32] = f2bf(O[r]);
    }
  }
  if (pc_next >= 0) gla_prefetch(p, R, b, h, dir, pc_next, gt);
  bf16x8_t I0, I1;
#pragma unroll
  for (int j = 0; j < 8; ++j) { I0[j] = (r32 == 8 * hi + j) ? (short)0x3F80 : (short)0; I1[j] = (r32 == 16 + 8 * hi + j) ? (short)0x3F80 : (short)0; }
#pragma unroll
  for (int kblk = 0; kblk < 2; ++kblk) {
    const float ek = eb[32 * kblk + r32];
#pragma unroll
    for (int r = 0; r < 16; ++r) S[kblk][r] *= L.Tg[crow(r, hi) + 32 * kblk];
#pragma unroll
    for (int sblk = 0; sblk < 2; ++sblk) {
      const bf16_t* Kb = Kt + (32 * sblk + r32) * GQ_LD;
      f32x16_t X;
#pragma unroll
      for (int r = 0; r < 16; ++r) X[r] = 0.f;
      X = MFMA32(ld_nat(Kb + 32 * kblk + 8 * hi), I0, X);
      X = MFMA32(ld_nat(Kb + 32 * kblk + 16 + 8 * hi), I1, X);
#pragma unroll
      for (int r = 0; r < 16; ++r) X[r] *= ek;
      S[kblk] = MFMA32(acc_frag(X, 0), ld_perm(L.vt + r32 * VT_LD + 32 * sblk, hi), S[kblk]);
      S[kblk] = MFMA32(acc_frag(X, 1), ld_perm(L.vt + r32 * VT_LD + 32 * sblk + 16, hi), S[kblk]);
    }
    dprod[kblk] *= ek;
  }
  WAVE_LDS_SYNC();
}
template <int PASS> __device__ __forceinline__ void gla_block(const Params& p, unsigned char* lds) {
  const int tid = threadIdx.x, lane = tid & 63, wid = UNIFORM(tid >> 6), r32 = lane & 31, hi = lane >> 5, grp = wid >> 2, vs = wid & 3, gt = tid & 255;
  WaveLds& L = *reinterpret_cast<WaveLds*>(lds + (size_t)wid * sizeof(WaveLds));
  bf16_t* Qt = reinterpret_cast<bf16_t*>(lds + OFF_TILES) + (size_t)grp * 2 * G_TILE; bf16_t* Kt = Qt + G_TILE;
  constexpr int NIT = NB * GLA_H * 2 * NSEG;
#pragma unroll 1
  for (int pidx = (int)blockIdx.x; pidx < NIT / 2; pidx += (int)gridDim.x) {
    const int it = 2 * pidx + grp, seg = it % NSEG, dir = (it / NSEG) % 2, h = (it / (NSEG * 2)) % GLA_H, b = it / (NSEG * 2 * GLA_H);
    int c0, nc, c0b, ncb; seg_range(seg, c0, nc); seg_range((2 * pidx + (grp ^ 1)) % NSEG, c0b, ncb);
    if (PASS == 1 && seg == NSEG - 1) nc = 0;
    if (PASS == 1 && (2 * pidx + (grp ^ 1)) % NSEG == NSEG - 1) ncb = 0;
    const int ncmax = nc > ncb ? nc : ncb;
    f32x16_t S[2]; float dprod[2] = {1.f, 1.f};
#pragma unroll
    for (int k = 0; k < 2; ++k)
#pragma unroll
      for (int r = 0; r < 16; ++r) S[k][r] = 0.f;
    float* stbase = p.scanst + (size_t)((((b * GLA_H + h) * 2 + dir) * 4 + vs)) * (NSEG - 1) * GST_STRIDE;
    if (PASS == 2) {
#pragma unroll 1
      for (int j = 0; j < seg; ++j) { const float* st = stbase + (size_t)j * GST_STRIDE; const float* sp = st;
#pragma unroll
        for (int k = 0; k < 2; ++k)
#pragma unroll
          for (int r = 0; r < 16; ++r) { S[k][r] = st[2048 + 32 * k + crow(r, hi)] * S[k][r] + sp[lane]; sp += 64; } }
    }
    GPre R;
    if (nc > 0) { gla_prefetch(p, R, b, h, dir, c0, gt); gla_tiles_to_lds(R, Qt, Kt, gt); }
    __syncthreads();
#pragma unroll 1
    for (int ci = 0; ci < ncmax; ++ci) {
      const bool act = ci < nc, more = ci + 1 < nc;
      if (act) gla_chunk2<PASS == 2>(p, L, Qt, Kt, R, b, h, dir, vs, c0 + ci, more ? c0 + ci + 1 : -1, S, dprod, gt, lane);
      __syncthreads();
      if (more) gla_tiles_to_lds(R, Qt, Kt, gt);
      __syncthreads();
    }
    if (PASS == 1 && nc > 0) { float* st = stbase + (size_t)seg * GST_STRIDE; float* sp = st;
#pragma unroll
      for (int k = 0; k < 2; ++k) {
#pragma unroll
        for (int r = 0; r < 16; ++r) { sp[lane] = S[k][r]; sp += 64; }
        if (hi == 0) st[2048 + 32 * k + r32] = dprod[k]; } }
  }
}
}

namespace na {
constexpr int VP = 144, WLDS = 64 * VP;
static_assert(NA_D == 64 && NA_KW == 16 && NA_KH == 8 && CTX % 64 == 0, "NA geometry");
__device__ __forceinline__ unsigned char* wave_lds(unsigned char* lds, int wid) { return lds + (size_t)wid * WLDS; }
template <int GRP> __device__ __forceinline__ void pv_group(f32x4_t (&O)[4], const int vb, const bf16x8_t pf) {
  const s16x4_t a0 = TR_READ(vb, GRP * 32 * VP + 0), b0 = TR_READ(vb, GRP * 32 * VP + 4 * VP + 0), a1 = TR_READ(vb, GRP * 32 * VP + 32), b1 = TR_READ(vb, GRP * 32 * VP + 4 * VP + 32);
  const s16x4_t a2 = TR_READ(vb, GRP * 32 * VP + 64), b2 = TR_READ(vb, GRP * 32 * VP + 4 * VP + 64), a3 = TR_READ(vb, GRP * 32 * VP + 96), b3 = TR_READ(vb, GRP * 32 * VP + 4 * VP + 96);
  LGKM_WAIT(); SBAR();
#define PKV(L, H) (bf16x8_t){L[0], L[1], L[2], L[3], H[0], H[1], H[2], H[3]}
  O[0] = MFMA16(pf, PKV(a0, b0), O[0]); O[1] = MFMA16(pf, PKV(a1, b1), O[1]); O[2] = MFMA16(pf, PKV(a2, b2), O[2]); O[3] = MFMA16(pf, PKV(a3, b3), O[3]);
#undef PKV
}
__device__ __forceinline__ bf16x8_t p_frag(const float (&pv)[8]) {
  u32x4_t w = {cvtpk(pv[0], pv[1]), cvtpk(pv[2], pv[3]), cvtpk(pv[4], pv[5]), cvtpk(pv[6], pv[7])}; return __builtin_bit_cast(bf16x8_t, w);
}
template <int PART>
__device__ __forceinline__ void na_part(const Params& p, unsigned char* wl, const bf16_t* __restrict__ Pbb, const int h, const int r, const int rs, const int cb, const int cs, const int qc, const int g0ctx,
                                        const bf16x8_t (&qf)[2], f32x4_t (&O)[4], float& mrun, float& lrun, const bool first, const int lane) {
  const int qi = lane & 15, g = lane >> 4;
  const int kap0 = 8 * (qi >> 2) + (qi & 3);
  float sv[8][8];
#pragma unroll
  for (int half = 0; half < 2; ++half) {
    bf16x8_t kf[4][2][2]; float bias[4][8];
#pragma unroll
    for (int q4 = 0; q4 < 4; ++q4) { const int gi = half * 4 + q4;
      const int tokbase = PART == 0 ? CTX + (rs + gi) * GW + cb : 32 * (g0ctx + gi);
#pragma unroll
      for (int T = 0; T < 2; ++T) { const bf16_t* kr = Pbb + (size_t)(tokbase + kap0 + 4 * T) * LDP + P1_NK + h * NA_D + 8 * g;
        kf[q4][T][0] = *reinterpret_cast<const bf16x8_t*>(kr); kf[q4][T][1] = *reinterpret_cast<const bf16x8_t*>(kr + 32);
#pragma unroll
        for (int e = 0; e < 4; ++e) { bias[q4][4 * T + e] = 0.f;
          if (PART == 0) { const int kcol = cb + 8 * g + 4 * T + e; const bool valid = kcol >= cs && kcol < cs + NA_KW;
            const int bi = (h * (2 * NA_KH - 1) + (rs + gi - r + NA_KH - 1)) * (2 * NA_KW - 1) + (valid ? kcol - qc + NA_KW - 1 : 0);
            bias[q4][4 * T + e] = valid ? p.rpb[bi] : -1e30f; } } } }
#pragma unroll
    for (int q4 = 0; q4 < 4; ++q4) { const int gi = half * 4 + q4;
#pragma unroll
      for (int T = 0; T < 2; ++T) {
        f32x4_t acc = {0.f, 0.f, 0.f, 0.f};
        acc = MFMA16(kf[q4][T][0], qf[0], acc); acc = MFMA16(kf[q4][T][1], qf[1], acc);
#pragma unroll
        for (int e = 0; e < 4; ++e) { const float sc = acc[e] * 0.125f; sv[gi][4 * T + e] = (PART == 0) ? (bias[q4][4 * T + e] < -1e29f ? -1e30f : sc + bias[q4][4 * T + e]) : sc; }
      } }
  }
  float mx = sv[0][0];
#pragma unroll
  for (int gi = 0; gi < 8; ++gi)
#pragma unroll
    for (int e = 0; e < 8; ++e) mx = fmaxf(mx, sv[gi][e]);
  mx = fmaxf(mx, __shfl_xor(mx, 16)); mx = fmaxf(mx, __shfl_xor(mx, 32));
  const float mn = first ? mx : fmaxf(mrun, mx), alpha = first ? 0.f : fast_exp(mrun - mn);
  float ls = 0.f;
#pragma unroll
  for (int gi = 0; gi < 8; ++gi)
#pragma unroll
    for (int e = 0; e < 8; ++e) { const float pe = fast_exp(sv[gi][e] - mn); sv[gi][e] = pe; ls += pe; }
  ls += __shfl_xor(ls, 16); ls += __shfl_xor(ls, 32);
  lrun = lrun * alpha + ls; mrun = mn;
  if (!first) {
#pragma unroll
    for (int e = 0; e < 4; ++e) { const float f = __shfl(alpha, 4 * g + e);
#pragma unroll
      for (int dt = 0; dt < 4; ++dt) O[dt][e] *= f; }
  }
  const int vb = LDS_ADDR(wl) + (8 * g + (qi >> 2)) * VP + 8 * (qi & 3);
#pragma unroll
  for (int c = 0; c < 4; ++c) {
#pragma unroll
    for (int it = 0; it < 8; ++it) { const int row = it * 8 + (lane >> 3), grp = row >> 5, kk = row & 31;
      const int tok = PART == 0 ? CTX + (rs + 2 * c + grp) * GW + cb + kk : 32 * (g0ctx + 2 * c + grp) + kk;
      *reinterpret_cast<u32x4_t*>(wl + row * VP + (lane & 7) * 16) = *reinterpret_cast<const u32x4_t*>(Pbb + (size_t)tok * LDP + P1_NV + h * NA_D + (lane & 7) * 8); }
    WAVE_LDS_SYNC();
    pv_group<0>(O, vb, p_frag(sv[2 * c]));
    pv_group<1>(O, vb, p_frag(sv[2 * c + 1]));
    WAVE_LDS_SYNC();
  }
}
__device__ __forceinline__ void fp_na(const Params& p, unsigned char* lds) {
  const int lane = threadIdx.x & 63, wid = UNIFORM((int)(threadIdx.x >> 6)), qi = lane & 15, g = lane >> 4;
  unsigned char* wl = wave_lds(lds, wid);
  const int nwaves = (int)gridDim.x * (NTHREADS / 64);
#pragma unroll 1
  for (int item = (int)blockIdx.x * (NTHREADS / 64) + wid; item < NB * NA_H * GROWS * 4; item += nwaves) {
    const int cg = item & 3, r = (item >> 2) % GROWS, h = (item / (4 * GROWS)) % NA_H, b = item / (4 * GROWS * NA_H);
    const int qc = cg * 16 + qi;
    int rs = r - NA_KH / 2; rs = rs < 0 ? 0 : (rs > GROWS - NA_KH ? GROWS - NA_KH : rs);
    int cb = cg * 16 - 8; cb = cb < 0 ? 0 : (cb > GW - 32 ? GW - 32 : cb);
    int cs = qc - NA_KW / 2; cs = cs < 0 ? 0 : (cs > GW - NA_KW ? GW - NA_KW : cs);
    const bf16_t* Pbb = p.Pb + (size_t)b * TB * LDP;
    const size_t tq = (size_t)CTX + r * GW + qc;
    bf16x8_t qf[2];
    qf[0] = *reinterpret_cast<const bf16x8_t*>(Pbb + tq * LDP + P1_NQ + h * NA_D + 8 * g);
    qf[1] = *reinterpret_cast<const bf16x8_t*>(Pbb + tq * LDP + P1_NQ + h * NA_D + 32 + 8 * g);
    f32x4_t O[4];
#pragma unroll
    for (int dt = 0; dt < 4; ++dt) O[dt] = (f32x4_t){0.f, 0.f, 0.f, 0.f};
    float mrun = -1e30f, lrun = 0.f;
    na_part<0>(p, wl, Pbb, h, r, rs, cb, cs, qc, 0, qf, O, mrun, lrun, true, lane);
#pragma unroll 1
    for (int g0 = 0; g0 < CTX / 32; g0 += 8) na_part<1>(p, wl, Pbb, h, r, rs, cb, cs, qc, g0, qf, O, mrun, lrun, false, lane);
    const float invl = 1.f / lrun;
#pragma unroll
    for (int e = 0; e < 4; ++e) {
      const float f = __shfl(invl, 4 * g + e);
      const size_t tl = (size_t)r * GW + cg * 16 + 4 * g + e, ml = (size_t)b * SEQ + tl;
      const bf16_t* zr = Pbb + ((size_t)CTX + tl) * LDP + P1_Z + BRC + h * NA_D + qi;
      bf16_t* orow = p.A0 + ml * LDA + BRC + h * NA_D + qi;
#pragma unroll
      for (int dt = 0; dt < 4; ++dt) orow[dt * 16] = f2bf(O[dt][e] * f * silu_f(bf2f(zr[dt * 16])));
    }
  }
}
}


namespace na2 {
constexpr int VP = 144, ROWB = 64 * VP, STG = 2 * ROWB;
constexpr int OFF_K = 0, OFF_V = 2 * STG, OFF_RPB = 4 * STG, NRPB = (2 * NA_KH - 1) * (2 * NA_KW - 1), LDS_NA = OFF_RPB + NRPB * 4;
template <int NG>
__device__ __forceinline__ void na_step(const float* rpl, const unsigned char* Kst, const unsigned char* Vst, const bool local, const int cb, const int r, const int krow0, const bool act0, const bool act1,
                                        const int cs, const int qc, const bf16x8_t (&qf)[2], f32x4_t (&O)[4], float& mrun, float& lrun, const int lane) {
  const int qi = lane & 15, g = lane >> 4, kap0 = 8 * (qi >> 2) + (qi & 3);
  float sv[NG][8];
#pragma unroll
  for (int gg = 0; gg < NG; ++gg) {
    const int k0 = local ? 64 * gg + cb : 32 * gg;
    const bool act = !local || (gg == 0 ? act0 : act1);
#pragma unroll
    for (int T = 0; T < 2; ++T) {
      const unsigned char* kr = Kst + (k0 + kap0 + 4 * T) * VP + 16 * g;
      f32x4_t acc = {0.f, 0.f, 0.f, 0.f};
      acc = MFMA16(*reinterpret_cast<const bf16x8_t*>(kr), qf[0], acc);
      acc = MFMA16(*reinterpret_cast<const bf16x8_t*>(kr + 64), qf[1], acc);
#pragma unroll
      for (int e = 0; e < 4; ++e) {
        float sc = acc[e] * 0.125f;
        if (local) { const int kcol = cb + 8 * g + 4 * T + e; const bool valid = act && kcol >= cs && kcol < cs + NA_KW;
          const int bi = (krow0 + gg - r + NA_KH - 1) * (2 * NA_KW - 1) + (valid ? kcol - qc + NA_KW - 1 : 0);
          sc = valid ? sc + rpl[valid ? bi : 0] : -1e30f; }
        sv[gg][4 * T + e] = sc;
      }
    }
  }
  float mx = sv[0][0];
#pragma unroll
  for (int gg = 0; gg < NG; ++gg)
#pragma unroll
    for (int e = 0; e < 8; ++e) mx = fmaxf(mx, sv[gg][e]);
  if (__any(mx > mrun + 8.f)) {
    mx = fmaxf(mx, __shfl_xor(mx, 16)); mx = fmaxf(mx, __shfl_xor(mx, 32));
    const float mn = fmaxf(mrun, mx), alpha = fast_exp(mrun - mn);
    lrun *= alpha; mrun = mn;
#pragma unroll
    for (int e = 0; e < 4; ++e) { const float f = __shfl(alpha, 4 * g + e);
#pragma unroll
      for (int dt = 0; dt < 4; ++dt) O[dt][e] *= f; }
  }
  float ls = 0.f;
#pragma unroll
  for (int gg = 0; gg < NG; ++gg)
#pragma unroll
    for (int e = 0; e < 8; ++e) { const float pe = fast_exp(sv[gg][e] - mrun); sv[gg][e] = pe; ls += pe; }
  lrun += ls;
#pragma unroll
  for (int gg = 0; gg < NG; ++gg) {
    const int k0 = local ? 64 * gg + cb : 32 * gg;
    const int vb = LDS_ADDR(Vst) + (k0 + 8 * g + (qi >> 2)) * VP + 8 * (qi & 3);
    na::pv_group<0>(O, vb, na::p_frag(sv[gg]));
  }
}
__device__ __forceinline__ void fp_na2(const Params& p, unsigned char* lds) {
  const int tid = threadIdx.x, lane = tid & 63, wid = UNIFORM(tid >> 6), qi = lane & 15, g = lane >> 4;
  const int skk = tid >> 3, sc16 = tid & 7;
  constexpr int NU = NB * NA_H * (GROWS / 2), NCS = CTX / 128;
  static_assert(CTX % 128 == 0, "context keys are staged 128 at a time");
  float* rpl = reinterpret_cast<float*>(lds + OFF_RPB);
  static_assert(NRPB <= NTHREADS, "bias table staging");
#pragma unroll 1
  for (int u = (int)blockIdx.x; u < NU; u += (int)gridDim.x) {
    const int rp = u % (GROWS / 2), h = (u / (GROWS / 2)) % NA_H, b = u / ((GROWS / 2) * NA_H);
    const int r = 2 * rp + (wid >> 2), cg = wid & 3, qc = cg * 16 + qi;
    int rs = r - NA_KH / 2; rs = rs < 0 ? 0 : (rs > GROWS - NA_KH ? GROWS - NA_KH : rs);
    int rlo = 2 * rp - NA_KH / 2; rlo = rlo < 0 ? 0 : (rlo > GROWS - NA_KH ? GROWS - NA_KH : rlo);
    int rhi = 2 * rp + 1 - NA_KH / 2; rhi = (rhi < 0 ? 0 : (rhi > GROWS - NA_KH ? GROWS - NA_KH : rhi)) + NA_KH - 1;
    const int nloc = (rhi - rlo + 2) / 2, nsteps = nloc + NCS;
    int cb = cg * 16 - 8; cb = cb < 0 ? 0 : (cb > GW - 32 ? GW - 32 : cb);
    int cs = qc - NA_KW / 2; cs = cs < 0 ? 0 : (cs > GW - NA_KW ? GW - NA_KW : cs);
    const bf16_t* Pbb = p.Pb + (size_t)b * TB * LDP;
    const size_t tq = (size_t)CTX + r * GW + qc;
    bf16x8_t qf[2];
    qf[0] = *reinterpret_cast<const bf16x8_t*>(Pbb + tq * LDP + P1_NQ + h * NA_D + 8 * g);
    qf[1] = *reinterpret_cast<const bf16x8_t*>(Pbb + tq * LDP + P1_NQ + h * NA_D + 32 + 8 * g);
    f32x4_t O[4];
#pragma unroll
    for (int dt = 0; dt < 4; ++dt) O[dt] = (f32x4_t){0.f, 0.f, 0.f, 0.f};
    float mrun = -1e30f, lrun = 0.f;
    static_assert(CTX / 128 + (NA_KH + 2) / 2 <= 7, "NA step unroll");
    u32x4_t ka0, va0, kb0, vb0_, ka1, va1, kb1, vb1_, ka2, va2, kb2, vb2_, ka3, va3, kb3, vb3_;
#define NA_LOAD(R_, s_) do { const int sl_ = (s_) < nsteps ? (s_) : nsteps - 1; \
    const int rowA_ = rlo + 2 * sl_, rowB_ = rowA_ + 1 > rhi ? rhi : rowA_ + 1; \
    const int tokA_ = sl_ < nloc ? CTX + rowA_ * GW : 128 * (sl_ - nloc), tokB_ = sl_ < nloc ? CTX + rowB_ * GW : 128 * (sl_ - nloc) + 64; \
    const bf16_t* sa_ = Pbb + (size_t)(tokA_ + skk) * LDP + h * NA_D + sc16 * 8; const bf16_t* sb_ = Pbb + (size_t)(tokB_ + skk) * LDP + h * NA_D + sc16 * 8; \
    ka##R_ = *reinterpret_cast<const u32x4_t*>(sa_ + P1_NK); va##R_ = *reinterpret_cast<const u32x4_t*>(sa_ + P1_NV); \
    kb##R_ = *reinterpret_cast<const u32x4_t*>(sb_ + P1_NK); vb##R_##_ = *reinterpret_cast<const u32x4_t*>(sb_ + P1_NV); } while (0)
#define NA_STORE(R_, buf_) do { unsigned char* kd_ = lds + OFF_K + (buf_) * STG + skk * VP + sc16 * 16; unsigned char* vd_ = lds + OFF_V + (buf_) * STG + skk * VP + sc16 * 16; \
    *reinterpret_cast<u32x4_t*>(kd_) = ka##R_; *reinterpret_cast<u32x4_t*>(vd_) = va##R_; *reinterpret_cast<u32x4_t*>(kd_ + ROWB) = kb##R_; *reinterpret_cast<u32x4_t*>(vd_ + ROWB) = vb##R_##_; } while (0)
#define NA_COMPUTE(s_, buf_) do { const unsigned char* Kst = lds + OFF_K + (buf_) * STG; const unsigned char* Vst = lds + OFF_V + (buf_) * STG; \
    if ((s_) < nloc) { const int kr0_ = rlo + 2 * (s_); const bool a0_ = kr0_ >= rs && kr0_ < rs + NA_KH, a1_ = kr0_ + 1 <= rhi && kr0_ + 1 >= rs && kr0_ + 1 < rs + NA_KH; \
      if (a0_ || a1_) na_step<2>(rpl, Kst, Vst, true, cb, r, kr0_, a0_, a1_, cs, qc, qf, O, mrun, lrun, lane); } \
    else if ((s_) < nsteps) na_step<4>(rpl, Kst, Vst, false, 0, r, 0, true, true, cs, qc, qf, O, mrun, lrun, lane); } while (0)
#define NA_STEP(s_, cur_, nxt_, buf_, nbuf_) do { NA_LOAD(cur_, (s_) + 4); NA_COMPUTE(s_, buf_); NA_STORE(nxt_, nbuf_); __syncthreads(); } while (0)
    NA_LOAD(0, 0); NA_LOAD(1, 1); NA_LOAD(2, 2); NA_LOAD(3, 3);
    if (tid < NRPB) rpl[tid] = p.rpb[(size_t)h * NRPB + tid];
    NA_STORE(0, 0);
    __syncthreads();
    NA_STEP(0, 0, 1, 0, 1);
    NA_STEP(1, 1, 2, 1, 0);
    NA_STEP(2, 2, 3, 0, 1);
    NA_STEP(3, 3, 0, 1, 0);
    NA_STEP(4, 0, 1, 0, 1);
    NA_STEP(5, 1, 2, 1, 0);
    NA_STEP(6, 2, 3, 0, 1);
#undef NA_STEP
#undef NA_COMPUTE
#undef NA_LOAD
#undef NA_STORE
    lrun += __shfl_xor(lrun, 16); lrun += __shfl_xor(lrun, 32);
    const float invl = 1.f / lrun;
#pragma unroll
    for (int e = 0; e < 4; ++e) {
      const float f = __shfl(invl, 4 * g + e);
      const size_t tl = (size_t)r * GW + cg * 16 + 4 * g + e, ml = (size_t)b * SEQ + tl;
      const bf16_t* zr = Pbb + ((size_t)CTX + tl) * LDP + P1_Z + BRC + h * NA_D + qi;
      bf16_t* orow = p.A0 + ml * LDA + BRC + h * NA_D + qi;
#pragma unroll
      for (int dt = 0; dt < 4; ++dt) orow[dt * 16] = f2bf(O[dt][e] * f * silu_f(bf2f(zr[dt * 16])));
    }
  }
}
}

__device__ __forceinline__ void fp_conv(const Params& p) {
  constexpr int CH8 = 2 * BRB / 8;
  for (long idx = gtid(); idx < (long)M * CH8; idx += gsize()) {
    const int c8 = (int)(idx % CH8), m = (int)(idx / CH8), t = m % TB, j0 = c8 * 8;
    const int lo = t < CTX ? 0 : CTX, hi = t < CTX ? CTX : TB;
    float y[8];
#pragma unroll
    for (int e = 0; e < 8; ++e) y[e] = p.conv_b[j0 + e];
#pragma unroll
    for (int tap = 0; tap < 3; ++tap) { const int tt = t + tap - 1;
      if (tt >= lo && tt < hi) { const bf16x8_t v = *reinterpret_cast<const bf16x8_t*>(p.Pb + (size_t)(m + tap - 1) * LDP + P0_MQ + j0);
#pragma unroll
        for (int e = 0; e < 8; ++e) y[e] += bf2f((bf16_t)v[e]) * p.conv_w[tap * 2 * BRB + j0 + e]; } }
    const float sc = j0 < BRB ? 0.08838834764831845f : 1.f;
#pragma unroll
    for (int e = 0; e < 8; ++e) y[e] = silu_f(y[e]) * sc;
    u32x4_t o; o.x = pk2bf(y[0], y[1]); o.y = pk2bf(y[2], y[3]); o.z = pk2bf(y[4], y[5]); o.w = pk2bf(y[6], y[7]);
    bf16_t* dst = j0 < BRB ? p.mqc + (size_t)m * BRB + j0 : p.mkc + (size_t)m * BRB + (j0 - BRB);
    *reinterpret_cast<u32x4_t*>(dst) = o;
  }
}
template <int LAYER> __device__ __forceinline__ void fp_comb(const Params& p) {
  static_assert(BRB == 512 && BRC == 512, "fp_comb: 4 heads x 128 channels");
  const int lane = threadIdx.x & 63, gw = (int)(gtid() >> 6), ngw = (int)(gsize() >> 6), c0 = lane * 8;
  const int NR = LAYER == 0 ? M : MLAT;
  for (int row = gw; row < NR; row += ngw) {
    const size_t m = LAYER == 0 ? (size_t)row : ((size_t)(row / SEQ) * TB + CTX + (row % SEQ));
    const bf16x8_t a = *reinterpret_cast<const bf16x8_t*>(p.Hf + hoff(c0, (size_t)row, (size_t)NR)), b = *reinterpret_cast<const bf16x8_t*>(p.Hb + hoff(c0, (size_t)row, (size_t)NR));
    const bf16x8_t z8 = *reinterpret_cast<const bf16x8_t*>(p.Pb + m * LDP + (LAYER == 0 ? P0_Z + BRA : P1_Z) + c0);
    float g[8]; float ss = 0.f;
    if (LAYER == 0) { const bf16x8_t mo = *reinterpret_cast<const bf16x8_t*>(p.Pb + m * LDP + P0_MO + c0);
#pragma unroll
      for (int e = 0; e < 8; ++e) g[e] = sigmoid_f(bf2f((bf16_t)mo[e])) * (bf2f((bf16_t)a[e]) + bf2f((bf16_t)b[e])); }
    else {
#pragma unroll
      for (int e = 0; e < 8; ++e) g[e] = bf2f((bf16_t)a[e]) + bf2f((bf16_t)b[e]); }
#pragma unroll
    for (int e = 0; e < 8; ++e) ss += g[e] * g[e];
    ss += __shfl_xor(ss, 1); ss += __shfl_xor(ss, 2); ss += __shfl_xor(ss, 4); ss += __shfl_xor(ss, 8);
    const float rstd = rsqrtf(ss * (1.f / 128.f) + EPS);
    const float* gain = (LAYER == 0 ? p.h_norm : p.gla_norm) + c0;
    float o[8];
#pragma unroll
    for (int e = 0; e < 8; ++e) o[e] = g[e] * rstd * gain[e] * silu_f(bf2f((bf16_t)z8[e]));
    u32x4_t w; w.x = pk2bf(o[0], o[1]); w.y = pk2bf(o[2], o[3]); w.z = pk2bf(o[4], o[5]); w.w = pk2bf(o[6], o[7]);
    *reinterpret_cast<u32x4_t*>(p.A0 + (size_t)row * LDA + (LAYER == 0 ? BRA : 0) + c0) = w;
  }
}

#ifndef NA_PHASE
#define NA_PHASE 9
#endif
constexpr int NPHASE = 15;
constexpr int DMP = (DM + 255) / 256 * 256, QWP = (QW + 255) / 256 * 256, KVWP = (KVW + 255) / 256 * 256;
constexpr bool FAST_OK = (TB % 256 == 0) && (CTX == 256) && (DM % 128 == 0) && (DM >= 256) && (QR % 128 == 0) && (KVR % 128 == 0) && (CW0 % 128 == 0) && (CW1 % 128 == 0);
template <int ph> __device__ __forceinline__ void run_phase_t(const Params& p, unsigned char* lds) {
  switch (ph) {
    case 0:
      if (FAST_OK) {
        fp_wt<0>(p.l0_w_in, nullptr, p.Wt0, DM, N0, LDP); fp_wt<1>(p.l1_w_in, nullptr, p.Wt1, DM, N1, LDP);
        fp_wt<2>(p.l0_w_out, nullptr, p.Wo0, CW0, DM, DMP); fp_wt<2>(p.l1_w_out, nullptr, p.Wo1, CW1, DM, DMP);
        fp_wt<2>(p.w_uq, p.q_norm, p.Wq, QR, QW, QWP); fp_wt<2>(p.w_ukv, p.kv_norm, p.Wkv, KVR, KVW, KVWP);
      }
      if (USE_FAST(0)) { fp_mod(p, (float*)lds); fp_zero(p); } else nv_mod(p);
      break;
    case 1:
      if (USE_FAST(1)) { fp_sw(p, (float*)lds); fp_prep0(p); } else { nv_prep0(p); nv_sw(p); }
      fp_gm1(p);
      break;
    case 2:
      if (USE_FAST(2)) run_gemm(lds, p.A0, LDA, p.Wt0, DM, M, LDP, DM, EpiIn<0>{p.Pb, p.ssq0, p.sw, p.ssq_q, p.ssq_kv, p.ropet});
      else nv_gemm_in<0>(p);
      break;
    case 3:
      if (USE_FAST(3)) { run_gemm(lds, p.Pb + P0_CQ, LDP, p.Wq, QR, M, QWP, QR, EpiQ{p.qb, p.ssq_q, p.ropet});
                         run_gemm(lds, p.Pb + P0_CKV, LDP, p.Wkv, KVR, M, KVWP, KVR, EpiKV{p.kn, p.vb, p.ssq_kv}); }
      else { nv_uq(p); nv_ukv(p); }
      if (USE_FAST(12)) fp_conv(p); else nv_conv(p);
      break;
    case 4:
      if (USE_FAST(13)) scan::mlstm_block<1>(p, lds); else nv_mlstm(p);
      if (USE_FAST(4)) { __syncthreads(); fp_attn(p, lds); } else nv_attn_mla(p);
      break;
    case 5: if (USE_FAST(13)) scan::mlstm_block<2>(p, lds); break;
    case 6: if (USE_FAST(5)) fp_comb<0>(p); else nv_comb0(p); break;
    case 7:
      if (USE_FAST(6)) run_gemm(lds, p.A0, LDA, p.Wo0, CW0, M, DMP, CW0, EpiOut0{p.x, p.ctx, p.modv, p.gm1, p.out, p.A1, p.ssq1});
      else nv_out0(p);
      break;
    case 8:
      if (USE_FAST(7)) run_gemm(lds, p.A1, LDA, p.Wt1, DM, M, LDP, DM, EpiIn<1>{p.Pb, p.ssq1, p.sw + (size_t)NV * LDP, nullptr, nullptr, nullptr});
      else nv_gemm_in<1>(p);
      break;
    case 9:
      if (USE_FAST(8)) scan::gla_prepass(p, lds); else nv_gla(p);
      if (NA_PHASE == 9) { if (USE_FAST(14)) { __syncthreads(); na2::fp_na2(p, lds); } else nv_na(p); }
      break;
    case 10:
      if (NA_PHASE == 10) { if (USE_FAST(14)) { na2::fp_na2(p, lds); __syncthreads(); } else nv_na(p); }
      if (USE_FAST(8)) scan::gla_block<1>(p, lds);
      break;
    case 11: if (USE_FAST(8)) scan::gla_block<2>(p, lds); break;
    case 12: if (USE_FAST(9)) fp_comb<1>(p); else nv_comb1(p); break;
    case 13:
      if (USE_FAST(10)) run_gemm(lds, p.A0, LDA, p.Wo1, CW1, MLAT, DMP, CW1, EpiOut1{p.modv, p.out, p.ssq2});
      else nv_out1(p);
      break;
    case 14: if (USE_FAST(11)) fp_final(p); else nv_final(p); break;
    default: break;
  }
}

#ifdef HOST_TEST
constexpr int TEST_THREADS = 512, TEST_GRID = 3;
static int phase_threads(int ph) {
  auto F = [](int b) { return (g_fastmask >> b) & 1; };
  switch (ph) {
    case 0: return F(0) ? 512 : 0;  case 1: return F(1) ? 512 : 0;  case 2: return F(2) ? 512 : 0;  case 3: return (F(3) || F(12)) ? 512 : 0;
    case 4: return (F(4) || F(13)) ? 512 : 128;  case 5: return 512;  case 6: return F(5) ? 512 : 0;  case 7: return F(6) ? 512 : 0;  case 8: return F(7) ? 512 : 0;
    case 9: return (F(8) || F(14)) ? 512 : 128;  case 10: return 512;  case 11: return 512;  case 12: return F(9) ? 512 : 0;  case 13: return F(10) ? 512 : 0;  case 14: return F(11) ? 512 : 0;
  }
  return 512;
}
#endif
constexpr size_t al256(size_t x) { return (x + 255) / 256 * 256; }
constexpr size_t WS_PB = 0;
constexpr size_t WS_A0 = WS_PB + al256((size_t)M * LDP * 2);
constexpr size_t WS_A1 = WS_A0 + al256((size_t)M * LDA * 2);
constexpr size_t WS_H = WS_A1 + al256((size_t)M * (LDA > 2 * BRB ? LDA : 2 * BRB) * 2);
constexpr size_t WS_SMALL = WS_H + al256((size_t)M * BRB * 2 * 2);
constexpr size_t WS_MODV = WS_SMALL;
constexpr size_t WS_SW = WS_MODV + al256((size_t)2 * NV * 3 * DM * 4);
constexpr size_t WS_SSQ = WS_SW + al256((size_t)2 * NV * LDP * 4);
constexpr size_t WS_GM1 = WS_SSQ + al256((size_t)5 * M * 4);
constexpr size_t WS_ROPE = WS_GM1 + al256((size_t)NV * DM * 4);
constexpr size_t WS_WT0 = WS_ROPE + al256((size_t)RPOS * 16 * 4);
constexpr size_t WS_WT1 = WS_WT0 + al256((size_t)LDP * DM * 2);
constexpr size_t WS_WO0 = WS_WT1 + al256((size_t)LDP * DM * 2);
constexpr size_t WS_WO1 = WS_WO0 + al256((size_t)DMP * CW0 * 2);
constexpr size_t WS_WQ = WS_WO1 + al256((size_t)DMP * CW1 * 2);
constexpr size_t WS_WKV = WS_WQ + al256((size_t)QWP * QR * 2);
constexpr size_t WS_SCAN = WS_WKV + al256((size_t)KVWP * KVR * 2);
constexpr size_t WS_END0 = WS_SCAN + al256((size_t)NB * ML_H * 2 * 4 * 7 * (4096 + 128 + 8) * 4);
constexpr bool QKV_IN_OUT = (size_t)M * (QW + 2 * BRA) * 2 <= (size_t)MLAT * DM * 4;
constexpr size_t WS_BAR = WS_END0;
constexpr size_t WS_BAR_BYTES = 16384;
constexpr size_t WS_QKV = WS_BAR + WS_BAR_BYTES;
constexpr size_t WS_END = WS_QKV + (QKV_IN_OUT ? 0 : al256((size_t)M * (QW + 2 * BRA) * 2));

__host__ __device__ inline void carve(Params& p, unsigned char* ws, float* out) {
  p.out = out;
  p.Pb = (bf16_t*)(ws + WS_PB); p.A0 = (bf16_t*)(ws + WS_A0); p.A1 = (bf16_t*)(ws + WS_A1);
  p.mqc = p.A1; p.mkc = p.A1 + (size_t)M * BRB;
  p.Hf = (bf16_t*)(ws + WS_H); p.Hb = p.Hf + (size_t)M * BRB;
  p.modv = (float*)(ws + WS_MODV); p.sw = (float*)(ws + WS_SW);
  float* s = (float*)(ws + WS_SSQ); p.ssq0 = s; p.ssq1 = s + M; p.ssq_q = s + 2 * M; p.ssq_kv = s + 3 * M; p.ssq2 = s + 4 * M;
  p.gm1 = (float*)(ws + WS_GM1); p.ropet = (float*)(ws + WS_ROPE); p.scanst = (float*)(ws + WS_SCAN);
  p.Wt0 = (bf16_t*)(ws + WS_WT0); p.Wt1 = (bf16_t*)(ws + WS_WT1); p.Wo0 = (bf16_t*)(ws + WS_WO0); p.Wo1 = (bf16_t*)(ws + WS_WO1); p.Wq = (bf16_t*)(ws + WS_WQ); p.Wkv = (bf16_t*)(ws + WS_WKV);
  p.qb = QKV_IN_OUT ? (bf16_t*)out : (bf16_t*)(ws + WS_QKV); p.kn = p.qb + (size_t)M * QW; p.vb = p.kn + (size_t)M * BRA;
}
__host__ __device__ inline void set_inputs(Params& p, void* const* d_in) {
  const float* const* in = (const float* const*)d_in;
  p.x = in[0]; p.c = in[1]; p.ctx = in[2]; p.c_ctx = in[3];
  p.l0_norm = in[4]; p.l0_w_mod = in[5]; p.l0_b_mod = in[6]; p.l0_w_in = in[7]; p.q_norm = in[8]; p.w_uq = in[9]; p.kv_norm = in[10]; p.w_ukv = in[11];
  p.conv_w = in[12]; p.conv_b = in[13]; p.b_i = in[14]; p.b_f = in[15]; p.h_norm = in[16]; p.l0_w_out = in[17];
  p.l1_norm = in[18]; p.l1_w_mod = in[19]; p.l1_b_mod = in[20]; p.l1_w_in = in[21]; p.w_gate = in[22]; p.b_gate = in[23]; p.gla_norm = in[24]; p.rpb = in[25];
  p.l1_w_out = in[26]; p.final_norm = in[27];
}


#ifndef HOST_TEST
#define LAS __attribute__((address_space(3)))
#define XB_TMO      128
#define XB_XCNT(j)  (256  + 64 * (j))
#define XB_XSUB(j)  (1280 + 64 * (j))
#define XB_XGEN(j)  (2304 + 64 * (j))
#define XB_TOP      3328
#define XB_TOPGEN   3392
#define XCD_BAR_WORDS 3456
#define XB_SPIN_CAP (1u << 18)

__device__ __forceinline__ unsigned xb_ld(unsigned* p)              { return __hip_atomic_load(p, __ATOMIC_RELAXED, __HIP_MEMORY_SCOPE_AGENT); }
__device__ __forceinline__ unsigned xb_add(unsigned* p, unsigned v) { return __hip_atomic_fetch_add(p, v, __ATOMIC_RELAXED, __HIP_MEMORY_SCOPE_AGENT); }
__device__ __forceinline__ unsigned xb_xcc_id() { return (unsigned)__builtin_amdgcn_s_getreg((3 << 11) | 20) & 0xFu; }
#define XB_SPIN(cond, bar) do { unsigned _sp = 0; while (cond) { __builtin_amdgcn_s_sleep(1); \
    if ((++_sp & 255u) == 0u) { if (xb_ld(&(bar)[XB_TMO])) break; if (_sp > XB_SPIN_CAP) { atomicAdd(&(bar)[XB_TMO], 1u); break; } } } } while (0)

struct XcdBarrier {
    unsigned* bar; unsigned x;
    volatile LAS unsigned* st;
};

__device__ __forceinline__ XcdBarrier xcd_barrier_post(unsigned* bar, volatile LAS unsigned* st) {
    XcdBarrier b; b.bar = bar; b.x = xb_xcc_id(); b.st = st;
    if (threadIdx.x == 0) (void)xb_add(&bar[XB_XCNT(b.x)], 1u);
    return b;
}
__device__ __forceinline__ void xcd_barrier_complete(unsigned* bar, unsigned x, unsigned& nloc, unsigned& nx) {
    const unsigned G = gridDim.x * gridDim.y * gridDim.z;
    unsigned sum, cnt, mine, sp = 0u;
    for (;;) {
        sum = 0u; cnt = 0u; mine = 0u;
#pragma unroll
        for (unsigned j = 0; j < 16; ++j) { const unsigned c = xb_ld(&bar[XB_XCNT(j)]); sum += c; cnt += (c > 0u) ? 1u : 0u; mine = (j == x) ? c : mine; }
        if (sum == G) break;
        __builtin_amdgcn_s_sleep(1);
        if ((++sp & 255u) == 0u) { if (xb_ld(&bar[XB_TMO])) break; if (sp > XB_SPIN_CAP) { atomicAdd(&bar[XB_TMO], 1u); break; } }
    }
    nloc = mine > 0u ? mine : 1u; nx = cnt > 0u ? cnt : 1u;
}

__device__ __forceinline__ void xcd_barrier(const XcdBarrier& b) {
    asm volatile("s_waitcnt vmcnt(0)" ::: "memory");
    __syncthreads();
    if (threadIdx.x == 0) {
        unsigned* bar = b.bar;
        __builtin_amdgcn_s_waitcnt(0);
        unsigned nloc = b.st[0], nx = b.st[1];
        if (nloc == 0u) { xcd_barrier_complete(bar, b.x, nloc, nx); b.st[0] = nloc; b.st[1] = nx; }
        const unsigned old = xb_add(&bar[XB_XSUB(b.x)], 1u);
        const unsigned gen = old / nloc;
        if (old + 1u == (gen + 1u) * nloc) {
            __builtin_amdgcn_fence(__ATOMIC_RELEASE, "agent");
            asm volatile("s_waitcnt vmcnt(0)" ::: "memory");
            const unsigned og = xb_add(&bar[XB_TOP], 1u);
            const unsigned tg = og / nx;
            if (og + 1u == (tg + 1u) * nx) xb_add(&bar[XB_TOPGEN], 1u);
            else XB_SPIN(xb_ld(&bar[XB_TOPGEN]) == tg, bar);
            __builtin_amdgcn_fence(__ATOMIC_ACQUIRE, "agent");
            xb_add(&bar[XB_XGEN(b.x)], 1u);
            asm volatile("s_waitcnt vmcnt(0)" ::: "memory");
        } else {
            XB_SPIN(xb_ld(&bar[XB_XGEN(b.x)]) == gen, bar);
            __builtin_amdgcn_fence(__ATOMIC_ACQUIRE, "agent");
            asm volatile("s_waitcnt vmcnt(0)" ::: "memory");
        }
    }
    __syncthreads();
}
#endif
struct KArgs { const float* in[28]; float* out; unsigned char* ws; int ph_lo, ph_hi; };
template <int ph> __device__ __forceinline__ void phase_scoped(const KArgs& a, unsigned char* lds) {
  Params p; set_inputs(p, (void* const*)a.in); carve(p, a.ws, a.out); p.ph_lo = 0; p.ph_hi = 0;
  run_phase_t<ph>(p, lds);
}
#ifdef HOST_TEST
static void run_phase(const KArgs& a, int ph, unsigned char* lds) {
  switch (ph) { case 0: phase_scoped<0>(a, lds); break; case 1: phase_scoped<1>(a, lds); break; case 2: phase_scoped<2>(a, lds); break; case 3: phase_scoped<3>(a, lds); break;
    case 4: phase_scoped<4>(a, lds); break; case 5: phase_scoped<5>(a, lds); break; case 6: phase_scoped<6>(a, lds); break; case 7: phase_scoped<7>(a, lds); break;
    case 8: phase_scoped<8>(a, lds); break; case 9: phase_scoped<9>(a, lds); break; case 10: phase_scoped<10>(a, lds); break; case 11: phase_scoped<11>(a, lds); break; case 12: phase_scoped<12>(a, lds); break; case 13: phase_scoped<13>(a, lds); break; case 14: phase_scoped<14>(a, lds); break; default: break; }
}
#endif

#ifndef HOST_TEST
constexpr int LDS_BYTES = 151552;
__global__ void __launch_bounds__(NTHREADS, 2) mega(KArgs a) {
  extern __shared__ __attribute__((aligned(16))) unsigned char lds[];
  cg::grid_group grid = cg::this_grid();
  volatile LAS unsigned* bst = (volatile LAS unsigned*)((LAS unsigned char*)lds + (LDS_BYTES - 64));
  if (threadIdx.x < 2) bst[threadIdx.x] = 0u;
  __syncthreads();
  const XcdBarrier bar = xcd_barrier_post((unsigned*)(a.ws + WS_BAR), bst);
#ifndef DUPMASK
#define DUPMASK 0
#endif
#define PHASE(k) if (a.ph_lo <= (k) && (k) < a.ph_hi) { if ((DUPMASK >> (k)) & 1) { phase_scoped<k>(a, lds); xcd_barrier(bar); } phase_scoped<k>(a, lds); if ((k) + 1 < a.ph_hi) { if ((k) == 0) { asm volatile("s_waitcnt vmcnt(0) lgkmcnt(0)" ::: "memory"); grid.sync(); } else xcd_barrier(bar); } }
  PHASE(0) PHASE(1) PHASE(2) PHASE(3) PHASE(4) PHASE(5) PHASE(6) PHASE(7) PHASE(8) PHASE(9) PHASE(10) PHASE(11) PHASE(12) PHASE(13) PHASE(14)
#undef PHASE
}

extern "C" void kernel_launch(void* const* d_in, const int* in_sizes, int n_in, void* d_out, int out_size, void* d_ws, size_t ws_size, hipStream_t stream) {
  static int grid = 0;
  if (grid == 0) {
    int dev = 0, cus = 0, per_cu = 0;
    (void)hipGetDevice(&dev);
    (void)hipDeviceGetAttribute(&cus, hipDeviceAttributeMultiprocessorCount, dev);
    (void)hipFuncSetAttribute((const void*)mega, hipFuncAttributeMaxDynamicSharedMemorySize, LDS_BYTES);
    (void)hipOccupancyMaxActiveBlocksPerMultiprocessor(&per_cu, (const void*)mega, NTHREADS, LDS_BYTES);
    fprintf(stderr, "kernel_launch: cus=%d per_cu=%d ws_size=%zu need=%zu n_in=%d out_size=%d\n", cus, per_cu, ws_size, (size_t)WS_END, n_in, out_size);
    grid = cus;
    if (n_in != 28 || ws_size < WS_END || out_size != MLAT * DM || per_cu < 1) { fprintf(stderr, "kernel_launch: unexpected shapes / workspace; nothing launched\n"); grid = -1; }
  }
  if (grid < 0) return;
  if (hipMemsetAsync((unsigned char*)d_ws + WS_BAR, 0, WS_BAR_BYTES, stream) != hipSuccess) { fprintf(stderr, "kernel_launch: memset of the barrier words failed\n"); return; }
  KArgs a{};
  for (int i = 0; i < 28; ++i) a.in[i] = (const float*)d_in[i];
  a.out = (float*)d_out; a.ws = (unsigned char*)d_ws; a.ph_lo = 0; a.ph_hi = NPHASE;
  void* args[] = {&a};
  hipError_t e = hipLaunchCooperativeKernel((const void*)mega, dim3(grid), dim3(NTHREADS), args, LDS_BYTES, stream);
  if (e != hipSuccess) fprintf(stderr, "cooperative launch failed: %s (grid %d)\n", hipGetErrorString(e), grid);
}
#endif
```

```cpp
#ifndef HOST_TEST
#include <hip/hip_runtime.h>
#include <hip/hip_cooperative_groups.h>
#include <cstdio>
#include <cstdint>
namespace cg = cooperative_groups;
#endif

#if defined(SMALL_CFG)
constexpr int DM = 128, NB = 2, SEQ = 256, GW = 16, CTX = 64, MLA_H = 2, QR = 48, KVR = 32, ML_H = 2, GLA_H = 2, NA_H = 2;
#elif defined(MED_CFG)
constexpr int DM = 256, NB = 1, SEQ = 1024, GW = 64, CTX = 256, MLA_H = 8, QR = 384, KVR = 256, ML_H = 4, GLA_H = 4, NA_H = 8;
#else
constexpr int DM = 1024, NB = 8, SEQ = 4096, GW = 64, CTX = 256, MLA_H = 8, QR = 384, KVR = 256, ML_H = 4, GLA_H = 4, NA_H = 8;
#endif
constexpr int NOPE = 64, ROPE = 32, VD = 64, QD = 96, ML_D = 128, GLA_DK = 64, GLA_DV = 128, GRANK = 16, NA_D = 64, NA_KH = 8, NA_KW = 16;
constexpr float EPS = 1e-6f;
constexpr int BRA = MLA_H * VD, BRB = ML_H * ML_D, BRC = GLA_H * GLA_DV, BRD = NA_H * NA_D;
constexpr int TB = CTX + SEQ, M = NB * TB, MLAT = NB * SEQ, NV = NB + 1, GROWS = SEQ / GW;
constexpr int QW = MLA_H * QD, KVW = MLA_H * (NOPE + VD);
constexpr int S0_CQ = 0, S0_CKV = QR, S0_KR = QR + KVR, S0_MQ = S0_KR + ROPE, S0_MK = S0_MQ + BRB, S0_MV = S0_MK + BRB, S0_MO = S0_MV + BRB,
              S0_G = S0_MO + BRB, S0_Z = S0_G + 4 * ML_H, N0 = S0_Z + BRA + BRB;
constexpr int P0_CQ = 0, P0_CKV = QR, P0_MQ = QR + KVR, P0_MK = P0_MQ + BRB, P0_MV = P0_MK + BRB, P0_MO = P0_MV + BRB, P0_Z = P0_MO + BRB,
              P0_KR = P0_Z + BRA + BRB, P0_G = P0_KR + ROPE;
static_assert(P0_G + 4 * ML_H == N0, "layer-0 column map");
constexpr int S1_GQ = 0, S1_GK = GLA_H * GLA_DK, S1_GV = 2 * GLA_H * GLA_DK, S1_GA = S1_GV + BRC, S1_NQ = S1_GA + 2 * GRANK, S1_NK = S1_NQ + BRD,
              S1_NV = S1_NK + BRD, S1_Z = S1_NV + BRD, N1 = S1_Z + BRC + BRD;
constexpr int P1_GQ = 0, P1_GK = S1_GK, P1_GV = S1_GV, P1_NQ = S1_GA, P1_NK = P1_NQ + BRD, P1_NV = P1_NK + BRD, P1_Z = P1_NV + BRD, P1_GA = P1_Z + BRC + BRD;
static_assert(P1_GA + 2 * GRANK == N1, "layer-1 column map");
constexpr int NMAX = N0 > N1 ? N0 : N1;
constexpr int LDP = (NMAX + 255) / 256 * 256;
constexpr float LOG2E = 1.4426950408889634f;
constexpr float C2Q = 0.10206207261596575f * LOG2E;
constexpr int NTHREADS = 512;
constexpr int RPOS = GW > GROWS ? GW : GROWS;
constexpr int CW0 = BRA + BRB, CW1 = BRC + BRD;
constexpr int LDA = (DM > CW0 ? (DM > CW1 ? DM : CW1) : (CW0 > CW1 ? CW0 : CW1));

__device__ __forceinline__ int l0_src(int j) {
  if (j < P0_MQ) return j;
  if (j < P0_Z) return S0_MQ + (j - P0_MQ);
  if (j < P0_KR) return S0_Z + (j - P0_Z);
  if (j < P0_G) return S0_KR + (j - P0_KR);
  if (j < N0) return S0_G + (j - P0_G);
  return -1;
}
__device__ __forceinline__ int l1_src(int j) {
  if (j < P1_NQ) return j;
  if (j < P1_Z) return S1_NQ + (j - P1_NQ);
  if (j < P1_GA) return S1_Z + (j - P1_Z);
  if (j < N1) return S1_GA + (j - P1_GA);
  return -1;
}

typedef unsigned short bf16_t;
#ifdef HOST_TEST
static inline float fast_exp(float x) { return expf(x); }
static inline float fast_log(float x) { return logf(x); }
#else
__device__ __forceinline__ float fast_exp(float x) { return __expf(x); }
__device__ __forceinline__ float fast_log(float x) { return __logf(x); }
#endif
__device__ __forceinline__ float bf2f(bf16_t h) { unsigned u = (unsigned)h << 16; float f; __builtin_memcpy(&f, &u, 4); return f; }
__device__ __forceinline__ bf16_t f2bf(float f) { unsigned u; __builtin_memcpy(&u, &f, 4); return (bf16_t)((u + 0x7fffu + ((u >> 16) & 1u)) >> 16); }
__device__ __forceinline__ float silu_f(float x) { return x / (1.f + fast_exp(-x)); }
__device__ __forceinline__ float sigmoid_f(float x) { return 1.f / (1.f + fast_exp(-x)); }
__device__ __forceinline__ float log_sigmoid_f(float x) { return fminf(x, 0.f) - log1pf(fast_exp(-fabsf(x))); }

struct Params {
  const float *x, *c, *ctx, *c_ctx;
  const float *l0_norm, *l0_w_mod, *l0_b_mod, *l0_w_in, *q_norm, *w_uq, *kv_norm, *w_ukv, *conv_w, *conv_b, *b_i, *b_f, *h_norm, *l0_w_out;
  const float *l1_norm, *l1_w_mod, *l1_b_mod, *l1_w_in, *w_gate, *b_gate, *gla_norm, *rpb, *l1_w_out, *final_norm;
  float* out;
  unsigned* bar;
  float *modv;
  float *sw;
  float *ssq0, *ssq1;
  float *ssq_q, *ssq_kv;
  float *ssq2;
  float *gm1;
  float *ropet;
  float *scanst;
  bf16_t *Wt0, *Wt1, *Wo0, *Wo1, *Wq, *Wkv;
  bf16_t *A0;
  bf16_t *A1;
  bf16_t *mqc, *mkc;
  bf16_t *Pb;
  bf16_t *qb, *kn, *vb;
  bf16_t *Hf, *Hb;
  int ph_lo, ph_hi;
};

__device__ __forceinline__ long gtid() { return (long)blockIdx.x * blockDim.x + threadIdx.x; }
__device__ __forceinline__ long gsize() { return (long)gridDim.x * blockDim.x; }

__device__ __forceinline__ size_t hoff(int c, size_t row, size_t NR) { return ((size_t)(c >> 5) * NR + row) * 32 + (c & 31); }
__device__ __forceinline__ int row_variant(int m) { const int b = m / TB, t = m % TB; return t < CTX ? NB : b; }
__device__ __forceinline__ const float* row_input(const Params& p, int m) {
  const int b = m / TB, t = m % TB;
  return t < CTX ? p.ctx + ((size_t)b * CTX + t) * DM : p.x + ((size_t)b * SEQ + (t - CTX)) * DM;
}
__device__ __forceinline__ float rope_inv(int i) { return exp2f(-(float)i * (13.287712379549449f / 8.f)); }

__device__ __forceinline__ void nv_mod_l(const Params& p, const int l, const float* __restrict__ w, const float* __restrict__ b) {
  for (long idx = gtid(); idx < (long)NV * 3 * DM; idx += gsize()) {
    const int v = (int)(idx / (3 * DM)), j = (int)(idx % (3 * DM));
    const float* cv = p.c + (size_t)(v < NB ? v : 0) * DM;
    float acc = b[j];
    for (int k = 0; k < DM; ++k) { const float cc = v < NB ? cv[k] : p.c_ctx[k]; acc += silu_f(cc) * w[(size_t)k * 3 * DM + j]; }
    p.modv[(size_t)l * NV * 3 * DM + idx] = acc;
  }
}
__device__ __forceinline__ void nv_mod(const Params& p) {
  nv_mod_l(p, 0, p.l0_w_mod, p.l0_b_mod);
  nv_mod_l(p, 1, p.l1_w_mod, p.l1_b_mod);
  for (long i = gtid(); i < M; i += gsize()) { p.ssq_q[i] = 0.f; p.ssq_kv[i] = 0.f; p.ssq1[i] = 0.f; if (i < MLAT) p.ssq2[i] = 0.f; }
}
__device__ __forceinline__ void nv_prep0(const Params& p) {
  for (long m = gtid(); m < M; m += gsize()) {
    const float* xr = row_input(p, (int)m); const int v = row_variant((int)m);
    const float* sc = p.modv + ((size_t)0 * NV + v) * 3 * DM + DM;
    float ss = 0.f;
    for (int k = 0; k < DM; ++k) { const float xv = xr[k]; ss += xv * xv; p.A0[(size_t)m * LDA + k] = f2bf(xv * p.l0_norm[k] * (1.f + sc[k])); }
    p.ssq0[m] = ss;
  }
}
template <int L> __device__ __forceinline__ void nv_sw_l(const Params& p, const float* __restrict__ w) {
  constexpr int NO = L ? N1 : N0;
  for (long idx = gtid(); idx < (long)NV * LDP; idx += gsize()) {
    const int v = (int)(idx / LDP), j = (int)(idx % LDP);
    const int src = L ? l1_src(j) : l0_src(j);
    const float* sh = p.modv + ((size_t)L * NV + v) * 3 * DM;
    float acc = 0.f;
    if (src >= 0) for (int k = 0; k < DM; ++k) acc += sh[k] * w[(size_t)k * NO + src];
    p.sw[(size_t)L * NV * LDP + idx] = acc;
  }
}
__device__ __forceinline__ void nv_sw(const Params& p) { nv_sw_l<0>(p, p.l0_w_in); nv_sw_l<1>(p, p.l1_w_in); }
template <int l> __device__ __forceinline__ void nv_gemm_in(const Params& p) {
  constexpr int NO = l ? N1 : N0; const float* __restrict__ w = l ? p.l1_w_in : p.l0_w_in; const bf16_t* __restrict__ A = l ? p.A1 : p.A0; const float* __restrict__ ssq = l ? p.ssq1 : p.ssq0;
  for (long idx = gtid(); idx < (long)(M / 4) * NO; idx += gsize()) {
    const int j = (int)(idx % NO), mg = (int)(idx / NO);
    const int src = l ? l1_src(j) : l0_src(j);
    const bool rope = (l == 0) && j >= P0_KR && j < P0_KR + ROPE && ((mg * 4) % TB) >= CTX;
    int jj = 0, src2 = src; if (rope) { jj = j - P0_KR; src2 = ((jj & 15) < 8) ? src + 8 : src - 8; }
    float acc[4] = {0.f, 0.f, 0.f, 0.f}, acc2[4] = {0.f, 0.f, 0.f, 0.f};
    for (int k = 0; k < DM; ++k) {
      const float wv = w[(size_t)k * NO + src], wv2 = w[(size_t)k * NO + src2];
#pragma unroll
      for (int r = 0; r < 4; ++r) { const float a = bf2f(A[(size_t)(mg * 4 + r) * LDA + k]); acc[r] += a * wv; acc2[r] += a * wv2; }
    }
#pragma unroll
    for (int r = 0; r < 4; ++r) {
      const int m = mg * 4 + r, v = row_variant(m);
      const float rstd = rsqrtf(ssq[m] * (1.f / DM) + EPS);
      const float* swv = p.sw + ((size_t)l * NV + v) * LDP;
      float val = rstd * acc[r] + swv[j];
      if (rope) {
        const int j2 = ((jj & 15) < 8) ? j + 8 : j - 8;
        const float val2 = rstd * acc2[r] + swv[j2];
        const int tl = (m % TB) - CTX, pos = (jj < 16) ? tl / GW : tl % GW;
        const float ang = (float)pos * rope_inv(jj & 7); const float cs = cosf(ang), sn = sinf(ang);
        val = ((jj & 15) < 8) ? val * cs - val2 * sn : val * cs + val2 * sn;
      }
      p.Pb[(size_t)m * LDP + j] = f2bf(val);
      if (l == 0 && j < QR) atomicAdd(&p.ssq_q[m], val * val); else if (l == 0 && j < QR + KVR) atomicAdd(&p.ssq_kv[m], val * val);
    }
  }
}
__device__ __forceinline__ void nv_uq(const Params& p) {
  for (long idx = gtid(); idx < (long)M * QW; idx += gsize()) {
    const int j = (int)(idx % QW), m = (int)(idx / QW);
    const int jh = j % QD; const bool rope = jh >= NOPE && (m % TB) >= CTX;
    const int jj = jh - NOPE; const int j2 = rope ? (((jj & 15) < 8) ? j + 8 : j - 8) : j;
    float acc = 0.f, acc2 = 0.f;
    for (int k = 0; k < QR; ++k) { const float a = bf2f(p.Pb[(size_t)m * LDP + P0_CQ + k]) * p.q_norm[k]; acc += a * p.w_uq[(size_t)k * QW + j]; acc2 += a * p.w_uq[(size_t)k * QW + j2]; }
    const float rstd = rsqrtf(p.ssq_q[m] * (1.f / QR) + EPS);
    float val = acc * rstd;
    if (rope) {
      const float val2 = acc2 * rstd; const int tl = (m % TB) - CTX, pos = (jj < 16) ? tl / GW : tl % GW;
      const float ang = (float)pos * rope_inv(jj & 7); const float cs = cosf(ang), sn = sinf(ang);
      val = ((jj & 15) < 8) ? val * cs - val2 * sn : val * cs + val2 * sn;
    }
    p.qb[(size_t)m * QW + j] = f2bf(val * C2Q);
  }
}
__device__ __forceinline__ void nv_ukv(const Params& p) {
  for (long idx = gtid(); idx < (long)M * KVW; idx += gsize()) {
    const int j = (int)(idx % KVW), m = (int)(idx / KVW);
    float acc = 0.f;
    for (int k = 0; k < KVR; ++k) acc += bf2f(p.Pb[(size_t)m * LDP + P0_CKV + k]) * p.kv_norm[k] * p.w_ukv[(size_t)k * KVW + j];
    const float val = acc * rsqrtf(p.ssq_kv[m] * (1.f / KVR) + EPS);
    const int hh = j / (NOPE + VD), jj = j % (NOPE + VD);
    if (jj < NOPE) p.kn[(size_t)m * BRA + hh * NOPE + jj] = f2bf(val); else p.vb[(size_t)m * BRA + hh * VD + (jj - NOPE)] = f2bf(val);
  }
}
__device__ __forceinline__ void nv_conv(const Params& p) {
  for (long idx = gtid(); idx < (long)M * 2 * BRB; idx += gsize()) {
    const int j = (int)(idx % (2 * BRB)), m = (int)(idx / (2 * BRB)); const int t = m % TB;
    const int lo = t < CTX ? 0 : CTX, hi = t < CTX ? CTX : TB;
    float y = p.conv_b[j];
#pragma unroll
    for (int tap = 0; tap < 3; ++tap) { const int tt = t + tap - 1; if (tt >= lo && tt < hi) y += bf2f(p.Pb[(size_t)(m + tap - 1) * LDP + P0_MQ + j]) * p.conv_w[tap * 2 * BRB + j]; }
    y = silu_f(y);
    if (j < BRB) p.mqc[(size_t)m * BRB + j] = f2bf(y * 0.08838834764831845f); else p.mkc[(size_t)m * BRB + (j - BRB)] = f2bf(y);
  }
}
__device__ __forceinline__ void nv_attn_mla(const Params& p) {
  for (long idx = gtid(); idx < (long)NB * MLA_H * TB; idx += gsize()) {
    const int t = (int)(idx % TB), h = (int)((idx / TB) % MLA_H), b = (int)(idx / ((long)TB * MLA_H));
    const int m = b * TB + t; const int nkeys = t < CTX ? CTX : TB;
    float q[QD], o[VD];
#pragma unroll
    for (int d = 0; d < QD; ++d) q[d] = bf2f(p.qb[(size_t)m * QW + h * QD + d]);
#pragma unroll
    for (int d = 0; d < VD; ++d) o[d] = 0.f;
    float mx = -1e30f, l = 0.f;
    for (int key = 0; key < nkeys; ++key) {
      const size_t kk = (size_t)b * TB + key; float s = 0.f;
#pragma unroll
      for (int d = 0; d < NOPE; ++d) s += q[d] * bf2f(p.kn[kk * BRA + h * NOPE + d]);
#pragma unroll
      for (int d = 0; d < ROPE; ++d) s += q[NOPE + d] * bf2f(p.Pb[kk * LDP + P0_KR + d]);
      const float mn = fmaxf(mx, s), alpha = exp2f(mx - mn), pp = exp2f(s - mn);
      l = l * alpha + pp; mx = mn;
#pragma unroll
      for (int d = 0; d < VD; ++d) o[d] = o[d] * alpha + pp * bf2f(p.vb[kk * BRA + h * VD + d]);
    }
    const float il = 1.f / l;
#pragma unroll
    for (int d = 0; d < VD; ++d) p.A0[(size_t)m * LDA + h * VD + d] = f2bf(o[d] * il * silu_f(bf2f(p.Pb[(size_t)m * LDP + P0_Z + h * VD + d])));
  }
}
__device__ __forceinline__ int seq_token(int s, int dir) {
  if (dir == 0) return s;
  return s < CTX ? CTX - 1 - s : TB - 1 - (s - CTX);
}
__device__ __forceinline__ void nv_mlstm(const Params& p) {
  __shared__ float qs[ML_D], ks[ML_D], red[ML_D];
  const int j = threadIdx.x;
  for (int item = blockIdx.x; item < NB * ML_H * 2; item += gridDim.x) {
    const int dir = item & 1, h = (item >> 1) % ML_H, b = item / (2 * ML_H);
    float C[ML_D]; float nj = 0.f, mst = 0.f;
#pragma unroll
    for (int d = 0; d < ML_D; ++d) C[d] = 0.f;
    bf16_t* Hout = dir ? p.Hb : p.Hf;
    for (int s = 0; s < TB; ++s) {
      const int t = seq_token(s, dir); const size_t m = (size_t)b * TB + t;
      const float ig = bf2f(p.Pb[m * LDP + P0_G + dir * 2 * ML_H + h]) + p.b_i[dir * ML_H + h];
      const float lf = log_sigmoid_f(bf2f(p.Pb[m * LDP + P0_G + dir * 2 * ML_H + ML_H + h]) + p.b_f[dir * ML_H + h]);
      const float mn = fmaxf(lf + mst, ig), decay = fast_exp(lf + mst - mn), iw = fast_exp(ig - mn); mst = mn;
      float vj = 0.f;
      if (j < ML_D) { qs[j] = bf2f(p.mqc[m * BRB + h * ML_D + j]); ks[j] = bf2f(p.mkc[m * BRB + h * ML_D + j]); vj = bf2f(p.Pb[m * LDP + P0_MV + h * ML_D + j]); }
      __syncthreads();
      float num = 0.f;
      if (j < ML_D) {
#pragma unroll
        for (int d = 0; d < ML_D; ++d) { C[d] = decay * C[d] + iw * ks[d] * vj; num += qs[d] * C[d]; }
        nj = decay * nj + iw * ks[j]; red[j] = qs[j] * nj;
      }
      __syncthreads();
      if (j < ML_D) {
        float den = 0.f;
        for (int d = 0; d < ML_D; ++d) den += red[d];
        Hout[hoff(h * ML_D + j, m, M)] = f2bf(num / fmaxf(fabsf(den), fast_exp(-mst)));
      }
      __syncthreads();
    }
  }
}
__device__ __forceinline__ void nv_comb0(const Params& p) {
  for (long idx = gtid(); idx < (long)M * ML_H; idx += gsize()) {
    const int hh = (int)(idx % ML_H); const size_t m = (size_t)(idx / ML_H);
    float ss = 0.f;
    for (int d = 0; d < ML_D; ++d) { const int c = hh * ML_D + d;
      const float g = sigmoid_f(bf2f(p.Pb[m * LDP + P0_MO + c])) * (bf2f(p.Hf[hoff(c, m, M)]) + bf2f(p.Hb[hoff(c, m, M)])); ss += g * g; }
    const float rstd = rsqrtf(ss * (1.f / ML_D) + EPS);
    for (int d = 0; d < ML_D; ++d) { const int c = hh * ML_D + d;
      const float g = sigmoid_f(bf2f(p.Pb[m * LDP + P0_MO + c])) * (bf2f(p.Hf[hoff(c, m, M)]) + bf2f(p.Hb[hoff(c, m, M)]));
      p.A0[m * LDA + BRA + c] = f2bf(g * rstd * p.h_norm[c] * silu_f(bf2f(p.Pb[m * LDP + P0_Z + BRA + c]))); }
  }
}
__device__ __forceinline__ void nv_out0(const Params& p) {
  for (long idx = gtid(); idx < (long)(M / 4) * DM; idx += gsize()) {
    const int j = (int)(idx % DM), mg = (int)(idx / DM);
    float acc[4] = {0.f, 0.f, 0.f, 0.f};
    for (int k = 0; k < BRA + BRB; ++k) { const float wv = p.l0_w_out[(size_t)k * DM + j];
#pragma unroll
      for (int r = 0; r < 4; ++r) acc[r] += bf2f(p.A0[(size_t)(mg * 4 + r) * LDA + k]) * wv; }
#pragma unroll
    for (int r = 0; r < 4; ++r) {
      const int m = mg * 4 + r, v = row_variant(m), b = m / TB, t = m % TB;
      const float gate = p.modv[((size_t)0 * NV + v) * 3 * DM + 2 * DM + j];
      const float h1 = row_input(p, m)[j] + gate * acc[r];
      if (t >= CTX) p.out[((size_t)b * SEQ + (t - CTX)) * DM + j] = h1;
      atomicAdd(&p.ssq1[m], h1 * h1);
      p.A1[(size_t)m * LDA + j] = f2bf(h1 * p.l1_norm[j] * (1.f + p.modv[((size_t)1 * NV + v) * 3 * DM + DM + j]));
    }
  }
}
__device__ __forceinline__ void nv_gla(const Params& p) {
  __shared__ float qs[GLA_DK], ks[GLA_DK], al[GLA_DK];
  const int j = threadIdx.x;
  for (int item = blockIdx.x; item < NB * GLA_H * 2; item += gridDim.x) {
    const int dir = item & 1, h = (item >> 1) % GLA_H, b = item / (2 * GLA_H);
    float S[GLA_DK];
#pragma unroll
    for (int d = 0; d < GLA_DK; ++d) S[d] = 0.f;
    bf16_t* Oout = dir ? p.Hb : p.Hf;
    for (int s = 0; s < TB; ++s) {
      const int t = seq_token(s, dir); const size_t m = (size_t)b * TB + t;
      if (j < GLA_DK) {
        float g = p.b_gate[dir * GLA_H * GLA_DK + h * GLA_DK + j];
        for (int r = 0; r < GRANK; ++r) g += bf2f(p.Pb[m * LDP + P1_GA + dir * GRANK + r]) * p.w_gate[((size_t)dir * GRANK + r) * GLA_H * GLA_DK + h * GLA_DK + j];
        al[j] = fast_exp(log_sigmoid_f(g) * (1.f / 16.f));
        qs[j] = bf2f(p.Pb[m * LDP + P1_GQ + h * GLA_DK + j]) * 0.125f; ks[j] = bf2f(p.Pb[m * LDP + P1_GK + h * GLA_DK + j]);
      }
      float vj = 0.f; if (j < GLA_DV) vj = bf2f(p.Pb[m * LDP + P1_GV + h * GLA_DV + j]);
      __syncthreads();
      if (j < GLA_DV) {
        float o = 0.f;
#pragma unroll
        for (int d = 0; d < GLA_DK; ++d) { S[d] = al[d] * S[d] + ks[d] * vj; o += qs[d] * S[d]; }
        if (t >= CTX) Oout[hoff(h * GLA_DV + j, (size_t)b * SEQ + (t - CTX), MLAT)] = f2bf(o);
      }
      __syncthreads();
    }
  }
}
__device__ __forceinline__ void nv_na(const Params& p) {
  for (long idx = gtid(); idx < (long)NB * NA_H * SEQ; idx += gsize()) {
    const int tl = (int)(idx % SEQ), h = (int)((idx / SEQ) % NA_H), b = (int)(idx / ((long)SEQ * NA_H));
    const int r = tl / GW, c = tl % GW; const size_t m = (size_t)b * TB + CTX + tl;
    int rs = r - NA_KH / 2; rs = rs < 0 ? 0 : (rs > GROWS - NA_KH ? GROWS - NA_KH : rs);
    int cs = c - NA_KW / 2; cs = cs < 0 ? 0 : (cs > GW - NA_KW ? GW - NA_KW : cs);
    float q[NA_D], o[NA_D];
#pragma unroll
    for (int d = 0; d < NA_D; ++d) { q[d] = bf2f(p.Pb[m * LDP + P1_NQ + h * NA_D + d]) * 0.125f; o[d] = 0.f; }
    float mx = -1e30f, l = 0.f;
    for (int key = 0; key < NA_KH * NA_KW + CTX; ++key) {
      size_t kk; float bias = 0.f;
      if (key < NA_KH * NA_KW) { const int i = key / NA_KW, jc = key % NA_KW; kk = (size_t)b * TB + CTX + (rs + i) * GW + cs + jc;
        bias = p.rpb[((size_t)h * (2 * NA_KH - 1) + (rs + i - r + NA_KH - 1)) * (2 * NA_KW - 1) + (cs + jc - c + NA_KW - 1)]; }
      else kk = (size_t)b * TB + (key - NA_KH * NA_KW);
      float s = 0.f;
#pragma unroll
      for (int d = 0; d < NA_D; ++d) s += q[d] * bf2f(p.Pb[kk * LDP + P1_NK + h * NA_D + d]);
      s += bias;
      const float mn = fmaxf(mx, s), alpha = fast_exp(mx - mn), pp = fast_exp(s - mn);
      l = l * alpha + pp; mx = mn;
#pragma unroll
      for (int d = 0; d < NA_D; ++d) o[d] = o[d] * alpha + pp * bf2f(p.Pb[kk * LDP + P1_NV + h * NA_D + d]);
    }
    const float il = 1.f / l; const size_t ml = (size_t)b * SEQ + tl;
#pragma unroll
    for (int d = 0; d < NA_D; ++d) p.A0[ml * LDA + BRC + h * NA_D + d] = f2bf(o[d] * il * silu_f(bf2f(p.Pb[m * LDP + P1_Z + BRC + h * NA_D + d])));
  }
}
__device__ __forceinline__ void nv_comb1(const Params& p) {
  for (long idx = gtid(); idx < (long)MLAT * GLA_H; idx += gsize()) {
    const int hh = (int)(idx % GLA_H); const size_t ml = (size_t)(idx / GLA_H); const size_t m = (ml / SEQ) * TB + CTX + (ml % SEQ);
    float ss = 0.f;
    for (int d = 0; d < GLA_DV; ++d) { const int c = hh * GLA_DV + d; const float g = bf2f(p.Hf[hoff(c, ml, MLAT)]) + bf2f(p.Hb[hoff(c, ml, MLAT)]); ss += g * g; }
    const float rstd = rsqrtf(ss * (1.f / GLA_DV) + EPS);
    for (int d = 0; d < GLA_DV; ++d) { const int c = hh * GLA_DV + d; const float g = bf2f(p.Hf[hoff(c, ml, MLAT)]) + bf2f(p.Hb[hoff(c, ml, MLAT)]);
      p.A0[ml * LDA + c] = f2bf(g * rstd * p.gla_norm[c] * silu_f(bf2f(p.Pb[m * LDP + P1_Z + c]))); }
  }
}
__device__ __forceinline__ void nv_out1(const Params& p) {
  for (long idx = gtid(); idx < (long)(MLAT / 4) * DM; idx += gsize()) {
    const int j = (int)(idx % DM), mg = (int)(idx / DM);
    float acc[4] = {0.f, 0.f, 0.f, 0.f};
    for (int k = 0; k < BRC + BRD; ++k) { const float wv = p.l1_w_out[(size_t)k * DM + j];
#pragma unroll
      for (int r = 0; r < 4; ++r) acc[r] += bf2f(p.A0[(size_t)(mg * 4 + r) * LDA + k]) * wv; }
#pragma unroll
    for (int r = 0; r < 4; ++r) { const size_t ml = (size_t)mg * 4 + r; const int b = (int)(ml / SEQ);
      p.out[ml * DM + j] += p.modv[((size_t)1 * NV + b) * 3 * DM + 2 * DM + j] * acc[r]; }
  }
}
__device__ __forceinline__ void nv_final(const Params& p) {
  for (long ml = gtid(); ml < MLAT; ml += gsize()) {
    float* r = p.out + (size_t)ml * DM; float ss = 0.f;
    for (int k = 0; k < DM; ++k) ss += r[k] * r[k];
    const float rstd = rsqrtf(ss * (1.f / DM) + EPS);
    for (int k = 0; k < DM; ++k) r[k] = r[k] * rstd * p.final_norm[k];
  }
}


#ifdef HOST_TEST
#define UNIFORM(x) (x)
#define WAVE_LDS_SYNC() wave_barrier()
static int g_fastmask = 0;
#define USE_FAST(k) ((g_fastmask >> (k)) & 1)
#else
#define UNIFORM(x) __builtin_amdgcn_readfirstlane(x)
#define WAVE_LDS_SYNC() asm volatile("s_waitcnt lgkmcnt(0)" ::: "memory")
#ifndef FASTMASK
#define FASTMASK 0x7FFF
#endif
#define USE_FAST(k) ((FASTMASK >> (k)) & 1)
#endif

#ifndef HOST_TEST
namespace pg8 {
#define PG8_LAS __attribute__((address_space(3)))
typedef unsigned short bf16_t;
typedef short bf16x8 __attribute__((ext_vector_type(8)));
typedef float f32x4 __attribute__((ext_vector_type(4)));
typedef unsigned u32x4 __attribute__((ext_vector_type(4)));
constexpr int BM = 256, BK = 64, HALF = 128, HTB = HALF * BK * 2  , STAGE_BYTES = 8 * HTB, NXCD = 8, WGM = 8;

__host__ __device__ __forceinline__ int lds_byte(int r, int c) { const int st = (r >> 4) * 2 + (c >> 5), rr = r & 15, cc = c & 31, ob = rr * 64 + cc * 2; return st * 1024 + (ob ^ (((ob >> 9) & 1) << 5)); }
__host__ __device__ __forceinline__ void stage_rc(int b, int& R, int& C) { const int st = b / 1024, sb = b % 1024, swz = sb ^ (((sb >> 9) & 1) << 5); R = (st >> 1) * 16 + swz / 64; C = (st & 1) * 32 + (swz % 64) / 2; }
__host__ __device__ __forceinline__ int perm32(int rho) { const int n = rho >> 4, i = rho & 15; return 8 * (i >> 2) + 4 * n + (i & 3); }

struct Unit { int pm, pn; };
struct Gemm { const bf16_t* A; const bf16_t* Bt; int M, N, K, lda, ldb; };

struct StaticOrder {
    int nM, nN, nwg, G, c;
    __host__ __device__ void init(int M, int N, int G_, int c_) { nM = M / BM; nN = N / BM; nwg = nM * nN; G = G_; c = c_; }
    __host__ __device__ bool next(int i, Unit& u) const {
        const long L = (long)i * G + c; if (L >= nwg) return false;
        int wgid = (int)L; { const int q = nwg / NXCD, r = nwg % NXCD, xcd = wgid % NXCD, off = wgid / NXCD; wgid = (xcd < r ? xcd * (q + 1) : r * (q + 1) + (xcd - r) * q) + off; }
        const int nig = WGM * nN, gid = wgid / nig, fm = gid * WGM, gsz = (nM - fm) < WGM ? (nM - fm) : WGM;
        u.pm = fm + ((wgid % nig) % gsz); u.pn = (wgid % nig) / gsz; return true;
    }
    __device__ __forceinline__ void a_ready(const Unit&) const {}
    __device__ __forceinline__ void done(const Unit&) const {}
};
__device__ __forceinline__ unsigned cvt_pk_bf16(float lo, float hi) { unsigned r; asm volatile("v_cvt_pk_bf16_f32 %0, %1, %2" : "=v"(r) : "v"(lo), "v"(hi)); return r; }
template <class Epi, class Sched, bool ALIGN_EPI = false, bool SP2 = false>
__device__ __forceinline__ void gemm_phase(PG8_LAS unsigned char* lds, const Gemm g, const Sched& S, const Epi& E) {
    const int tid = threadIdx.x, wid = __builtin_amdgcn_readfirstlane(tid >> 6), lane = tid & 63, wr = wid >> 2, wc = wid & 3, fr = lane & 15, fq = lane >> 4;
    const int K = g.K, nt = K / BK;
    unsigned voffA[2], voffB[2];
#pragma unroll
    for (int i = 0; i < 2; ++i) { int R, C; stage_rc(tid * 16 + i * 8192, R, C); const int Rb = Epi::PERM ? ((R & ~31) + perm32(R & 31)) : R;
        voffA[i] = (unsigned)(R * g.lda + C) * 2u; voffB[i] = (unsigned)(Rb * g.ldb + C) * 2u; }
    const size_t kstep = (size_t)(BK * 2);
    const size_t hstepA = (size_t)HALF * g.lda * 2, hstepB = (size_t)HALF * g.ldb * 2;
    const size_t tstepA = 2 * hstepA, tstepB = 2 * hstepB;
    const unsigned ldsw = (unsigned)wid * 1024u;
    const int aoff = lds_byte(wr * 64 + fr, fq * 8), boff = lds_byte(wc * 32 + fr, fq * 8);
#define PG8_SA(b, h) (((b) * 2 + (h)) * HTB)
#define PG8_SB(b, h) ((4 + (b) * 2 + (h)) * HTB)
#define PG8_STAGE(bufoff, gbase, voff) do { _Pragma("unroll") for (int _i = 0; _i < 2; ++_i) \
        __builtin_amdgcn_global_load_lds((const unsigned*)((const char*)(gbase) + (voff)[_i]), (PG8_LAS unsigned*)(lds + (bufoff) + ldsw + _i * 8192), 16, 0, 0); } while (0)
#define PG8_LDA(dst, b, h) do { _Pragma("unroll") for (int m = 0; m < 4; ++m) _Pragma("unroll") for (int k = 0; k < 2; ++k) dst[m][k] = *(const PG8_LAS bf16x8*)(lds + PG8_SA(b, h) + aoff + m * 2048 + k * 1024); } while (0)
#define PG8_LDB(dst, b, h) do { _Pragma("unroll") for (int n = 0; n < 2; ++n) _Pragma("unroll") for (int k = 0; k < 2; ++k) dst[n][k] = *(const PG8_LAS bf16x8*)(lds + PG8_SB(b, h) + boff + n * 2048 + k * 1024); } while (0)
#define PG8_MMA(ai, bj, At, Bt) do { __builtin_amdgcn_s_setprio(1); _Pragma("unroll") for (int m = 0; m < 4; ++m) _Pragma("unroll") for (int n = 0; n < 2; ++n) _Pragma("unroll") for (int k = 0; k < 2; ++k) \
        acc[ai][bj][m][n] = __builtin_amdgcn_mfma_f32_16x16x32_bf16(Bt[n][k], At[m][k], acc[ai][bj][m][n], 0, 0, 0); __builtin_amdgcn_s_setprio(0); } while (0)
#define PG8_WAIT_V(n) asm volatile("s_waitcnt vmcnt(" #n ")" ::: "memory")
#define PG8_WAIT_L(n) asm volatile("s_waitcnt lgkmcnt(" #n ")" ::: "memory")
#define PG8_BAR __builtin_amdgcn_s_barrier()
#define PG8_SCHED __builtin_amdgcn_sched_barrier(0)
    Unit cur, nxt; int ui = 0;
    if (!S.next(0, cur)) return;
    f32x4 acc[2][2][4][2];
#pragma unroll
    for (int a = 0; a < 2; ++a)
#pragma unroll
        for (int b = 0; b < 2; ++b)
#pragma unroll
            for (int m = 0; m < 4; ++m)
#pragma unroll
                for (int n = 0; n < 2; ++n) acc[a][b][m][n] = (f32x4){0.f, 0.f, 0.f, 0.f};
    bf16x8 At[4][2], B0[2][2], B1[2][2];
    const char* cA = (const char*)g.A + (size_t)cur.pm * tstepA; const char* cB = (const char*)g.Bt + (size_t)cur.pn * tstepB;
    S.a_ready(cur);
    if constexpr (SP2) {
        PG8_STAGE(PG8_SB(0, 0), cB, voffB); PG8_STAGE(PG8_SB(0, 1), cB + hstepB, voffB); PG8_STAGE(PG8_SA(0, 0), cA, voffA); PG8_STAGE(PG8_SA(0, 1), cA + hstepA, voffA);
        if (wr == 1) PG8_BAR;
        PG8_WAIT_V(2); PG8_BAR;
        PG8_STAGE(PG8_SB(1, 0), cB + kstep, voffB); PG8_STAGE(PG8_SA(1, 0), cA + kstep, voffA); PG8_STAGE(PG8_SB(1, 1), cB + hstepB + kstep, voffB);
        PG8_WAIT_V(6); PG8_BAR;
    } else {
        PG8_STAGE(PG8_SB(0, 0), cB, voffB); PG8_STAGE(PG8_SA(0, 0), cA, voffA); PG8_STAGE(PG8_SB(0, 1), cB + hstepB, voffB); PG8_STAGE(PG8_SA(0, 1), cA + hstepA, voffA);
        if (wr == 1) PG8_BAR;
        PG8_WAIT_V(4); PG8_BAR;
        PG8_STAGE(PG8_SB(1, 0), cB + kstep, voffB); PG8_STAGE(PG8_SA(1, 0), cA + kstep, voffA); PG8_STAGE(PG8_SB(1, 1), cB + hstepB + kstep, voffB);
        PG8_WAIT_V(6); PG8_BAR;
    }
    for (;;) {
        const bool has_next = S.next(ui + 1, nxt);
        const char* nA = has_next ? (const char*)g.A + (size_t)nxt.pm * tstepA : cA; const char* nB = has_next ? (const char*)g.Bt + (size_t)nxt.pn * tstepB : cB;
#pragma unroll 1
        for (int t = 0; t < nt; t += 2) {
            const bool last = (t == nt - 2);
            const char* a1 = cA + (size_t)(t + 1) * kstep;
            const char* a2 = last ? nA : cA + (size_t)(t + 2) * kstep; const char* b2 = last ? nB : cB + (size_t)(t + 2) * kstep;
            const char* a3 = a2 + kstep; const char* b3 = b2 + kstep;
            if (last && has_next) S.a_ready(nxt);
            if constexpr (SP2) {
            PG8_LDB(B0, 0, 0); PG8_LDB(B1, 0, 1); PG8_SCHED; PG8_LDA(At, 0, 0); PG8_STAGE(PG8_SA(1, 1), a1 + hstepA, voffA);
            PG8_WAIT_V(8); PG8_WAIT_L(0); PG8_BAR; PG8_MMA(0, 0, At, B0); PG8_MMA(0, 1, At, B1); PG8_BAR; PG8_SCHED;
            PG8_LDA(At, 0, 1); PG8_STAGE(PG8_SB(0, 0), b2, voffB); PG8_STAGE(PG8_SB(0, 1), b2 + hstepB, voffB); PG8_STAGE(PG8_SA(0, 0), a2, voffA);
            PG8_WAIT_V(8); PG8_WAIT_L(0); PG8_BAR; PG8_MMA(1, 0, At, B0); PG8_MMA(1, 1, At, B1); PG8_BAR; PG8_SCHED;
            PG8_LDB(B0, 1, 0); PG8_LDB(B1, 1, 1); PG8_SCHED; PG8_LDA(At, 1, 0); PG8_STAGE(PG8_SA(0, 1), a2 + hstepA, voffA);
            PG8_WAIT_V(8); PG8_WAIT_L(0); PG8_BAR; PG8_MMA(0, 0, At, B0); PG8_MMA(0, 1, At, B1); PG8_BAR; PG8_SCHED;
            PG8_LDA(At, 1, 1); PG8_STAGE(PG8_SB(1, 0), b3, voffB); PG8_STAGE(PG8_SB(1, 1), b3 + hstepB, voffB); PG8_STAGE(PG8_SA(1, 0), a3, voffA);
            PG8_WAIT_V(8); PG8_WAIT_L(0); PG8_BAR; PG8_MMA(1, 0, At, B0); PG8_MMA(1, 1, At, B1); PG8_BAR; PG8_SCHED;
            } else {
            PG8_LDB(B0, 0, 0); PG8_SCHED; PG8_LDA(At, 0, 0); PG8_STAGE(PG8_SA(1, 1), a1 + hstepA, voffA);
            PG8_WAIT_L(8); PG8_BAR; PG8_WAIT_L(0); PG8_MMA(0, 0, At, B0); PG8_BAR; PG8_SCHED;
            PG8_LDB(B1, 0, 1); PG8_STAGE(PG8_SB(0, 0), b2, voffB);
            PG8_BAR; PG8_WAIT_L(0); PG8_MMA(0, 1, At, B1); PG8_BAR;
            PG8_LDA(At, 0, 1); PG8_STAGE(PG8_SA(0, 0), a2, voffA);
            PG8_BAR; PG8_WAIT_L(0); PG8_MMA(1, 0, At, B0); PG8_BAR; PG8_SCHED;
            PG8_STAGE(PG8_SB(0, 1), b2 + hstepB, voffB);
            PG8_WAIT_V(6); PG8_BAR; PG8_MMA(1, 1, At, B1); PG8_BAR;
            PG8_LDB(B0, 1, 0); PG8_SCHED; PG8_LDA(At, 1, 0); PG8_STAGE(PG8_SA(0, 1), a2 + hstepA, voffA);
            PG8_WAIT_L(8); PG8_BAR; PG8_WAIT_L(0); PG8_MMA(0, 0, At, B0); PG8_BAR; PG8_SCHED;
            PG8_LDB(B1, 1, 1); PG8_STAGE(PG8_SB(1, 0), b3, voffB);
            PG8_BAR; PG8_WAIT_L(0); PG8_MMA(0, 1, At, B1); PG8_BAR;
            PG8_LDA(At, 1, 1); PG8_STAGE(PG8_SA(1, 0), a3, voffA);
            PG8_BAR; PG8_WAIT_L(0); PG8_MMA(1, 0, At, B0); PG8_BAR; PG8_SCHED;
            PG8_STAGE(PG8_SB(1, 1), b3 + hstepB, voffB);
            PG8_WAIT_V(6); PG8_BAR; PG8_MMA(1, 1, At, B1); PG8_BAR;
            }
        }
        if constexpr (ALIGN_EPI) { if (wr == 0) PG8_BAR; }
        if constexpr (!Epi::AFTER_DRAIN) { E(acc, cur, wr, wc, fr, fq); S.done(cur); }
        if (!has_next) break;
#pragma unroll
        for (int a = 0; a < 2; ++a)
#pragma unroll
            for (int b = 0; b < 2; ++b)
#pragma unroll
                for (int m = 0; m < 4; ++m)
#pragma unroll
                    for (int n = 0; n < 2; ++n) acc[a][b][m][n] = (f32x4){0.f, 0.f, 0.f, 0.f};
        cur = nxt; cA = nA; cB = nB; ++ui;
        if constexpr (ALIGN_EPI) { if (wr == 1) PG8_BAR; }
    }
    PG8_WAIT_V(0);
    if constexpr (!ALIGN_EPI) { if (wr == 0) PG8_BAR; }
    PG8_BAR;
    if constexpr (Epi::AFTER_DRAIN) { E.fused(acc, cur, wr, wc, fr, fq, lds, wid, lane); S.done(cur); }
#undef PG8_SA
#undef PG8_SB
#undef PG8_STAGE
#undef PG8_LDA
#undef PG8_LDB
#undef PG8_MMA
#undef PG8_WAIT_V
#undef PG8_WAIT_L
#undef PG8_BAR
#undef PG8_SCHED
}
}
#else
namespace pg8 {
typedef unsigned short bf16_t;
constexpr int BM = 256, BK = 64, HALF = 128, STAGE_BYTES = 131072, NXCD = 8, WGM = 8;
struct Unit { int pm, pn; };
struct Gemm { const bf16_t* A; const bf16_t* Bt; int M, N, K, lda, ldb; };
struct StaticOrder {
    int nM, nN, nwg, G, c;
    void init(int M, int N, int G_, int c_) { nM = M / BM; nN = N / BM; nwg = nM * nN; G = G_; c = c_; }
    bool next(int i, Unit& u) const {
        const long L = (long)i * G + c; if (L >= nwg) return false;
        int wgid = (int)L; { const int q = nwg / NXCD, r = nwg % NXCD, xcd = wgid % NXCD, off = wgid / NXCD; wgid = (xcd < r ? xcd * (q + 1) : r * (q + 1) + (xcd - r) * q) + off; }
        const int nig = WGM * nN, gid = wgid / nig, fm = gid * WGM, gsz = (nM - fm) < WGM ? (nM - fm) : WGM;
        u.pm = fm + ((wgid % nig) % gsz); u.pn = (wgid % nig) / gsz; return true;
    }
};
template <class Epi, class Sched, bool ALIGN_EPI = false, bool SP2 = false>
static void gemm_phase(unsigned char*, const Gemm g, const Sched& S, const Epi& E) {
    const int tid = threadIdx.x, wid = tid >> 6, lane = tid & 63, wr = wid >> 2, wc = wid & 3, fr = lane & 15, fq = lane >> 4;
    Unit cur;
    for (int ui = 0; S.next(ui, cur); ++ui) {
        f32x4 acc[2][2][4][2];
        for (int ai = 0; ai < 2; ++ai) for (int bj = 0; bj < 2; ++bj) for (int m = 0; m < 4; ++m) for (int n = 0; n < 2; ++n) for (int e = 0; e < 4; ++e) {
            const int row = cur.pm * 256 + ai * 128 + wr * 64 + m * 16 + fr;
            const int col = cur.pn * 256 + bj * 128 + wc * 32 + (Epi::PERM ? 8 * fq + 4 * n + e : 16 * n + 4 * fq + e);
            float sum = 0.f; for (int k = 0; k < g.K; ++k) sum += bf2f(g.A[(size_t)row * g.lda + k]) * bf2f(g.Bt[(size_t)col * g.ldb + k]);
            acc[ai][bj][m][n][e] = sum; }
        E(acc, cur, wr, wc, fr, fq);
    }
}
}
#define PG8_LAS
#endif
typedef float f32x4_t __attribute__((ext_vector_type(4)));
#ifdef HOST_TEST
#define CO_LOAD(p_) (*(p_))
#define CO_STORE(p_, v_) (*(p_) = (v_))
#else
#define CO_LOAD(p_) __hip_atomic_load((p_), __ATOMIC_RELAXED, __HIP_MEMORY_SCOPE_AGENT)
#define CO_STORE(p_, v_) __hip_atomic_store((p_), (v_), __ATOMIC_RELAXED, __HIP_MEMORY_SCOPE_AGENT)
#endif
#define MOD_FLAG0 3712
#ifdef HOST_TEST
#define W_LOAD(p) (*(p))
#define NT_LOAD4(p) (*(const f32x4_t*)(p))
#else
#define W_LOAD(p) __builtin_nontemporal_load(p)
#define NT_LOAD4(p) __builtin_nontemporal_load((const f32x4_t*)(p))
#endif
typedef unsigned u32x4_t __attribute__((ext_vector_type(4)));
typedef unsigned u32x2_t __attribute__((ext_vector_type(2)));
#ifdef HOST_TEST
__device__ __forceinline__ unsigned pk2bf(float lo, float hi) { return (unsigned)f2bf(lo) | ((unsigned)f2bf(hi) << 16); }
#else
__device__ __forceinline__ unsigned pk2bf(float lo, float hi) { unsigned r; asm volatile("v_cvt_pk_bf16_f32 %0, %1, %2" : "=v"(r) : "v"(lo), "v"(hi)); return r; }
#endif

template <int MODE>
__device__ __forceinline__ void fp_wt(const float* __restrict__ W, const float* __restrict__ kscale, bf16_t* __restrict__ Wt, const int K, const int NO, const int NP) {
  for (long idx = gtid(); idx < (long)NP * (K / 8); idx += gsize()) {
    const int n = (int)(idx % NP), kc = (int)(idx / NP);
    const int src = MODE == 0 ? l0_src(n) : (MODE == 1 ? l1_src(n) : (n < NO ? n : -1));
    float v[8];
#pragma unroll
    for (int i = 0; i < 8; ++i) { v[i] = src >= 0 ? W[(size_t)(kc * 8 + i) * NO + src] : 0.f; if (MODE == 2 && kscale) v[i] *= kscale[kc * 8 + i]; }
    u32x4_t o; o.x = pk2bf(v[0], v[1]); o.y = pk2bf(v[2], v[3]); o.z = pk2bf(v[4], v[5]); o.w = pk2bf(v[6], v[7]);
    *(u32x4_t*)(Wt + (size_t)n * K + kc * 8) = o;
  }
}
template <bool IN> __device__ __forceinline__ void fp_wt_pair(const float* __restrict__ Wa, const float* __restrict__ Wb, bf16_t* __restrict__ Ta, bf16_t* __restrict__ Tb, const int K, const int NOa, const int NOb, const int NP) {
  for (long idx = gtid(); idx < (long)NP * (K / 8); idx += gsize()) {
    const int n = (int)(idx % NP), kc = (int)(idx / NP);
    const int sa = IN ? l0_src(n) : (n < NOa ? n : -1), sb = IN ? l1_src(n) : (n < NOb ? n : -1);
    float va[8], vb[8];
#pragma unroll
    for (int i = 0; i < 8; ++i) va[i] = sa >= 0 ? W_LOAD(Wa + (size_t)(kc * 8 + i) * NOa + sa) : 0.f;
#pragma unroll
    for (int i = 0; i < 8; ++i) vb[i] = sb >= 0 ? W_LOAD(Wb + (size_t)(kc * 8 + i) * NOb + sb) : 0.f;
    u32x4_t o; o.x = pk2bf(va[0], va[1]); o.y = pk2bf(va[2], va[3]); o.z = pk2bf(va[4], va[5]); o.w = pk2bf(va[6], va[7]);
    *(u32x4_t*)(Ta + (size_t)n * K + kc * 8) = o;
    o.x = pk2bf(vb[0], vb[1]); o.y = pk2bf(vb[2], vb[3]); o.z = pk2bf(vb[4], vb[5]); o.w = pk2bf(vb[6], vb[7]);
    *(u32x4_t*)(Tb + (size_t)n * K + kc * 8) = o;
  }
}
__device__ __forceinline__ void fp_wt_rev(const float* __restrict__ W, const float* __restrict__ kscale, bf16_t* __restrict__ Wt, const int K, const int NO, const int NP) {
  for (long idx = (long)(gridDim.x - 1 - blockIdx.x) * blockDim.x + threadIdx.x; idx < (long)NP * (K / 8); idx += gsize()) {
    const int n = (int)(idx % NP), kc = (int)(idx / NP);
    float v[8];
#pragma unroll
    for (int i = 0; i < 8; ++i) v[i] = n < NO ? W_LOAD(W + (size_t)(kc * 8 + i) * NO + n) * kscale[kc * 8 + i] : 0.f;
    u32x4_t o; o.x = pk2bf(v[0], v[1]); o.y = pk2bf(v[2], v[3]); o.z = pk2bf(v[4], v[5]); o.w = pk2bf(v[6], v[7]);
    *(u32x4_t*)(Wt + (size_t)n * K + kc * 8) = o;
  }
}
struct WtItem { const float* W; const float* ks; bf16_t* T; int K, NO, mode, k0, n0; };
constexpr int WT_ROWB = 144;
constexpr int WT_NI_IN = (DM / 64) * (LDP / 128), WT_NI_O0 = (CW0 / 64) * (((DM + 255) / 256 * 256) / 128), WT_NI_O1 = (CW1 / 64) * (((DM + 255) / 256 * 256) / 128),
              WT_NI_Q = (QR / 64) * (((QW + 255) / 256 * 256) / 128), WT_NI_KV = (KVR / 64) * (((KVW + 255) / 256 * 256) / 128);
constexpr int WT_NITEMS = 2 * WT_NI_IN + WT_NI_O0 + WT_NI_O1 + WT_NI_Q + WT_NI_KV;
constexpr bool WT_CAN_DEFER = true;
constexpr bool WT_OK = (DM % 64 == 0) && (CW0 % 64 == 0) && (CW1 % 64 == 0) && (QR % 64 == 0) && (KVR % 64 == 0) && (LDP % 128 == 0) && (NTHREADS == 512);
constexpr int WT_N0 = WT_NI_IN + WT_NI_O0 + WT_NI_Q + WT_NI_KV, WT_N1 = WT_NI_IN + WT_NI_O1;
template <int SET> __device__ __forceinline__ WtItem wt_item(const Params& p, int it) {
  WtItem r; int nt;
  if (SET == 0) {
    if (it < WT_NI_IN) { r.W = p.l0_w_in; r.ks = nullptr; r.T = p.Wt0; r.K = DM; r.NO = N0; r.mode = 0; nt = LDP / 128; }
    else if ((it -= WT_NI_IN) < WT_NI_O0) { r.W = p.l0_w_out; r.ks = nullptr; r.T = p.Wo0; r.K = CW0; r.NO = DM; r.mode = 2; nt = ((DM + 255) / 256 * 256) / 128; }
    else if ((it -= WT_NI_O0) < WT_NI_Q) { r.W = p.w_uq; r.ks = p.q_norm; r.T = p.Wq; r.K = QR; r.NO = QW; r.mode = 2; nt = ((QW + 255) / 256 * 256) / 128; }
    else { it -= WT_NI_Q; r.W = p.w_ukv; r.ks = p.kv_norm; r.T = p.Wkv; r.K = KVR; r.NO = KVW; r.mode = 2; nt = ((KVW + 255) / 256 * 256) / 128; }
  } else {
    if (it < WT_NI_IN) { r.W = p.l1_w_in; r.ks = nullptr; r.T = p.Wt1; r.K = DM; r.NO = N1; r.mode = 1; nt = LDP / 128; }
    else { it -= WT_NI_IN; r.W = p.l1_w_out; r.ks = nullptr; r.T = p.Wo1; r.K = CW1; r.NO = DM; r.mode = 2; nt = ((DM + 255) / 256 * 256) / 128; }
  }
  r.k0 = (it / nt) * 64; r.n0 = (it % nt) * 128;
  return r;
}
__device__ __forceinline__ void wt_load(const WtItem& w, float (&v)[2][8]) {
  const int lane = threadIdx.x & 63, wv = UNIFORM((int)(threadIdx.x >> 6));
#pragma unroll
  for (int h = 0; h < 2; ++h) {
    const int n = w.n0 + h * 64 + lane;
    const int src = w.mode == 0 ? l0_src(n) : (w.mode == 1 ? l1_src(n) : (n < w.NO ? n : -1));
    const float* col = w.W + (size_t)(w.k0 + wv * 8) * w.NO + (src >= 0 ? src : 0);
#pragma unroll
    for (int i = 0; i < 8; ++i) v[h][i] = src >= 0 ? W_LOAD(col + (size_t)i * w.NO) : 0.f;
  }
}
__device__ __forceinline__ void wt_store(const WtItem& w, const float (&v)[2][8], unsigned char* lds) {
  const int tid = threadIdx.x, lane = tid & 63, wv = UNIFORM((int)(tid >> 6));
  float sc[8];
#pragma unroll
  for (int i = 0; i < 8; ++i) sc[i] = w.ks ? w.ks[w.k0 + wv * 8 + i] : 1.f;
#pragma unroll
  for (int h = 0; h < 2; ++h) {
    u32x4_t o; o.x = pk2bf(v[h][0] * sc[0], v[h][1] * sc[1]); o.y = pk2bf(v[h][2] * sc[2], v[h][3] * sc[3]); o.z = pk2bf(v[h][4] * sc[4], v[h][5] * sc[5]); o.w = pk2bf(v[h][6] * sc[6], v[h][7] * sc[7]);
    *(u32x4_t*)(lds + (h * 64 + lane) * WT_ROWB + wv * 16) = o;
  }
  __syncthreads();
#pragma unroll
  for (int ps = 0; ps < 2; ++ps) {
    const int nl = ps * 64 + (tid >> 3), ch = tid & 7;
    const u32x4_t o = *(const u32x4_t*)(lds + nl * WT_ROWB + ch * 16);
    *(u32x4_t*)(w.T + (size_t)(w.n0 + nl) * w.K + w.k0 + ch * 8) = o;
  }
  __syncthreads();
}
__device__ __forceinline__ int wt_slot(int s, const int b, const int nb, const int nmod, const int extra) {
  if (b >= nmod) { if (s < extra) return (b - nmod) * extra + s; s -= extra; }
  return (nb - nmod) * extra + s * nb + b;
}
template <int SET> __device__ __forceinline__ void fp_wt_tiles(const Params& p, unsigned char* lds, const int b, const int nb, const int nmod, const int extra) {
  constexpr int NI = SET ? WT_N1 : WT_N0;
  float va[2][8], vb[2][8];
  int s = 0, item = wt_slot(0, b, nb, nmod, extra);
  if (item < NI) wt_load(wt_item<SET>(p, item), va);
  while (item < NI) {
    const int nitem = wt_slot(s + 1, b, nb, nmod, extra);
    if (nitem < NI) wt_load(wt_item<SET>(p, nitem), vb);
    wt_store(wt_item<SET>(p, item), va, lds);
#pragma unroll
    for (int h = 0; h < 2; ++h)
#pragma unroll
      for (int i = 0; i < 8; ++i) va[h][i] = vb[h][i];
    item = nitem; ++s;
  }
}
__device__ __forceinline__ void fp_mod(const Params& p, float* ldsf) {
  float* sc = ldsf;
  float* red = ldsf + NV * DM;
  const int tid = threadIdx.x, jl = tid & 63, ks = tid >> 6;
  for (int i = tid; i < NV * DM; i += NTHREADS) sc[i] = silu_f(i < NB * DM ? p.c[i] : p.c_ctx[i - NB * DM]);
  __syncthreads();
  constexpr int NJB = 3 * DM / 64, KS = DM / 8;
  for (int item = blockIdx.x; item < 2 * NJB; item += gridDim.x) {
    const int l = item / NJB, j = (item % NJB) * 64 + jl;
    const float* w = l ? p.l1_w_mod : p.l0_w_mod; const float* bm = l ? p.l1_b_mod : p.l0_b_mod;
    float acc[NV];
#pragma unroll
    for (int v = 0; v < NV; ++v) acc[v] = 0.f;
    for (int k = ks * KS; k < (ks + 1) * KS; ++k) { const float wv = w[(size_t)k * 3 * DM + j];
#pragma unroll
      for (int v = 0; v < NV; ++v) acc[v] += sc[v * DM + k] * wv; }
#pragma unroll
    for (int v = 0; v < NV; ++v) red[(ks * NV + v) * 64 + jl] = acc[v];
    __syncthreads();
    for (int o = tid; o < NV * 64; o += NTHREADS) { const int v = o / 64, jj = o % 64; float t = bm[(item % NJB) * 64 + jj];
#pragma unroll
      for (int q = 0; q < 8; ++q) t += red[(q * NV + v) * 64 + jj];
      p.modv[((size_t)l * NV + v) * 3 * DM + (item % NJB) * 64 + jj] = t; }
    __syncthreads();
  }
}

template <int L> __device__ __forceinline__ void fp_sw_l(const Params& p, float* ldsf, const float* __restrict__ w) {
  float* sh = ldsf;
  float* red = ldsf + NV * DM;
  const int tid = threadIdx.x, jl = tid & 63, ks = tid >> 6;
  for (int i = tid; i < NV * DM; i += NTHREADS) { const int v = i / DM, k = i % DM; sh[i] = p.modv[((size_t)L * NV + v) * 3 * DM + k]; }
  __syncthreads();
  constexpr int NJB = LDP / 64, KS = DM / 8, NO = L ? N1 : N0;
  for (int item = blockIdx.x; item < NJB; item += gridDim.x) {
    const int j = item * 64 + jl;
    const int src = L ? l1_src(j) : l0_src(j);
    float acc[NV];
#pragma unroll
    for (int v = 0; v < NV; ++v) acc[v] = 0.f;
    if (src >= 0) {
#pragma unroll 8
      for (int k = ks * KS; k < (ks + 1) * KS; ++k) { const float wv = w[(size_t)k * NO + src];
#pragma unroll
        for (int v = 0; v < NV; ++v) acc[v] += sh[v * DM + k] * wv; } }
#pragma unroll
    for (int v = 0; v < NV; ++v) red[(ks * NV + v) * 64 + jl] = acc[v];
    __syncthreads();
    for (int o = tid; o < NV * 64; o += NTHREADS) { const int v = o / 64, jj = o % 64; float t = 0.f;
#pragma unroll
      for (int q = 0; q < 8; ++q) t += red[(q * NV + v) * 64 + jj];
      p.sw[((size_t)L * NV + v) * LDP + item * 64 + jj] = t; }
    __syncthreads();
  }
  __syncthreads();
}
__device__ __forceinline__ void fp_sw(const Params& p, float* ldsf) { fp_sw_l<0>(p, ldsf, p.l0_w_in); fp_sw_l<1>(p, ldsf, p.l1_w_in); }
constexpr int GV_KS = DM / 64;
constexpr bool GV_OK = (DM % 64 == 0) && (N0 % 4 == 0) && (N1 % 4 == 0) && (LDP % 32 == 0) && ((3 * DM) % 32 == 0) && (P0_MQ % 4 == 0) && (P0_Z % 4 == 0) && (P0_KR % 4 == 0) && (P0_G % 4 == 0) && (P1_NQ % 4 == 0) &&
                         (P1_Z % 4 == 0) && (P1_GA % 4 == 0) && (S0_MQ % 4 == 0) && (S0_Z % 4 == 0) && (S0_KR % 4 == 0) && (S0_G % 4 == 0) && (S1_NQ % 4 == 0) && (S1_Z % 4 == 0) && (S1_GA % 4 == 0) && (NTHREADS == 512);
__device__ __forceinline__ void gemv32_partial(const float* vec, float* red, const float* __restrict__ W, const int NO, const int src) {
  const int tid = threadIdx.x, cl = tid & 7, ks = tid >> 3;
  f32x4_t acc[NV];
#pragma unroll
  for (int v = 0; v < NV; ++v) acc[v] = f32x4_t{0.f, 0.f, 0.f, 0.f};
  if (src >= 0) {
    f32x4_t w[GV_KS];
#pragma unroll
    for (int i = 0; i < GV_KS; ++i) w[i] = *(const f32x4_t*)(W + (size_t)(ks * GV_KS + i) * NO + src);
#pragma unroll
    for (int i = 0; i < GV_KS; ++i)
#pragma unroll
      for (int v = 0; v < NV; ++v) acc[v] += w[i] * vec[v * DM + ks * GV_KS + i];
  }
#pragma unroll
  for (int v = 0; v < NV; ++v) *(f32x4_t*)(red + (ks * NV + v) * 32 + cl * 4) = acc[v];
}
__device__ __forceinline__ float gemv32_sum(const float* red, const int v, const int jj) { float t = 0.f;
#pragma unroll 8
  for (int q = 0; q < 64; ++q) t += red[(q * NV + v) * 32 + jj];
  return t; }
__device__ __forceinline__ void fp_mod2(const Params& p, float* ldsf) {
  float* sc = ldsf; float* red = ldsf + NV * DM;
  const int tid = threadIdx.x, cl = tid & 7;
  constexpr int NJB = 3 * DM / 32;
  if ((int)blockIdx.x < 2 * NJB) {
    constexpr int NL = (NV * DM + NTHREADS - 1) / NTHREADS; float cv[NL];
#pragma unroll
    for (int r = 0; r < NL; ++r) { const int i = tid + r * NTHREADS; cv[r] = i < NB * DM ? p.c[i] : (i < NV * DM ? p.c_ctx[i - NB * DM] : 0.f); }
#pragma unroll
    for (int r = 0; r < NL; ++r) { const int i = tid + r * NTHREADS; if (i < NV * DM) sc[i] = silu_f(cv[r]); }
  }
  __syncthreads();
  for (int item = blockIdx.x; item < 2 * NJB; item += gridDim.x) {
    const int l = item / NJB, j0 = (item % NJB) * 32;
    gemv32_partial(sc, red, l ? p.l1_w_mod : p.l0_w_mod, 3 * DM, j0 + 4 * cl);
    __syncthreads();
    const float* bm = l ? p.l1_b_mod : p.l0_b_mod;
    for (int o = tid; o < NV * 32; o += NTHREADS) { const int v = o / 32, jj = o % 32; CO_STORE(&p.modv[((size_t)l * NV + v) * 3 * DM + j0 + jj], bm[j0 + jj] + gemv32_sum(red, v, jj)); }
#ifndef HOST_TEST
    asm volatile("s_waitcnt vmcnt(0)" ::: "memory");
#endif
    __syncthreads();
#ifndef HOST_TEST
    if (tid == 0) __hip_atomic_store(&p.bar[MOD_FLAG0 + item], 1u, __ATOMIC_RELAXED, __HIP_MEMORY_SCOPE_AGENT);
#endif
  }
}
__device__ __forceinline__ void fp_sw2(const Params& p, float* ldsf) {
  float* sh = ldsf; float* red = ldsf + NV * DM;
  const int tid = threadIdx.x, cl = tid & 7;
  constexpr int NJB = LDP / 32;
  for (int item = blockIdx.x; item < 2 * NJB; item += gridDim.x) {
    const int l = item / NJB, j0 = (item % NJB) * 32;
    { constexpr int NL = (NV * DM + NTHREADS - 1) / NTHREADS; float cv[NL];
#pragma unroll
      for (int r = 0; r < NL; ++r) { const int i = tid + r * NTHREADS, v = i / DM, k = i % DM; cv[r] = i < NV * DM ? CO_LOAD(&p.modv[((size_t)l * NV + v) * 3 * DM + k]) : 0.f; }
#pragma unroll
      for (int r = 0; r < NL; ++r) { const int i = tid + r * NTHREADS; if (i < NV * DM) sh[i] = cv[r]; } }
    __syncthreads();
    gemv32_partial(sh, red, l ? p.l1_w_in : p.l0_w_in, l ? N1 : N0, l ? l1_src(j0 + 4 * cl) : l0_src(j0 + 4 * cl));
    __syncthreads();
    for (int o = tid; o < NV * 32; o += NTHREADS) { const int v = o / 32, jj = o % 32; p.sw[((size_t)l * NV + v) * LDP + j0 + jj] = gemv32_sum(red, v, jj); }
    __syncthreads();
  }
}
__device__ __forceinline__ void fp_zero(const Params& p) {
  for (long i = gtid(); i < (long)RPOS * 8; i += gsize()) { const int pos = (int)(i / 8), e = (int)(i % 8); float sn, cs; sincosf((float)pos * rope_inv(e), &sn, &cs); p.ropet[i] = cs; p.ropet[RPOS * 8 + i] = sn; }
  for (long i = gtid(); i < M; i += gsize()) { p.ssq_q[i] = 0.f; p.ssq_kv[i] = 0.f; p.ssq1[i] = 0.f; if (i < MLAT) p.ssq2[i] = 0.f; }
}
__device__ __forceinline__ float wave_sum(float v) {
#pragma unroll
  for (int o = 1; o < 64; o <<= 1) v += __shfl_xor(v, o);
  return v;
}
__device__ __forceinline__ void fp_prep0(const Params& p, float* scl) {
  { constexpr int NL = (NV * DM + NTHREADS - 1) / NTHREADS; float cv[NL];
#pragma unroll
    for (int r = 0; r < NL; ++r) { const int i = (int)threadIdx.x + r * NTHREADS, v = i / DM, k = i % DM; cv[r] = i < NV * DM ? CO_LOAD(&p.modv[((size_t)0 * NV + v) * 3 * DM + DM + k]) : 0.f; }
#pragma unroll
    for (int r = 0; r < NL; ++r) { const int i = (int)threadIdx.x + r * NTHREADS; if (i < NV * DM) scl[i] = cv[r]; } }
  __syncthreads();
  const int lane = threadIdx.x & 63, gw = (int)(gtid() >> 6), ngw = (int)(gsize() >> 6);
  constexpr int NQ = DM / 256;
  static_assert(DM % 256 == 0, "fp_prep0: DM must be a multiple of 256");
  f32x4_t g[NQ];
#pragma unroll
  for (int q = 0; q < NQ; ++q) g[q] = *(const f32x4_t*)(p.l0_norm + lane * 4 + q * 256);
  for (int m0 = gw; m0 < M; m0 += 4 * ngw) {
    f32x4_t xv[4][NQ];
#pragma unroll
    for (int r = 0; r < 4; ++r) { const int m = m0 + r * ngw;
      if (m < M) { const float* xr = row_input(p, m);
#pragma unroll
        for (int q = 0; q < NQ; ++q) xv[r][q] = NT_LOAD4(xr + lane * 4 + q * 256); } }
#pragma unroll
    for (int r = 0; r < 4; ++r) { const int m = m0 + r * ngw;
      if (m < M) {
        const float* sc = scl + row_variant(m) * DM;
        float ss = 0.f;
#pragma unroll
        for (int q = 0; q < NQ; ++q) { const int c = lane * 4 + q * 256; const f32x4_t x4 = xv[r][q], s1 = *(const f32x4_t*)(sc + c);
          ss += x4.x * x4.x + x4.y * x4.y + x4.z * x4.z + x4.w * x4.w;
          u32x2_t o; o.x = pk2bf(x4.x * g[q].x * (1.f + s1.x), x4.y * g[q].y * (1.f + s1.y)); o.y = pk2bf(x4.z * g[q].z * (1.f + s1.z), x4.w * g[q].w * (1.f + s1.w));
          *(u32x2_t*)(p.A0 + (size_t)m * LDA + c) = o; }
        ss = wave_sum(ss);
        if (lane == 0) p.ssq0[m] = ss; } }
  }
}
__device__ __forceinline__ void fp_gm1(const Params& p) {
  for (long idx = gtid(); idx < (long)NV * DM; idx += gsize()) { const int v = (int)(idx / DM), k = (int)(idx % DM);
    p.gm1[idx] = p.l1_norm[k] * (1.f + CO_LOAD(&p.modv[((size_t)1 * NV + v) * 3 * DM + DM + k])); }
}

__device__ __forceinline__ void rope8(const float* __restrict__ ropet, f32x4_t& v0, f32x4_t& v1, const int fq, const int tl) {
  const int pos = fq < 2 ? tl / GW : tl % GW; const bool first = (fq & 1) == 0;
  const f32x4_t c0 = *(const f32x4_t*)(ropet + pos * 8), c1 = *(const f32x4_t*)(ropet + pos * 8 + 4), s0 = *(const f32x4_t*)(ropet + RPOS * 8 + pos * 8), s1 = *(const f32x4_t*)(ropet + RPOS * 8 + pos * 8 + 4);
#pragma unroll
  for (int e = 0; e < 8; ++e) {
    const float own = e < 4 ? v0[e & 3] : v1[e & 3]; const float oth = __shfl_xor(own, 16);
    const float cs = e < 4 ? c0[e & 3] : c1[e & 3], sn = e < 4 ? s0[e & 3] : s1[e & 3];
    const float r = first ? own * cs - oth * sn : own * cs + oth * sn;
    if (e < 4) v0[e & 3] = r; else v1[e & 3] = r;
  }
}
template <int L> struct EpiIn {
  static constexpr bool PERM = true, AFTER_DRAIN = false;
  bf16_t* Pb; const float* ssq; const float* sw; float* ssq_q; float* ssq_kv; const float* ropet;
  __device__ __forceinline__ void operator()(const f32x4_t (&acc)[2][2][4][2], const pg8::Unit& u, int wr, int wc, int fr, int fq) const {
    const int r0 = u.pm * 256, tt = r0 % TB, b = r0 / TB; const bool latent = tt >= CTX; const int v = latent ? b : NB;
    const float* swv = sw + (size_t)v * LDP;
    float rstd[2][4];
#pragma unroll
    for (int ai = 0; ai < 2; ++ai)
#pragma unroll
      for (int m = 0; m < 4; ++m) rstd[ai][m] = rsqrtf(ssq[r0 + ai * 128 + wr * 64 + m * 16 + fr] * (1.f / DM) + EPS);
#pragma unroll
    for (int bj = 0; bj < 2; ++bj) {
      const int cg = u.pn * 256 + bj * 128 + wc * 32, c0 = cg + 8 * fq;
      const f32x4_t s0 = *(const f32x4_t*)(swv + c0), s1 = *(const f32x4_t*)(swv + c0 + 4);
      const bool is_rope = L == 0 && cg == P0_KR && latent;
      const int seg = L == 0 ? (cg < QR ? 1 : (cg < QR + KVR ? 2 : 0)) : 0;
#pragma unroll
      for (int ai = 0; ai < 2; ++ai)
#pragma unroll
        for (int m = 0; m < 4; ++m) {
          const int row = r0 + ai * 128 + wr * 64 + m * 16 + fr;
          f32x4_t v0 = acc[ai][bj][m][0] * rstd[ai][m] + s0, v1 = acc[ai][bj][m][1] * rstd[ai][m] + s1;
          if (seg) { float q = v0.x * v0.x + v0.y * v0.y + v0.z * v0.z + v0.w * v0.w + v1.x * v1.x + v1.y * v1.y + v1.z * v1.z + v1.w * v1.w;
            q += __shfl_xor(q, 16); q += __shfl_xor(q, 32); if (fq == 0) atomicAdd(seg == 1 ? &ssq_q[row] : &ssq_kv[row], q); }
          if (is_rope) rope8(ropet, v0, v1, fq, tt - CTX + ai * 128 + wr * 64 + m * 16 + fr);
          u32x4_t o; o.x = pk2bf(v0.x, v0.y); o.y = pk2bf(v0.z, v0.w); o.z = pk2bf(v1.x, v1.y); o.w = pk2bf(v1.z, v1.w);
          *(u32x4_t*)(Pb + (size_t)row * LDP + c0) = o;
        }
    }
  }
};
struct EpiQ {
  static constexpr bool PERM = true, AFTER_DRAIN = false;
  bf16_t* qb; const float* ssq_q; const float* ropet;
  __device__ __forceinline__ void operator()(const f32x4_t (&acc)[2][2][4][2], const pg8::Unit& u, int wr, int wc, int fr, int fq) const {
    const int r0 = u.pm * 256, tt = r0 % TB; const bool latent = tt >= CTX;
    float rsv[2][4];
#pragma unroll
    for (int ai = 0; ai < 2; ++ai)
#pragma unroll
      for (int m = 0; m < 4; ++m) rsv[ai][m] = rsqrtf(ssq_q[r0 + ai * 128 + wr * 64 + m * 16 + fr] * (1.f / QR) + EPS);
#pragma unroll
    for (int bj = 0; bj < 2; ++bj) {
      const int cg = u.pn * 256 + bj * 128 + wc * 32, c0 = cg + 8 * fq;
      const bool is_rope = latent && ((cg / 32) % 3 == 2);
#pragma unroll
      for (int ai = 0; ai < 2; ++ai)
#pragma unroll
        for (int m = 0; m < 4; ++m) {
          const int row = r0 + ai * 128 + wr * 64 + m * 16 + fr;
          const float rs = rsv[ai][m];
          f32x4_t v0 = acc[ai][bj][m][0] * rs, v1 = acc[ai][bj][m][1] * rs;
          if (is_rope) rope8(ropet, v0, v1, fq, tt - CTX + ai * 128 + wr * 64 + m * 16 + fr);
          v0 = v0 * C2Q; v1 = v1 * C2Q;
          u32x4_t o; o.x = pk2bf(v0.x, v0.y); o.y = pk2bf(v0.z, v0.w); o.z = pk2bf(v1.x, v1.y); o.w = pk2bf(v1.z, v1.w);
          if (c0 < QW) *(u32x4_t*)(qb + (size_t)row * QW + c0) = o;
        }
    }
  }
};
struct EpiKV {
  static constexpr bool PERM = true, AFTER_DRAIN = false;
  bf16_t* kn; bf16_t* vb; const float* ssq_kv;
  __device__ __forceinline__ void operator()(const f32x4_t (&acc)[2][2][4][2], const pg8::Unit& u, int wr, int wc, int fr, int fq) const {
    const int r0 = u.pm * 256;
    float rsv[2][4];
#pragma unroll
    for (int ai = 0; ai < 2; ++ai)
#pragma unroll
      for (int m = 0; m < 4; ++m) rsv[ai][m] = rsqrtf(ssq_kv[r0 + ai * 128 + wr * 64 + m * 16 + fr] * (1.f / KVR) + EPS);
#pragma unroll
    for (int bj = 0; bj < 2; ++bj) {
      const int cg = u.pn * 256 + bj * 128 + wc * 32, G = cg / 32, hh = G / 4, part = G % 4;
      bf16_t* dst = (part < 2 ? kn : vb) + hh * 64 + (part & 1) * 32 + 8 * fq;
#pragma unroll
      for (int ai = 0; ai < 2; ++ai)
#pragma unroll
        for (int m = 0; m < 4; ++m) {
          const int row = r0 + ai * 128 + wr * 64 + m * 16 + fr;
          const float rs = rsv[ai][m];
          const f32x4_t v0 = acc[ai][bj][m][0] * rs, v1 = acc[ai][bj][m][1] * rs;
          u32x4_t o; o.x = pk2bf(v0.x, v0.y); o.y = pk2bf(v0.z, v0.w); o.z = pk2bf(v1.x, v1.y); o.w = pk2bf(v1.z, v1.w);
          if (cg < KVW) *(u32x4_t*)(dst + (size_t)row * BRA) = o;
        }
    }
  }
};
#ifndef EPI_MB
#define EPI_MB 2
#endif
struct EpiOut0 {
  static constexpr bool PERM = true, AFTER_DRAIN = false;
  const float* x; const float* ctx; const float* modv; const float* gm1; float* out; bf16_t* A1; float* ssq1;
  __device__ __forceinline__ void operator()(const f32x4_t (&acc)[2][2][4][2], const pg8::Unit& u, int wr, int wc, int fr, int fq) const {
    const int r0 = u.pm * 256, tt = r0 % TB, b = r0 / TB; const bool latent = tt >= CTX; const int v = latent ? b : NB;
    const float* gate = modv + ((size_t)0 * NV + v) * 3 * DM + 2 * DM; const float* gm = gm1 + (size_t)v * DM;
    const int cb = u.pn * 256 + wc * 32 + fq * 8;
    f32x4_t gt[2][2], gv[2][2];
#pragma unroll
    for (int bj = 0; bj < 2; ++bj)
#pragma unroll
      for (int n = 0; n < 2; ++n) { gt[bj][n] = *(const f32x4_t*)(gate + cb + bj * 128 + n * 4); gv[bj][n] = *(const f32x4_t*)(gm + cb + bj * 128 + n * 4); }
    const float* xb = latent ? x + ((size_t)b * SEQ + (tt - CTX)) * DM : ctx + ((size_t)b * CTX + tt) * DM;
    float* ob = latent ? out + ((size_t)b * SEQ + (tt - CTX)) * DM : out;
#pragma unroll
    for (int ai = 0; ai < 2; ++ai)
#pragma unroll
      for (int mb = 0; mb < 4; mb += EPI_MB) {
        f32x4_t xv[EPI_MB][2][2];
#pragma unroll
        for (int mm = 0; mm < EPI_MB; ++mm)
#pragma unroll
          for (int bj = 0; bj < 2; ++bj)
#pragma unroll
            for (int n = 0; n < 2; ++n) xv[mm][bj][n] = *(const f32x4_t*)(xb + (unsigned)((ai * 128 + wr * 64 + (mb + mm) * 16 + fr) * DM + cb + bj * 128 + n * 4));
#pragma unroll
        for (int mm = 0; mm < EPI_MB; ++mm) {
          const int m = mb + mm, rl = ai * 128 + wr * 64 + m * 16 + fr, row = r0 + rl; float q = 0.f;
#pragma unroll
          for (int bj = 0; bj < 2; ++bj) {
            u32x4_t o;
#pragma unroll
            for (int n = 0; n < 2; ++n) {
              const int co = cb + bj * 128 + n * 4;
              const f32x4_t h1 = xv[mm][bj][n] + gt[bj][n] * acc[ai][bj][m][n];
              q += h1.x * h1.x + h1.y * h1.y + h1.z * h1.z + h1.w * h1.w;
              if (latent) *(f32x4_t*)(ob + (unsigned)(rl * DM + co)) = h1;
              const f32x4_t a = h1 * gv[bj][n];
              if (n == 0) { o.x = pk2bf(a.x, a.y); o.y = pk2bf(a.z, a.w); } else { o.z = pk2bf(a.x, a.y); o.w = pk2bf(a.z, a.w); }
            }
            *(u32x4_t*)(A1 + (size_t)row * LDA + cb + bj * 128) = o;
          }
          q += __shfl_xor(q, 16); q += __shfl_xor(q, 32); if (fq == 0) atomicAdd(&ssq1[row], q);
        }
      }
  }
};
struct EpiOut1 {
  static constexpr bool PERM = true, AFTER_DRAIN = false;
  const float* modv; float* out; float* ssq2;
  __device__ __forceinline__ void operator()(const f32x4_t (&acc)[2][2][4][2], const pg8::Unit& u, int wr, int wc, int fr, int fq) const {
    const int r0 = u.pm * 256, b = r0 / SEQ;
    const float* gate = modv + ((size_t)1 * NV + b) * 3 * DM + 2 * DM;
    const int cb = u.pn * 256 + wc * 32 + fq * 8;
    f32x4_t gt[2][2];
#pragma unroll
    for (int bj = 0; bj < 2; ++bj)
#pragma unroll
      for (int n = 0; n < 2; ++n) gt[bj][n] = *(const f32x4_t*)(gate + cb + bj * 128 + n * 4);
    float* ob = out + (size_t)r0 * DM;
#pragma unroll
    for (int ai = 0; ai < 2; ++ai)
#pragma unroll
      for (int mb = 0; mb < 4; mb += EPI_MB) {
        f32x4_t xv[EPI_MB][2][2];
#pragma unroll
        for (int mm = 0; mm < EPI_MB; ++mm)
#pragma unroll
          for (int bj = 0; bj < 2; ++bj)
#pragma unroll
            for (int n = 0; n < 2; ++n) xv[mm][bj][n] = *(const f32x4_t*)(ob + (unsigned)((ai * 128 + wr * 64 + (mb + mm) * 16 + fr) * DM + cb + bj * 128 + n * 4));
#pragma unroll
        for (int mm = 0; mm < EPI_MB; ++mm) {
          const int m = mb + mm, rl = ai * 128 + wr * 64 + m * 16 + fr; float q = 0.f;
#pragma unroll
          for (int bj = 0; bj < 2; ++bj)
#pragma unroll
            for (int n = 0; n < 2; ++n) {
              const f32x4_t h2 = xv[mm][bj][n] + gt[bj][n] * acc[ai][bj][m][n];
              q += h2.x * h2.x + h2.y * h2.y + h2.z * h2.z + h2.w * h2.w;
              *(f32x4_t*)(ob + (unsigned)(rl * DM + cb + bj * 128 + n * 4)) = h2;
            }
          q += __shfl_xor(q, 16); q += __shfl_xor(q, 32); if (fq == 0) atomicAdd(&ssq2[r0 + rl], q);
        }
      }
  }
};
#ifndef HOST_TEST
#define LAS __attribute__((address_space(3)))
#define XB_TMO      128
#define XB_XCNT(j)  (256  + 64 * (j))
#define XB_XSUB(j)  (1280 + 64 * (j))
#define XB_XGEN(j)  (2304 + 64 * (j))
#define XB_TOP      3328
#define XB_TOPGEN   3392
#define XCD_BAR_WORDS 3456
#define XB_SPIN_CAP (1u << 18)

__device__ __forceinline__ unsigned xb_ld(unsigned* p)              { return __hip_atomic_load(p, __ATOMIC_RELAXED, __HIP_MEMORY_SCOPE_AGENT); }
__device__ __forceinline__ unsigned xb_add(unsigned* p, unsigned v) { return __hip_atomic_fetch_add(p, v, __ATOMIC_RELAXED, __HIP_MEMORY_SCOPE_AGENT); }
__device__ __forceinline__ unsigned xb_xcc_id() { return (unsigned)__builtin_amdgcn_s_getreg((3 << 11) | 20) & 0xFu; }
#define XB_SPIN(cond, bar) do { unsigned _sp = 0; while (cond) { __builtin_amdgcn_s_sleep(1); \
    if ((++_sp & 255u) == 0u) { if (xb_ld(&(bar)[XB_TMO])) break; if (_sp > XB_SPIN_CAP) { atomicAdd(&(bar)[XB_TMO], 1u); break; } } } } while (0)

#define XB_PANEL 3584
struct EpiOut1F {
  static constexpr bool PERM = true, AFTER_DRAIN = false;
  const float* modv; float* out; float* ssq2; const float* fnorm; unsigned* bar;
  __device__ __forceinline__ void operator()(const f32x4_t (&acc)[2][2][4][2], const pg8::Unit& u, int wr, int wc, int fr, int fq) const {
    const int r0 = u.pm * 256, b = r0 / SEQ;
    const float* gate = modv + ((size_t)1 * NV + b) * 3 * DM + 2 * DM;
    const int cb = u.pn * 256 + wc * 32 + fq * 8;
    f32x4_t gt[2][2];
#pragma unroll
    for (int bj = 0; bj < 2; ++bj)
#pragma unroll
      for (int n = 0; n < 2; ++n) gt[bj][n] = *(const f32x4_t*)(gate + cb + bj * 128 + n * 4);
    float* ob = out + (size_t)r0 * DM;
    f32x4_t h[2][4][2][2];
#pragma unroll
    for (int ai = 0; ai < 2; ++ai)
#pragma unroll
      for (int mb = 0; mb < 4; mb += EPI_MB) {
        f32x4_t xv[EPI_MB][2][2];
#pragma unroll
        for (int mm = 0; mm < EPI_MB; ++mm)
#pragma unroll
          for (int bj = 0; bj < 2; ++bj)
#pragma unroll
            for (int n = 0; n < 2; ++n) xv[mm][bj][n] = *(const f32x4_t*)(ob + (unsigned)((ai * 128 + wr * 64 + (mb + mm) * 16 + fr) * DM + cb + bj * 128 + n * 4));
#pragma unroll
        for (int mm = 0; mm < EPI_MB; ++mm) {
          const int m = mb + mm, rl = ai * 128 + wr * 64 + m * 16 + fr; float q = 0.f;
#pragma unroll
          for (int bj = 0; bj < 2; ++bj)
#pragma unroll
            for (int n = 0; n < 2; ++n) {
              const f32x4_t h2 = xv[mm][bj][n] + gt[bj][n] * acc[ai][bj][m][n];
              q += h2.x * h2.x + h2.y * h2.y + h2.z * h2.z + h2.w * h2.w;
              h[ai][m][bj][n] = h2;
            }
          q += __shfl_xor(q, 16); q += __shfl_xor(q, 32); if (fq == 0) atomicAdd(&ssq2[r0 + rl], q);
        }
      }
    asm volatile("s_waitcnt vmcnt(0)" ::: "memory");
    __syncthreads();
    if (threadIdx.x == 0) {
      (void)xb_add(&bar[XB_PANEL + u.pm], 1u);
      XB_SPIN(xb_ld(&bar[XB_PANEL + u.pm]) < (unsigned)(((DM + 255) / 256 * 256) / 256), bar);
    }
    __syncthreads();
    f32x4_t gn[2][2];
#pragma unroll
    for (int bj = 0; bj < 2; ++bj)
#pragma unroll
      for (int n = 0; n < 2; ++n) gn[bj][n] = *(const f32x4_t*)(fnorm + cb + bj * 128 + n * 4);
    float sq[2][4];
#pragma unroll
    for (int ai = 0; ai < 2; ++ai)
#pragma unroll
      for (int m = 0; m < 4; ++m) sq[ai][m] = __hip_atomic_load(&ssq2[r0 + ai * 128 + wr * 64 + m * 16 + fr], __ATOMIC_RELAXED, __HIP_MEMORY_SCOPE_AGENT);
#pragma unroll
    for (int ai = 0; ai < 2; ++ai)
#pragma unroll
      for (int m = 0; m < 4; ++m) {
        const int rl = ai * 128 + wr * 64 + m * 16 + fr; const float rstd = rsqrtf(sq[ai][m] * (1.f / DM) + EPS);
#pragma unroll
        for (int bj = 0; bj < 2; ++bj)
#pragma unroll
          for (int n = 0; n < 2; ++n) *(f32x4_t*)(ob + (unsigned)(rl * DM + cb + bj * 128 + n * 4)) = h[ai][m][bj][n] * rstd * gn[bj][n];
      }
  }
};
#endif
template <class Epi> __device__ __forceinline__ void run_gemm(unsigned char* lds, const bf16_t* A, int lda, const bf16_t* Bt, int ldb, int Mr, int N, int K, const Epi& E, const int rot = 0) {
  const int G = (int)gridDim.x;
  pg8::Gemm g{A, Bt, Mr, N, K, lda, ldb}; pg8::StaticOrder S; S.init(Mr, N, G, ((int)blockIdx.x + G - rot % G) % G);
  pg8::gemm_phase<Epi, pg8::StaticOrder, true, true>((PG8_LAS unsigned char*)lds, g, S, E);
}
__device__ __forceinline__ void fp_final(const Params& p) {
  const int lane = threadIdx.x & 63, gw = (int)(gtid() >> 6), ngw = (int)(gsize() >> 6);
  for (int ml = gw; ml < MLAT; ml += ngw) {
    const float rstd = rsqrtf(p.ssq2[ml] * (1.f / DM) + EPS); float* r = p.out + (size_t)ml * DM;
    for (int c = lane * 4; c < DM; c += 256) { const f32x4_t h = *(const f32x4_t*)(r + c), g = *(const f32x4_t*)(p.final_norm + c); *(f32x4_t*)(r + c) = h * rstd * g; }
  }
}


typedef short bf16x8_t __attribute__((ext_vector_type(8)));
typedef short s16x4_t __attribute__((ext_vector_type(4)));
typedef float f32x16_t __attribute__((ext_vector_type(16)));
#ifdef HOST_TEST
#define SBAR()
#define MFMA_ASM_PAD()
#define LGKM_WAIT()
#define VM_WAIT3()
#define VM_WAIT0()
__device__ __forceinline__ unsigned cvtpk(float lo, float hi) { return pk2bf(lo, hi); }
#define MFMA32(a, b, c) shim_mfma_32x32x16(a, b, c)
#define MFMA16(a, b, c) shim_mfma_16x16x32(a, b, c)
#define TR_READ(vb, OFF) shim_tr_read((vb) + (OFF))
#define LDS_ADDR(ptr) ((int)((const unsigned char*)(ptr) - g_lds_base))
#define EXP2F(x) exp2f(x)
#define RCPF(x) (1.f / (x))
#else
#define SBAR() __builtin_amdgcn_sched_barrier(0)
#define MFMA_ASM_PAD() do { __builtin_amdgcn_sched_barrier(0); asm volatile("s_nop 15\n\ts_nop 3" ::: "memory"); __builtin_amdgcn_sched_barrier(0); } while (0)
#define LGKM_WAIT() asm volatile("s_waitcnt lgkmcnt(0)" ::: "memory")
#define VM_WAIT3() asm volatile("s_waitcnt vmcnt(3)" ::: "memory")
#define VM_WAIT0() asm volatile("s_waitcnt vmcnt(0)" ::: "memory")
__device__ __forceinline__ unsigned cvtpk(float lo, float hi) { unsigned r; asm volatile("v_cvt_pk_bf16_f32 %0, %1, %2" : "=v"(r) : "v"(lo), "v"(hi)); return r; }
#define MFMA32(a, b, c) __builtin_amdgcn_mfma_f32_32x32x16_bf16(a, b, c, 0, 0, 0)
#define MFMA16(a, b, c) __builtin_amdgcn_mfma_f32_16x16x32_bf16(a, b, c, 0, 0, 0)
template <int OFF> __device__ __forceinline__ s16x4_t tr_read_dev(int vb) { s16x4_t r; asm volatile("ds_read_b64_tr_b16 %0, %1 offset:%2" : "=&v"(r) : "v"(vb), "i"(OFF) : "memory"); return r; }
#define TR_READ(vb, OFF) tr_read_dev<OFF>(vb)
#define LDS_ADDR(ptr) ((int)(uintptr_t)(ptr))
#define EXP2F(x) __builtin_amdgcn_exp2f(x)
#define RCPF(x) __builtin_amdgcn_rcpf(x)
#endif
namespace att {
constexpr int NW = 8, QBLK = 32, KVBLK = 64;
constexpr int SHM_K = KVBLK * 256, SHM_V = KVBLK * 128 * 2;
constexpr int NBUF = 3;
constexpr int OFF_V = 0, OFF_K = NBUF * SHM_V, OFF_WS = NBUF * SHM_V + NBUF * SHM_K, LDS_ATT = OFF_WS + NW * 64 * 4;
constexpr float THR2 = 11.5f;
#define KSWZ(row, colB) ((row) * 256 + ((colB) ^ (((row) & 7) << 4)))
__device__ __forceinline__ int crow(int r, int hi) { return (r & 3) + 8 * (r >> 2) + 4 * hi; }
__device__ __forceinline__ void partialSM(f32x16_t& p0, f32x16_t& p1, float& m_reg, float& mn, float& alpha) {
  float pmax = p0[0];
#pragma unroll
  for (int r = 1; r < 16; ++r) pmax = fmaxf(pmax, p0[r]);
#pragma unroll
  for (int r = 0; r < 16; ++r) pmax = fmaxf(pmax, p1[r]);
  { auto rr = __builtin_amdgcn_permlane32_swap(__builtin_bit_cast(unsigned, pmax), __builtin_bit_cast(unsigned, pmax), false, false);
    pmax = fmaxf(__builtin_bit_cast(float, (unsigned)rr[0]), __builtin_bit_cast(float, (unsigned)rr[1])); }
  if (__all(pmax - m_reg <= THR2)) { mn = m_reg; alpha = 1.f; }
  else { mn = fmaxf(m_reg, pmax); alpha = EXP2F(m_reg - mn); m_reg = mn; }
#pragma unroll
  for (int r = 0; r < 16; ++r) { p0[r] -= mn; p1[r] -= mn; }
#pragma unroll
  for (int r = 0; r < 16; ++r) p0[r] = EXP2F(p0[r]);
}
__device__ __forceinline__ void finishSM(f32x16_t& p0, f32x16_t& p1, float alpha, float& l_reg, bf16x8_t& pa0, bf16x8_t& pa1, bf16x8_t& pa2, bf16x8_t& pa3) {
#pragma unroll
  for (int r = 0; r < 16; ++r) p1[r] = EXP2F(p1[r]);
  float ps = 0.f;
#pragma unroll
  for (int r = 0; r < 16; ++r) ps += p0[r];
#pragma unroll
  for (int r = 0; r < 16; ++r) ps += p1[r];
  { auto rr = __builtin_amdgcn_permlane32_swap(__builtin_bit_cast(unsigned, ps), __builtin_bit_cast(unsigned, ps), false, false);
    ps = __builtin_bit_cast(float, (unsigned)rr[0]) + __builtin_bit_cast(float, (unsigned)rr[1]); }
  l_reg = l_reg * alpha + ps;
#define PK4(P, BASE, OUT) do { unsigned a0 = cvtpk(P[BASE + 0], P[BASE + 1]), a1 = cvtpk(P[BASE + 2], P[BASE + 3]);   \
    unsigned b0 = cvtpk(P[BASE + 4], P[BASE + 5]), b1 = cvtpk(P[BASE + 6], P[BASE + 7]);                              \
    auto r0 = __builtin_amdgcn_permlane32_swap(a0, b0, false, false); auto r1 = __builtin_amdgcn_permlane32_swap(a1, b1, false, false); \
    u32x4_t w = {(unsigned)r0[0], (unsigned)r1[0], (unsigned)r0[1], (unsigned)r1[1]}; OUT = __builtin_bit_cast(bf16x8_t, w); } while (0)
  PK4(p0, 0, pa0); PK4(p0, 8, pa1); PK4(p1, 0, pa2); PK4(p1, 8, pa3);
#undef PK4
}
__device__ __forceinline__ void qkt(f32x16_t& p0, f32x16_t& p1, const unsigned char* Ks, const bf16x8_t* qr, int r32, int hi) {
#pragma unroll
  for (int r = 0; r < 16; ++r) { p0[r] = 0.f; p1[r] = 0.f; }
#pragma unroll
  for (int d0 = 0; d0 < 6; ++d0) { const int cb = (d0 * 16 + hi * 8) * 2;
    const bf16x8_t b0 = *reinterpret_cast<const bf16x8_t*>(Ks + KSWZ(r32, cb));
    const bf16x8_t b1 = *reinterpret_cast<const bf16x8_t*>(Ks + KSWZ(32 + r32, cb));
    p0 = MFMA32(b0, qr[d0], p0); p1 = MFMA32(b1, qr[d0], p1); }
}
__device__ __forceinline__ int v_st(int k, int c) { const int kk = (k & ~0xC) | ((k & 4) << 1) | ((k & 8) >> 1); return ((kk >> 3) * 4 + (c >> 5)) * 512 + ((kk & 7) * 32 + (c & 31)) * 2; }
__device__ __forceinline__ int v_rd_base(int lane) { return ((lane & 3) << 3) | (((lane >> 2) & 3) << 6) | (((lane >> 4) & 1) << 5) | (((lane >> 5) & 1) << 8); }
constexpr int v_rd_off(int d0, int ks, int half) { return d0 * 512 + ks * 4096 + half * 2048; }
template <int D0> __device__ __forceinline__ void pv_one(f32x16_t& od, int vb, bf16x8_t pa0, bf16x8_t pa1, bf16x8_t pa2, bf16x8_t pa3) {
  const s16x4_t l0 = TR_READ(vb, v_rd_off(D0, 0, 0)), h0 = TR_READ(vb, v_rd_off(D0, 0, 1)), l1 = TR_READ(vb, v_rd_off(D0, 1, 0)), h1 = TR_READ(vb, v_rd_off(D0, 1, 1));
  const s16x4_t l2 = TR_READ(vb, v_rd_off(D0, 2, 0)), h2 = TR_READ(vb, v_rd_off(D0, 2, 1)), l3 = TR_READ(vb, v_rd_off(D0, 3, 0)), h3 = TR_READ(vb, v_rd_off(D0, 3, 1));
  LGKM_WAIT(); SBAR();
#define PKV(L, H) (bf16x8_t){L[0], L[1], L[2], L[3], H[0], H[1], H[2], H[3]}
  od = MFMA32(pa0, PKV(l0, h0), od); od = MFMA32(pa1, PKV(l1, h1), od); od = MFMA32(pa2, PKV(l2, h2), od); od = MFMA32(pa3, PKV(l3, h3), od);
#undef PKV
}
__device__ __forceinline__ void pv_d0(f32x16_t* o, int vb, bf16x8_t pa0, bf16x8_t pa1, bf16x8_t pa2, bf16x8_t pa3) {
  pv_one<0>(o[0], vb, pa0, pa1, pa2, pa3); pv_one<1>(o[1], vb, pa0, pa1, pa2, pa3);
}
__device__ __forceinline__ void attn_unit(const bf16_t* __restrict__ Qb, const bf16_t* __restrict__ Kn, const bf16_t* __restrict__ Kr, const bf16_t* __restrict__ Vh, const int nkeys,
                                          bf16_t* __restrict__ Ob, const bf16_t* __restrict__ Zb, unsigned char* lds) {
  const int tid = threadIdx.x, wid = tid >> 6, lane = tid & 63, r32 = lane & 31, hi = lane >> 5;
  unsigned char* V_lds = lds + OFF_V; unsigned char* K_lds = lds + OFF_K;
  float* wsf = (float*)(lds + OFF_WS) + wid * 64; float* li_l = wsf; float* al_l = wsf + 32;
  float m_reg = -1e30f, l_reg = 0.f; f32x16_t o[2]; bf16x8_t qr[6];
#pragma unroll
  for (int r = 0; r < 16; ++r) { o[0][r] = 0.f; o[1][r] = 0.f; }
  { const unsigned offq = (unsigned)((wid * QBLK + r32) * QW + hi * 8);
#pragma unroll
    for (int d0 = 0; d0 < 6; ++d0) qr[d0] = *reinterpret_cast<const bf16x8_t*>(Qb + offq + d0 * 16); }
  const int vb0 = LDS_ADDR(V_lds) + v_rd_base(lane);
  bf16x8_t sA_kn, sA_kr, sA_v, sB_kn, sB_kr, sB_v;
#ifdef HOST_TEST
#define OPAQUE_TID() const int t_ = tid
#else
#define OPAQUE_TID() int t_ = tid; asm volatile("" : "+v"(t_))
#endif
#define SLOAD(S, k0) do { OPAQUE_TID(); const int srow_ = t_ >> 3, sc8_ = t_ & 7, rrow_ = (t_ & 255) >> 2, cr_ = t_ & 3; \
    const unsigned offn_ = (unsigned)(srow_ * BRA + sc8_ * 8), offr_ = (unsigned)(rrow_ * LDP + cr_ * 8); \
    const bf16_t* kn_t = Kn + (size_t)(k0) * BRA; const bf16_t* kr_t = Kr + (size_t)(k0) * LDP; const bf16_t* v_t = Vh + (size_t)(k0) * BRA; \
    S##_kn = *reinterpret_cast<const bf16x8_t*>(kn_t + offn_); S##_kr = *reinterpret_cast<const bf16x8_t*>(kr_t + offr_); S##_v = *reinterpret_cast<const bf16x8_t*>(v_t + offn_); } while (0)
#define SWRITE(b, S) do { OPAQUE_TID(); const int srow_ = t_ >> 3, sc8_ = t_ & 7, rrow_ = (t_ & 255) >> 2, cr_ = t_ & 3; \
    *reinterpret_cast<bf16x8_t*>(K_lds + (b) * SHM_K + KSWZ(srow_, sc8_ * 16)) = S##_kn; *reinterpret_cast<bf16x8_t*>(K_lds + (b) * SHM_K + KSWZ(rrow_, (8 + cr_) * 16)) = S##_kr; \
    *reinterpret_cast<bf16x8_t*>(V_lds + (b) * SHM_V + v_st(srow_, sc8_ * 8)) = S##_v; } while (0)
#define RESC(a) do { if (__any((a) < 1.f)) { if (hi == 0) al_l[r32] = (a); WAVE_LDS_SYNC(); \
    _Pragma("unroll") for (int r = 0; r < 16; ++r) { const float f = al_l[crow(r, hi)]; o[0][r] *= f; o[1][r] *= f; } WAVE_LDS_SYNC(); } } while (0)
  f32x16_t pA0, pA1, pB0, pB1; float mnA, mnB, alA, alB; bf16x8_t pa0, pa1, pa2, pa3; const int NT = nkeys / KVBLK;
  SLOAD(sA, 0); VM_WAIT0(); SWRITE(0, sA); __syncthreads();
  qkt(pA0, pA1, K_lds, qr, r32, hi); partialSM(pA0, pA1, m_reg, mnA, alA);
  SLOAD(sB, KVBLK); if (2 < NT) SLOAD(sA, 2 * KVBLK);
  VM_WAIT3(); SWRITE(1, sB); __syncthreads();
  int bc = 0, bn = 1, bw = 2;
#define ROT() do { const int t_ = bc; bc = bn; bn = bw; bw = t_; } while (0)
#pragma unroll 1
  for (int j = 1; j + 1 < NT; j += 2) {
    SBAR(); qkt(pB0, pB1, K_lds + bn * SHM_K, qr, r32, hi);
    finishSM(pA0, pA1, alA, l_reg, pa0, pa1, pa2, pa3); SBAR();
    SLOAD(sB, (j + 2) * KVBLK); SBAR();
    pv_d0(o, vb0 + bc * SHM_V, pa0, pa1, pa2, pa3); partialSM(pB0, pB1, m_reg, mnB, alB);
    VM_WAIT3(); SWRITE(bw, sA);
    RESC(alB); __syncthreads(); ROT();
    SBAR(); qkt(pA0, pA1, K_lds + bn * SHM_K, qr, r32, hi);
    finishSM(pB0, pB1, alB, l_reg, pa0, pa1, pa2, pa3); SBAR();
    if (j + 3 < NT) SLOAD(sA, (j + 3) * KVBLK); SBAR();
    pv_d0(o, vb0 + bc * SHM_V, pa0, pa1, pa2, pa3); partialSM(pA0, pA1, m_reg, mnA, alA);
    VM_WAIT3(); SWRITE(bw, sB);
    RESC(alA); __syncthreads(); ROT();
  }
  SBAR(); qkt(pB0, pB1, K_lds + bn * SHM_K, qr, r32, hi);
  finishSM(pA0, pA1, alA, l_reg, pa0, pa1, pa2, pa3); SBAR();
  pv_d0(o, vb0 + bc * SHM_V, pa0, pa1, pa2, pa3); partialSM(pB0, pB1, m_reg, mnB, alB);
  RESC(alB);
  finishSM(pB0, pB1, alB, l_reg, pa0, pa1, pa2, pa3); SBAR();
  pv_d0(o, vb0 + bn * SHM_V, pa0, pa1, pa2, pa3);
  __syncthreads();
#undef ROT
  if (hi == 0) li_l[r32] = l_reg;
  WAVE_LDS_SYNC();
  float rli[16];
#pragma unroll
  for (int r = 0; r < 16; ++r) rli[r] = RCPF(li_l[crow(r, hi)]);
  WAVE_LDS_SYNC();
#pragma unroll
  for (int r = 0; r < 16; ++r) { const unsigned orow = (unsigned)(wid * QBLK + crow(r, hi));
#pragma unroll
    for (int d0 = 0; d0 < 2; ++d0) { const unsigned col = (unsigned)(d0 * 32 + r32); const float z = bf2f(Zb[orow * LDP + col]);
      Ob[orow * LDA + col] = f2bf(o[d0][r] * rli[r] * silu_f(z)); } }
#undef SLOAD
#undef SWRITE
#undef RESC
#undef OPAQUE_TID
}
}
__device__ __forceinline__ void fp_attn(const Params& p, unsigned char* lds) {
  const int G = (int)gridDim.x, bx = (int)blockIdx.x; const int vcu = (G % 8 == 0) ? (bx % 8) * (G / 8) + bx / 8 : bx;
  constexpr int QPB = SEQ / 256, NLAT = NB * MLA_H * QPB, NCTXU = NB * MLA_H;
#pragma unroll 1
  for (int u = vcu; u < NLAT + NCTXU; u += G) {
    int b, h, t0, nkeys;
    if (u < NLAT) { const int bh = u / QPB, qblk = u % QPB; b = bh / MLA_H; h = bh % MLA_H; t0 = CTX + qblk * 256; nkeys = TB; }
    else { const int bh = u - NLAT; b = bh / MLA_H; h = bh % MLA_H; t0 = 0; nkeys = CTX; }
    const size_t m0 = (size_t)b * TB + t0, k0 = (size_t)b * TB;
    att::attn_unit(p.qb + m0 * QW + h * QD, p.kn + k0 * BRA + h * NOPE, p.Pb + k0 * LDP + P0_KR, p.vb + k0 * BRA + h * VD, nkeys,
                   p.A0 + m0 * LDA + h * VD, p.Pb + m0 * LDP + P0_Z + h * VD, lds);
  }
}


namespace scan {
constexpr int VT_LD = 72;
constexpr int NSEG = 8;
struct WaveLds { bf16_t vt[32 * VT_LD]; float Tg[64], Te1[64], Te2[64], Tw2[64], Tden[64], Tinv[64]; int Trow[64]; float Tn[128]; };
static_assert(sizeof(WaveLds) % 16 == 0, "per-wave LDS block alignment");
constexpr int ST_STRIDE = 4096 + 128 + 8;
#ifdef HOST_TEST
__device__ __forceinline__ float wave_psum(float v, int lane) {
#pragma unroll
  for (int d = 1; d < 64; d <<= 1) { const float o = __shfl_up(v, d); if (lane >= d) v += o; }
  return v;
}
__device__ __forceinline__ float wave_pmax(float v, int lane) {
#pragma unroll
  for (int d = 1; d < 64; d <<= 1) { const float o = __shfl_up(v, d); if (lane >= d) v = fmaxf(v, o); }
  return v;
}
#else
#define WDPP(v_, ident_, ctrl_, rmask_) __builtin_bit_cast(float, __builtin_amdgcn_update_dpp(__builtin_bit_cast(int, (float)(ident_)), __builtin_bit_cast(int, (v_)), (ctrl_), (rmask_), 0xF, false))
__device__ __forceinline__ float wave_psum(float v, int) {
  v += WDPP(v, 0.f, 0x111, 0xF); v += WDPP(v, 0.f, 0x112, 0xF); v += WDPP(v, 0.f, 0x114, 0xF); v += WDPP(v, 0.f, 0x118, 0xF);
  v += WDPP(v, 0.f, 0x142, 0xA); v += WDPP(v, 0.f, 0x143, 0xC);
  return v;
}
__device__ __forceinline__ float wave_pmax(float v, int) {
  constexpr float NI = -3.0e38f;
  v = fmaxf(v, WDPP(v, NI, 0x111, 0xF)); v = fmaxf(v, WDPP(v, NI, 0x112, 0xF)); v = fmaxf(v, WDPP(v, NI, 0x114, 0xF)); v = fmaxf(v, WDPP(v, NI, 0x118, 0xF));
  v = fmaxf(v, WDPP(v, NI, 0x142, 0xA)); v = fmaxf(v, WDPP(v, NI, 0x143, 0xC));
  return v;
}
#endif
#ifdef HOST_TEST
#define LANE63(x_) __shfl((x_), 63)
#else
#define LANE63(x_) __builtin_bit_cast(float, __builtin_amdgcn_readlane(__builtin_bit_cast(int, (x_)), 63))
#endif
__device__ __forceinline__ int crow(int r, int hi) { return (r & 3) + 8 * (r >> 2) + 4 * hi; }
__device__ __forceinline__ bf16x8_t acc_frag(const f32x16_t& x, int s) {
  u32x4_t w = {cvtpk(x[8 * s + 0], x[8 * s + 1]), cvtpk(x[8 * s + 2], x[8 * s + 3]), cvtpk(x[8 * s + 4], x[8 * s + 5]), cvtpk(x[8 * s + 6], x[8 * s + 7])};
  return __builtin_bit_cast(bf16x8_t, w);
}
__device__ __forceinline__ bf16x8_t pk4_frag(const f32x16_t& P, int base) {
  const unsigned a0 = cvtpk(P[base + 0], P[base + 1]), a1 = cvtpk(P[base + 2], P[base + 3]), b0 = cvtpk(P[base + 4], P[base + 5]), b1 = cvtpk(P[base + 6], P[base + 7]);
  auto r0 = __builtin_amdgcn_permlane32_swap(a0, b0, false, false); auto r1 = __builtin_amdgcn_permlane32_swap(a1, b1, false, false);
  u32x4_t w = {(unsigned)r0[0], (unsigned)r1[0], (unsigned)r0[1], (unsigned)r1[1]}; return __builtin_bit_cast(bf16x8_t, w);
}
typedef short s16x4v __attribute__((ext_vector_type(4)));
__device__ __forceinline__ bf16x8_t ld_nat(const bf16_t* p) { return *reinterpret_cast<const bf16x8_t*>(p); }
__device__ __forceinline__ bf16x8_t ld_perm(const bf16_t* p, int hi) {
  const s16x4v a = *reinterpret_cast<const s16x4v*>(p + 4 * hi), b = *reinterpret_cast<const s16x4v*>(p + 8 + 4 * hi);
  return (bf16x8_t){a[0], a[1], a[2], a[3], b[0], b[1], b[2], b[3]};
}
__device__ __forceinline__ void seg_range(int seg, int& c0, int& nc) { constexpr int nch = TB / 64, base = nch / NSEG, rem = nch % NSEG; c0 = seg * base + (seg < rem ? seg : rem); nc = base + (seg < rem ? 1 : 0); }

template <bool FULL>
__device__ __forceinline__ void mlstm_chunk(const Params& p, WaveLds& L, const int b, const int h, const int dir, const int vs, const int pc,
                                            f32x16_t (&C)[4], float (&nk)[4], float& m, float& bsum, const int lane) {
  const int r32 = lane & 31, hi = lane >> 5;
  const int mrow_l = b * TB + seq_token(pc * 64 + lane, dir);
  const int mr[2] = {b * TB + seq_token(pc * 64 + r32, dir), b * TB + seq_token(pc * 64 + 32 + r32, dir)};
  const bf16_t* Kb[2] = {p.mkc + (size_t)mr[0] * BRB + h * ML_D, p.mkc + (size_t)mr[1] * BRB + h * ML_D};
  const bf16_t* Qb[2] = {p.mqc + (size_t)mr[0] * BRB + h * ML_D, p.mqc + (size_t)mr[1] * BRB + h * ML_D};
  const bf16_t* pg = p.Pb + (size_t)mrow_l * LDP + P0_G + dir * 2 * ML_H + h;
  const float ig = bf2f(pg[0]) + p.b_i[dir * ML_H + h];
  const float lf = log_sigmoid_f(bf2f(pg[ML_H]) + p.b_f[dir * ML_H + h]);
  const float bc = wave_psum(lf, lane), g = ig - bc, pm = wave_pmax(g, lane);
  const float pm63 = LANE63(pm), blast = LANE63(bc), mm63 = fmaxf(m, pm63);
  { const bf16_t* vr = p.Pb + (size_t)mrow_l * LDP + P0_MV + h * ML_D + vs * 32;
#pragma unroll
    for (int c = 0; c < 4; ++c) { const bf16x8_t v8 = ld_nat(vr + c * 8);
#pragma unroll
      for (int e = 0; e < 8; ++e) L.vt[(c * 8 + e) * VT_LD + lane] = (bf16_t)v8[e]; } }
  L.Tw2[lane] = fast_exp(g - mm63);
  MFMA_ASM_PAD();
  float qn = 0.f, expmt = 0.f;
  if (FULL) {
    const float mm = fmaxf(m, pm);
    L.Tg[lane] = g; L.Te1[lane] = fast_exp(pm - mm); L.Te2[lane] = fast_exp(m - mm); L.Trow[lane] = mrow_l; expmt = fast_exp(-(bc + mm));
    const bf16_t* qrow = p.mqc + (size_t)mrow_l * BRB + h * ML_D;
#pragma unroll 4
    for (int c = 0; c < 16; ++c) { const bf16x8_t q8 = ld_nat(qrow + c * 8);
#pragma unroll
      for (int e = 0; e < 8; ++e) qn += bf2f((bf16_t)q8[e]) * L.Tn[c * 8 + e]; }
  }
  WAVE_LDS_SYNC();
  if (FULL) {
    f32x16_t O[2], Y[2];
#pragma unroll
    for (int tblk = 0; tblk < 2; ++tblk) {
#pragma unroll
      for (int r = 0; r < 16; ++r) { O[tblk][r] = 0.f; Y[tblk][r] = 0.f; }
      const int t = r32 + 32 * tblk; const float pm_t = __shfl(pm, t); float denl = 0.f;
#pragma unroll
      for (int sblk = 0; sblk <= tblk; ++sblk) {
        f32x16_t S;
#pragma unroll
        for (int r = 0; r < 16; ++r) S[r] = 0.f;
#pragma unroll
        for (int st = 0; st < 8; ++st) S = MFMA32(ld_nat(Kb[sblk] + 16 * st + 8 * hi), ld_nat(Qb[tblk] + 16 * st + 8 * hi), S);
#pragma unroll
        for (int r = 0; r < 16; ++r) { const int sidx = crow(r, hi) + 32 * sblk; const float w = fast_exp(L.Tg[sidx] - pm_t); const float pr = (sidx <= t) ? S[r] * w : 0.f; S[r] = pr; denl += pr; }
        const bf16x8_t pa0 = pk4_frag(S, 0), pa1 = pk4_frag(S, 8);
        O[tblk] = MFMA32(pa0, ld_nat(L.vt + r32 * VT_LD + 32 * sblk + 8 * hi), O[tblk]);
        O[tblk] = MFMA32(pa1, ld_nat(L.vt + r32 * VT_LD + 32 * sblk + 16 + 8 * hi), O[tblk]);
      }
      denl += __shfl_xor(denl, 32);
      if (hi == 0) L.Tden[t] = denl;
#pragma unroll
      for (int kblk = 0; kblk < 4; ++kblk)
#pragma unroll
        for (int s2 = 0; s2 < 2; ++s2) Y[tblk] = MFMA32(ld_perm(Qb[tblk] + 32 * kblk + 16 * s2, hi), acc_frag(C[kblk], s2), Y[tblk]);
    }
    WAVE_LDS_SYNC();
    { const float den = L.Te1[lane] * L.Tden[lane] + L.Te2[lane] * qn; L.Tinv[lane] = 1.f / fmaxf(fabsf(den), expmt); }
    WAVE_LDS_SYNC();
    bf16_t* Hout = (dir ? p.Hb : p.Hf) + (size_t)(h * 4 + vs) * M * 32 + r32;
#pragma unroll
    for (int tblk = 0; tblk < 2; ++tblk)
#pragma unroll
      for (int r = 0; r < 16; ++r) { const int t = crow(r, hi) + 32 * tblk;
        Hout[(size_t)L.Trow[t] * 32] = f2bf((L.Te1[t] * O[tblk][r] + L.Te2[t] * Y[tblk][r]) * L.Tinv[t]); }
  }
  const float a = fast_exp(m - mm63);
  bf16x8_t I0, I1;
#pragma unroll
  for (int j = 0; j < 8; ++j) { I0[j] = (r32 == 8 * hi + j) ? (short)0x3F80 : (short)0; I1[j] = (r32 == 16 + 8 * hi + j) ? (short)0x3F80 : (short)0; }
#pragma unroll
  for (int kblk = 0; kblk < 4; ++kblk) {
#pragma unroll
    for (int r = 0; r < 16; ++r) C[kblk][r] *= a;
    float nsum = 0.f;
#pragma unroll
    for (int sblk = 0; sblk < 2; ++sblk) {
      f32x16_t X;
#pragma unroll
      for (int r = 0; r < 16; ++r) X[r] = 0.f;
      X = MFMA32(ld_nat(Kb[sblk] + 32 * kblk + 8 * hi), I0, X);
      X = MFMA32(ld_nat(Kb[sblk] + 32 * kblk + 16 + 8 * hi), I1, X);
#pragma unroll
      for (int r = 0; r < 16; ++r) { X[r] *= L.Tw2[crow(r, hi) + 32 * sblk]; nsum += X[r]; }
      C[kblk] = MFMA32(acc_frag(X, 0), ld_perm(L.vt + r32 * VT_LD + 32 * sblk, hi), C[kblk]);
      C[kblk] = MFMA32(acc_frag(X, 1), ld_perm(L.vt + r32 * VT_LD + 32 * sblk + 16, hi), C[kblk]);
    }
    nsum += __shfl_xor(nsum, 32);
    nk[kblk] = a * nk[kblk] + nsum;
  }
  m = blast + mm63; bsum += blast;
  WAVE_LDS_SYNC();
  if (FULL && hi == 0) {
#pragma unroll
    for (int kblk = 0; kblk < 4; ++kblk) L.Tn[kblk * 32 + r32] = nk[kblk];
  }
  WAVE_LDS_SYNC();
}
template <int PASS> __device__ __forceinline__ void mlstm_pass(const Params& p, unsigned char* lds) {
  const int lane = threadIdx.x & 63, wid = UNIFORM((int)(threadIdx.x >> 6)), r32 = lane & 31, hi = lane >> 5;
  WaveLds& L = *reinterpret_cast<WaveLds*>(lds + (size_t)wid * sizeof(WaveLds));
  const int nwaves = (int)gridDim.x * (NTHREADS / 64);
#pragma unroll 1
  for (int item = (int)blockIdx.x * (NTHREADS / 64) + wid; item < NB * ML_H * 2 * 4 * NSEG; item += nwaves) {
    const int seg = item % NSEG, vs = (item / NSEG) % 4, dir = (item / (NSEG * 4)) % 2, h = (item / (NSEG * 8)) % ML_H, b = item / (NSEG * 8 * ML_H);
    if (PASS == 1 && seg == NSEG - 1) continue;
    int c0, nc; seg_range(seg, c0, nc);
    f32x16_t C[4]; float nk[4] = {0.f, 0.f, 0.f, 0.f}; float m = (PASS == 1) ? -1e30f : 0.f, bsum = 0.f;
#pragma unroll
    for (int k = 0; k < 4; ++k)
#pragma unroll
      for (int r = 0; r < 16; ++r) C[k][r] = 0.f;
    float* stbase = p.scanst + (size_t)(item / NSEG) * (NSEG - 1) * ST_STRIDE;
    if (PASS == 2) {
#pragma unroll 1
      for (int j = 0; j < seg; ++j) {
        const float* st = stbase + (size_t)j * ST_STRIDE;
        const float m2 = st[4096 + 128], B2 = st[4096 + 129];
        const float mn = fmaxf(B2 + m, m2), fa = fast_exp(B2 + m - mn), fb = fast_exp(m2 - mn);
#pragma unroll
        for (int k = 0; k < 4; ++k) {
#pragma unroll
          for (int r = 0; r < 16; ++r) C[k][r] = fa * C[k][r] + fb * st[(k * 16 + r) * 64 + lane];
          nk[k] = fa * nk[k] + fb * st[4096 + k * 32 + r32]; }
        m = mn;
      }
      if (hi == 0) {
#pragma unroll
        for (int k = 0; k < 4; ++k) L.Tn[k * 32 + r32] = nk[k]; }
      WAVE_LDS_SYNC();
    }
#pragma unroll 1
    for (int ci = 0; ci < nc; ++ci) mlstm_chunk<PASS == 2>(p, L, b, h, dir, vs, c0 + ci, C, nk, m, bsum, lane);
    if (PASS == 1) {
      float* st = stbase + (size_t)seg * ST_STRIDE;
#pragma unroll
      for (int k = 0; k < 4; ++k) {
#pragma unroll
        for (int r = 0; r < 16; ++r) st[(k * 16 + r) * 64 + lane] = C[k][r];
        if (hi == 0) st[4096 + k * 32 + r32] = nk[k]; }
      if (lane == 0) { st[4096 + 128] = m; st[4096 + 129] = bsum; }
    }
  }
}
}


namespace scan {
constexpr int OFF_TILES = 8 * (int)sizeof(WaveLds);
struct Pre { bf16x8_t tq[4], tk[4], v[4]; float g0, g1; };
constexpr int MQ_LD = ML_D + 8;
constexpr int M_TILE = 64 * MQ_LD;
template <bool LIGHT>
__device__ __forceinline__ void mlstm_prefetch(const Params& p, Pre& R, const int b, const int h, const int dir, const int vs, const int pc, const int gt, const int lane) {
  const int tlo = dir ? seq_token(pc * 64 + 63, dir) : seq_token(pc * 64, dir);
  const size_t m0 = (size_t)b * TB + tlo;
  const bf16_t* qb = p.mqc + m0 * BRB + h * ML_D; const bf16_t* kb = p.mkc + m0 * BRB + h * ML_D;
#pragma unroll
  for (int i = 0; i < 4; ++i) { const int j = gt + 256 * i, row = j >> 4; const unsigned off = (unsigned)((dir ? 63 - row : row) * BRB + (j & 15) * 8); if (!LIGHT) R.tq[i] = ld_nat(qb + off); R.tk[i] = ld_nat(kb + off); }
  if (LIGHT) {
    const unsigned voff = (unsigned)((dir ? 63 - lane : lane) * LDP);
    const bf16_t* vr = p.Pb + m0 * LDP + P0_MV + h * ML_D + vs * 32 + voff;
#pragma unroll
    for (int c = 0; c < 4; ++c) R.v[c] = ld_nat(vr + c * 8);
    const bf16_t* pg = p.Pb + m0 * LDP + P0_G + dir * 2 * ML_H + h + voff;
    R.g0 = bf2f(pg[0]); R.g1 = bf2f(pg[ML_H]);
  }
}
template <bool LIGHT>
__device__ __forceinline__ void mlstm_tiles_to_lds(const Pre& R, bf16_t* Qt, bf16_t* Kt, const int gt) {
#pragma unroll
  for (int i = 0; i < 4; ++i) { const int j = gt + 256 * i, row = j >> 4, c16 = j & 15;
    if (!LIGHT) *reinterpret_cast<bf16x8_t*>(Qt + row * MQ_LD + c16 * 8) = R.tq[i]; *reinterpret_cast<bf16x8_t*>(Kt + row * MQ_LD + c16 * 8) = R.tk[i]; }
}
template <bool FULL>
__device__ __forceinline__ void mlstm_chunk2(const Params& p, WaveLds& L, const bf16_t* Qt, const bf16_t* Kt, Pre& R, const int b, const int h, const int dir, const int vs, const int pc, const int pc_next,
                                             f32x16_t (&C)[4], float (&nk)[4], float& m, float& bsum, const int gt_in, const int lane_in) {
  int lane = lane_in, gt = gt_in;
#ifndef HOST_TEST
  asm volatile("" : "+v"(lane), "+v"(gt));
#endif
  const int r32 = lane & 31, hi = lane >> 5;
  const int mrow_l = b * TB + seq_token(pc * 64 + lane, dir);
  const bf16_t* prow = p.Pb + (size_t)mrow_l * LDP;
  const float ig = (FULL ? bf2f(prow[P0_G + dir * 2 * ML_H + h]) : R.g0) + p.b_i[dir * ML_H + h];
  const float lf = log_sigmoid_f((FULL ? bf2f(prow[P0_G + dir * 2 * ML_H + ML_H + h]) : R.g1) + p.b_f[dir * ML_H + h]);
  { const bf16_t* vr = prow + P0_MV + h * ML_D + vs * 32;
#pragma unroll
    for (int c = 0; c < 4; ++c) { const bf16x8_t v8 = FULL ? ld_nat(vr + c * 8) : R.v[c];
#pragma unroll
      for (int e = 0; e < 8; ++e) L.vt[(c * 8 + e) * VT_LD + lane] = (bf16_t)v8[e]; } }
  if (!FULL && pc_next >= 0) mlstm_prefetch<true>(p, R, b, h, dir, vs, pc_next, gt, lane);
  const float bc = wave_psum(lf, lane), g = ig - bc, pm = wave_pmax(g, lane);
  const float pm63 = LANE63(pm), blast = LANE63(bc), mm63 = fmaxf(m, pm63);
  L.Tw2[lane] = fast_exp(g - mm63);
  MFMA_ASM_PAD();
  float qn = 0.f, expmt = 0.f;
  if (FULL) {
    const float mm = fmaxf(m, pm);
    L.Tg[lane] = g; L.Te2[lane] = fast_exp(m - mm); L.Trow[lane] = mrow_l; expmt = fast_exp(-(bc + mm));
    const bf16_t* qrow = Qt + lane * MQ_LD;
#pragma unroll 4
    for (int c = 0; c < 16; ++c) { const bf16x8_t q8 = ld_nat(qrow + c * 8);
#pragma unroll
      for (int e = 0; e < 8; ++e) qn += bf2f((bf16_t)q8[e]) * L.Tn[c * 8 + e]; }
  }
  WAVE_LDS_SYNC();
  if (FULL) {
    bf16_t* Hout = (dir ? p.Hb : p.Hf) + (size_t)(h * 4 + vs) * M * 32 + r32;
    const float mm_l = fmaxf(m, pm);
#pragma unroll
    for (int tblk = 0; tblk < 2; ++tblk) {
      asm volatile("" ::: "memory");
      f32x16_t A;
#pragma unroll
      for (int r = 0; r < 16; ++r) A[r] = 0.f;
      const int t = r32 + 32 * tblk; const float mm_t = __shfl(mm_l, t); float denl = 0.f;
      const bf16_t* Qb = Qt + (32 * tblk + r32) * MQ_LD;
#pragma unroll
      for (int kblk = 0; kblk < 4; ++kblk)
#pragma unroll
        for (int s2 = 0; s2 < 2; ++s2) A = MFMA32(ld_perm(Qb + 32 * kblk + 16 * s2, hi), acc_frag(C[kblk], s2), A);
#pragma unroll
      for (int r = 0; r < 16; ++r) A[r] *= L.Te2[crow(r, hi) + 32 * tblk];
#pragma unroll
      for (int sblk = 0; sblk <= tblk; ++sblk) {
        asm volatile("" ::: "memory");
        const bf16_t* Kb = Kt + (32 * sblk + r32) * MQ_LD;
        f32x16_t S;
#pragma unroll
        for (int r = 0; r < 16; ++r) S[r] = 0.f;
#pragma unroll
        for (int st = 0; st < 8; ++st) S = MFMA32(ld_nat(Kb + 16 * st + 8 * hi), ld_nat(Qb + 16 * st + 8 * hi), S);
#pragma unroll
        for (int r = 0; r < 16; ++r) { const int sidx = crow(r, hi) + 32 * sblk; const float w = fast_exp(L.Tg[sidx] - mm_t); const float pr = (sidx <= t) ? S[r] * w : 0.f; S[r] = pr; denl += pr; }
        const bf16x8_t pa0 = pk4_frag(S, 0), pa1 = pk4_frag(S, 8);
        A = MFMA32(pa0, ld_nat(L.vt + r32 * VT_LD + 32 * sblk + 8 * hi), A);
        A = MFMA32(pa1, ld_nat(L.vt + r32 * VT_LD + 32 * sblk + 16 + 8 * hi), A);
      }
      denl += __shfl_xor(denl, 32);
      if (hi == 0) L.Tden[t] = denl;
      WAVE_LDS_SYNC();
      if ((lane >> 5) == tblk) { const float den = L.Tden[lane] + L.Te2[lane] * qn; L.Tinv[lane] = 1.f / fmaxf(fabsf(den), expmt); }
      WAVE_LDS_SYNC();
#pragma unroll
      for (int r = 0; r < 16; ++r) { const int tt = crow(r, hi) + 32 * tblk; Hout[(size_t)L.Trow[tt] * 32] = f2bf(A[r] * L.Tinv[tt]); }
    }
  }
  asm volatile("" ::: "memory");
  if (FULL && pc_next >= 0) mlstm_prefetch<false>(p, R, b, h, dir, vs, pc_next, gt, lane);
  const float a = fast_exp(m - mm63);
  bf16x8_t I0, I1;
#pragma unroll
  for (int j = 0; j < 8; ++j) { I0[j] = (r32 == 8 * hi + j) ? (short)0x3F80 : (short)0; I1[j] = (r32 == 16 + 8 * hi + j) ? (short)0x3F80 : (short)0; }
#pragma unroll
  for (int kblk = 0; kblk < 4; ++kblk) {
    asm volatile("" ::: "memory");
#pragma unroll
    for (int r = 0; r < 16; ++r) C[kblk][r] *= a;
    float nsum = 0.f;
#pragma unroll
    for (int sblk = 0; sblk < 2; ++sblk) {
      const bf16_t* Kb = Kt + (32 * sblk + r32) * MQ_LD;
      f32x16_t X;
#pragma unroll
      for (int r = 0; r < 16; ++r) X[r] = 0.f;
      X = MFMA32(ld_nat(Kb + 32 * kblk + 8 * hi), I0, X);
      X = MFMA32(ld_nat(Kb + 32 * kblk + 16 + 8 * hi), I1, X);
#pragma unroll
      for (int r = 0; r < 16; ++r) { X[r] *= L.Tw2[crow(r, hi) + 32 * sblk]; nsum += X[r]; }
      C[kblk] = MFMA32(acc_frag(X, 0), ld_perm(L.vt + r32 * VT_LD + 32 * sblk, hi), C[kblk]);
      C[kblk] = MFMA32(acc_frag(X, 1), ld_perm(L.vt + r32 * VT_LD + 32 * sblk + 16, hi), C[kblk]);
    }
    nsum += __shfl_xor(nsum, 32);
    nk[kblk] = a * nk[kblk] + nsum;
  }
  m = blast + mm63; bsum += blast;
  WAVE_LDS_SYNC();
  if (FULL && hi == 0) {
#pragma unroll
    for (int kblk = 0; kblk < 4; ++kblk) L.Tn[kblk * 32 + r32] = nk[kblk];
  }
  WAVE_LDS_SYNC();
}
#ifndef HOST_TEST
#define ML_MERGE (USE_FAST(13) && USE_FAST(4))
#define ML_FLAG_WORD0 4096
#define ST_STORE(p_, v_) __hip_atomic_store((p_), (v_), __ATOMIC_RELAXED, __HIP_MEMORY_SCOPE_AGENT)
#define ST_LOAD(p_) __hip_atomic_load((p_), __ATOMIC_RELAXED, __HIP_MEMORY_SCOPE_AGENT)
__device__ __forceinline__ void seg_publish(unsigned* bar, const int f) {
  asm volatile("s_waitcnt vmcnt(0)" ::: "memory");
  if ((threadIdx.x & 63) == 0) __hip_atomic_store(&bar[ML_FLAG_WORD0 + UNIFORM(f)], 1u, __ATOMIC_RELAXED, __HIP_MEMORY_SCOPE_AGENT);
}
__device__ __forceinline__ void seg_acquire(unsigned* bar, const int f0, const int n) {
  unsigned* fl = bar + ML_FLAG_WORD0 + UNIFORM(f0);
  for (int j = 0; j < n; ++j) { int sp = 0;
    while (UNIFORM((int)xb_ld(fl + j)) == 0) { __builtin_amdgcn_s_sleep(1); if (++sp > (1 << 20)) break; } }
  asm volatile("s_waitcnt vmcnt(0)" ::: "memory");
}
#else
#define ML_MERGE false
#define ST_STORE(p_, v_) (*(p_) = (v_))
#define ST_LOAD(p_) (*(p_))
#endif
template <int PASS> __device__ __forceinline__ void mlstm_block(const Params& p, unsigned char* lds) {
  const int tid = threadIdx.x, lane = tid & 63, wid = UNIFORM(tid >> 6), r32 = lane & 31, hi = lane >> 5, grp = wid >> 2, vs = wid & 3, gt = tid & 255;
  WaveLds& L = *reinterpret_cast<WaveLds*>(lds + (size_t)wid * sizeof(WaveLds));
  bf16_t* Qt = reinterpret_cast<bf16_t*>(lds + OFF_TILES) + (size_t)grp * 2 * M_TILE; bf16_t* Kt = Qt + M_TILE;
  constexpr int NIT = NB * ML_H * 2 * NSEG;
#pragma unroll 1
  for (int pidx = (int)blockIdx.x; pidx < NIT / 2; pidx += (int)gridDim.x) {
    const int it = 2 * pidx + grp, seg = it % NSEG, dir = (it / NSEG) % 2, h = (it / (NSEG * 2)) % ML_H, b = it / (NSEG * 2 * ML_H);
    int c0, nc, c0b, ncb; seg_range(seg, c0, nc); seg_range((2 * pidx + (grp ^ 1)) % NSEG, c0b, ncb);
    if (PASS == 1 && seg == NSEG - 1) nc = 0;
    if (PASS == 1 && (2 * pidx + (grp ^ 1)) % NSEG == NSEG - 1) ncb = 0;
    const int ncmax = nc > ncb ? nc : ncb;
    f32x16_t C[4]; float nk[4] = {0.f, 0.f, 0.f, 0.f}; float m = (PASS == 1) ? -1e30f : 0.f, bsum = 0.f;
#pragma unroll
    for (int k = 0; k < 4; ++k)
#pragma unroll
      for (int r = 0; r < 16; ++r) C[k][r] = 0.f;
    float* stbase = p.scanst + (size_t)((((b * ML_H + h) * 2 + dir) * 4 + vs)) * (NSEG - 1) * ST_STRIDE;
    if (PASS == 2) {
#ifndef HOST_TEST
      if (ML_MERGE) seg_acquire(p.bar, (((b * ML_H + h) * 2 + dir) * 4 + vs) * NSEG, seg);
#endif
#pragma unroll 1
      for (int j = 0; j < seg; ++j) {
        const float* st = stbase + (size_t)j * ST_STRIDE;
        const float m2 = ST_LOAD(st + 4096 + 128), B2 = ST_LOAD(st + 4096 + 129);
        const float mn = fmaxf(B2 + m, m2), fa = fast_exp(B2 + m - mn), fb = fast_exp(m2 - mn);
        const float* sp = st;
#pragma unroll
        for (int k = 0; k < 4; ++k) {
#pragma unroll
          for (int r = 0; r < 16; ++r) { C[k][r] = fa * C[k][r] + fb * ST_LOAD(sp + lane); sp += 64; }
          nk[k] = fa * nk[k] + fb * ST_LOAD(st + 4096 + k * 32 + r32); }
        m = mn;
      }
      if (hi == 0) {
#pragma unroll
        for (int k = 0; k < 4; ++k) L.Tn[k * 32 + r32] = nk[k]; }
      WAVE_LDS_SYNC();
    }
    Pre R;
    if (nc > 0) { mlstm_prefetch<PASS == 1>(p, R, b, h, dir, vs, c0, gt, lane); mlstm_tiles_to_lds<PASS == 1>(R, Qt, Kt, gt); }
    __syncthreads();
#pragma unroll 1
    for (int ci = 0; ci < ncmax; ++ci) {
      const bool act = ci < nc, more = ci + 1 < nc;
      if (act) mlstm_chunk2<PASS == 2>(p, L, Qt, Kt, R, b, h, dir, vs, c0 + ci, more ? c0 + ci + 1 : -1, C, nk, m, bsum, gt, lane);
      __syncthreads();
      if (more) mlstm_tiles_to_lds<PASS == 1>(R, Qt, Kt, gt);
      __syncthreads();
    }
    if (PASS == 1 && nc > 0) {
      float* st = stbase + (size_t)seg * ST_STRIDE;
      float* sp = st;
#pragma unroll
      for (int k = 0; k < 4; ++k) {
#pragma unroll
        for (int r = 0; r < 16; ++r) { ST_STORE(sp + lane, C[k][r]); sp += 64; }
        if (hi == 0) ST_STORE(st + 4096 + k * 32 + r32, nk[k]); }
      if (lane == 0) { ST_STORE(st + 4096 + 128, m); ST_STORE(st + 4096 + 129, bsum); }
#ifndef HOST_TEST
      if (ML_MERGE) seg_publish(p.bar, (((b * ML_H + h) * 2 + dir) * 4 + vs) * NSEG + seg);
#endif
    }
  }
}
}

namespace scan {
constexpr int GK = GLA_H * GLA_DK;
constexpr int NCH = TB / 64;
constexpr int GST_STRIDE = 2048 + 64 + 8;
static_assert(4 * GK <= LDA, "Q'|K' for both directions fit in the A1 region");
__device__ __forceinline__ bf16_t* gla_qp(const Params& p, int dir) { return p.A1 + (size_t)dir * M * GK; }
__device__ __forceinline__ bf16_t* gla_kp(const Params& p, int dir) { return p.A1 + (size_t)(2 + dir) * M * GK; }
__device__ __forceinline__ float* gla_ebl(const Params& p) { return p.scanst + (size_t)NB * GLA_H * 2 * 4 * (NSEG - 1) * GST_STRIDE; }
constexpr int PRE_WLDS = 2 * 64 * 64 * 2 + 64 * GRANK * 2;
__device__ __forceinline__ void gla_prepass(const Params& p, unsigned char* lds) {
  const int lane = threadIdx.x & 63, wid = UNIFORM((int)(threadIdx.x >> 6)), nwaves = (int)gridDim.x * (NTHREADS / 64);
  bf16_t* qt = reinterpret_cast<bf16_t*>(lds + (size_t)wid * PRE_WLDS); bf16_t* kt = qt + 64 * 64; bf16_t* gat = kt + 64 * 64;
#pragma unroll 1
  for (int item = (int)blockIdx.x * (NTHREADS / 64) + wid; item < NB * 2 * NCH * GLA_H; item += nwaves) {
    const int h = item % GLA_H, pc = (item / GLA_H) % NCH, dir = (item / (GLA_H * NCH)) % 2, b = item / (GLA_H * NCH * 2);
    const size_t m = (size_t)b * TB + seq_token(pc * 64 + lane, dir);
    const bf16_t* prow = p.Pb + m * LDP;
    const int tsub = lane >> 3, tch = (lane & 7) * 8;
    { bf16x8_t qv[8], kv[8];
#pragma unroll
      for (int j = 0; j < 8; ++j) { const bf16_t* pr = p.Pb + ((size_t)b * TB + seq_token(pc * 64 + j * 8 + tsub, dir)) * LDP;
        qv[j] = ld_nat(pr + P1_GQ + h * GLA_DK + tch); kv[j] = ld_nat(pr + P1_GK + h * GLA_DK + tch); }
      const int gsub = lane >> 1, gh = (lane & 1) * 8;
      const bf16x8_t g0 = ld_nat(p.Pb + ((size_t)b * TB + seq_token(pc * 64 + gsub, dir)) * LDP + P1_GA + dir * GRANK + gh),
                     g1 = ld_nat(p.Pb + ((size_t)b * TB + seq_token(pc * 64 + 32 + gsub, dir)) * LDP + P1_GA + dir * GRANK + gh);
#pragma unroll
      for (int j = 0; j < 8; ++j) { *reinterpret_cast<bf16x8_t*>(qt + (j * 8 + tsub) * 64 + tch) = qv[j]; *reinterpret_cast<bf16x8_t*>(kt + (j * 8 + tsub) * 64 + tch) = kv[j]; }
      *reinterpret_cast<bf16x8_t*>(gat + gsub * GRANK + gh) = g0; *reinterpret_cast<bf16x8_t*>(gat + (32 + gsub) * GRANK + gh) = g1; }
    float wg[GRANK];
#pragma unroll
    for (int r = 0; r < GRANK; ++r) wg[r] = p.w_gate[((size_t)dir * GRANK + r) * GK + h * GLA_DK + lane];
    const float bg = p.b_gate[dir * GK + h * GLA_DK + lane];
    WAVE_LDS_SYNC();
    float bc = 0.f;
#pragma unroll 4
    for (int i = 0; i < 64; ++i) {
      const bf16x8_t g0 = *reinterpret_cast<const bf16x8_t*>(gat + i * GRANK), g1 = *reinterpret_cast<const bf16x8_t*>(gat + i * GRANK + 8);
      float gp = bg;
#pragma unroll
      for (int r = 0; r < 8; ++r) gp += bf2f((bf16_t)g0[r]) * wg[r] + bf2f((bf16_t)g1[r]) * wg[8 + r];
      bc += (fminf(gp, 0.f) - fast_log(1.f + fast_exp(-fabsf(gp)))) * (1.f / 16.f);
      const float q = bf2f(qt[i * 64 + lane]) * 0.125f, k = bf2f(kt[i * 64 + lane]);
      qt[i * 64 + lane] = f2bf(q * fast_exp(bc)); kt[i * 64 + lane] = f2bf(k * fast_exp(-bc));
    }
    gla_ebl(p)[(((size_t)dir * NB + b) * NCH + pc) * GK + h * GLA_DK + lane] = fast_exp(bc);
    WAVE_LDS_SYNC();
#pragma unroll
    for (int j = 0; j < 8; ++j) { const size_t mj = (size_t)b * TB + seq_token(pc * 64 + j * 8 + tsub, dir);
      *reinterpret_cast<bf16x8_t*>(gla_qp(p, dir) + mj * GK + h * GLA_DK + tch) = *reinterpret_cast<const bf16x8_t*>(qt + (j * 8 + tsub) * 64 + tch);
      *reinterpret_cast<bf16x8_t*>(gla_kp(p, dir) + mj * GK + h * GLA_DK + tch) = *reinterpret_cast<const bf16x8_t*>(kt + (j * 8 + tsub) * 64 + tch); }
    WAVE_LDS_SYNC();
  }
}
template <bool FULL>
__device__ __forceinline__ void gla_chunk(const Params& p, WaveLds& L, const int b, const int h, const int dir, const int vs, const int pc, f32x16_t (&S)[2], float (&dprod)[2], const int lane) {
  const int r32 = lane & 31, hi = lane >> 5;
  const int tok_l = seq_token(pc * 64 + lane, dir), mrow_l = b * TB + tok_l;
  const int mr[2] = {b * TB + seq_token(pc * 64 + r32, dir), b * TB + seq_token(pc * 64 + 32 + r32, dir)};
  const bf16_t* Kb[2] = {gla_kp(p, dir) + (size_t)mr[0] * GK + h * GLA_DK, gla_kp(p, dir) + (size_t)mr[1] * GK + h * GLA_DK};
  const bf16_t* Qb[2] = {gla_qp(p, dir) + (size_t)mr[0] * GK + h * GLA_DK, gla_qp(p, dir) + (size_t)mr[1] * GK + h * GLA_DK};
  const float* eb = gla_ebl(p) + (((size_t)dir * NB + b) * NCH + pc) * GK + h * GLA_DK;
  { const bf16_t* vr = p.Pb + (size_t)mrow_l * LDP + P1_GV + h * GLA_DV + vs * 32;
#pragma unroll
    for (int c = 0; c < 4; ++c) { const bf16x8_t v8 = ld_nat(vr + c * 8);
#pragma unroll
      for (int e = 0; e < 8; ++e) L.vt[(c * 8 + e) * VT_LD + lane] = (bf16_t)v8[e]; } }
  L.Tg[lane] = eb[lane];
  MFMA_ASM_PAD();
  const bool emit = FULL && pc >= CTX / 64;
  if (emit) L.Trow[lane] = b * SEQ + (tok_l - CTX);
  WAVE_LDS_SYNC();
  if (emit) {
    bf16_t* Oout = (dir ? p.Hb : p.Hf) + (size_t)(h * 4 + vs) * MLAT * 32 + r32;
#pragma unroll
    for (int tblk = 0; tblk < 2; ++tblk) {
      f32x16_t O;
#pragma unroll
      for (int r = 0; r < 16; ++r) O[r] = 0.f;
      const int t = r32 + 32 * tblk;
#pragma unroll
      for (int sblk = 0; sblk <= tblk; ++sblk) {
        f32x16_t P;
#pragma unroll
        for (int r = 0; r < 16; ++r) P[r] = 0.f;
#pragma unroll
        for (int st = 0; st < 4; ++st) P = MFMA32(ld_nat(Kb[sblk] + 16 * st + 8 * hi), ld_nat(Qb[tblk] + 16 * st + 8 * hi), P);
#pragma unroll
        for (int r = 0; r < 16; ++r) { const int sidx = crow(r, hi) + 32 * sblk; P[r] = (sidx <= t) ? P[r] : 0.f; }
        MFMA_ASM_PAD();
        const bf16x8_t pa0 = pk4_frag(P, 0), pa1 = pk4_frag(P, 8);
        O = MFMA32(pa0, ld_nat(L.vt + r32 * VT_LD + 32 * sblk + 8 * hi), O);
        O = MFMA32(pa1, ld_nat(L.vt + r32 * VT_LD + 32 * sblk + 16 + 8 * hi), O);
      }
#pragma unroll
      for (int kblk = 0; kblk < 2; ++kblk)
#pragma unroll
        for (int s2 = 0; s2 < 2; ++s2) O = MFMA32(ld_perm(Qb[tblk] + 32 * kblk + 16 * s2, hi), acc_frag(S[kblk], s2), O);
#pragma unroll
      for (int r = 0; r < 16; ++r) Oout[(size_t)L.Trow[crow(r, hi) + 32 * tblk] * 32] = f2bf(O[r]);
    }
  }
  bf16x8_t I0, I1;
#pragma unroll
  for (int j = 0; j < 8; ++j) { I0[j] = (r32 == 8 * hi + j) ? (short)0x3F80 : (short)0; I1[j] = (r32 == 16 + 8 * hi + j) ? (short)0x3F80 : (short)0; }
#pragma unroll
  for (int kblk = 0; kblk < 2; ++kblk) {
    const float ek = eb[32 * kblk + r32];
#pragma unroll
    for (int r = 0; r < 16; ++r) S[kblk][r] *= L.Tg[crow(r, hi) + 32 * kblk];
#pragma unroll
    for (int sblk = 0; sblk < 2; ++sblk) {
      f32x16_t X;
#pragma unroll
      for (int r = 0; r < 16; ++r) X[r] = 0.f;
      X = MFMA32(ld_nat(Kb[sblk] + 32 * kblk + 8 * hi), I0, X);
      X = MFMA32(ld_nat(Kb[sblk] + 32 * kblk + 16 + 8 * hi), I1, X);
#pragma unroll
      for (int r = 0; r < 16; ++r) X[r] *= ek;
      S[kblk] = MFMA32(acc_frag(X, 0), ld_perm(L.vt + r32 * VT_LD + 32 * sblk, hi), S[kblk]);
      S[kblk] = MFMA32(acc_frag(X, 1), ld_perm(L.vt + r32 * VT_LD + 32 * sblk + 16, hi), S[kblk]);
    }
    dprod[kblk] *= ek;
  }
  WAVE_LDS_SYNC();
}
template <int PASS> __device__ __forceinline__ void gla_pass(const Params& p, unsigned char* lds) {
  const int lane = threadIdx.x & 63, wid = UNIFORM((int)(threadIdx.x >> 6)), r32 = lane & 31, hi = lane >> 5;
  WaveLds& L = *reinterpret_cast<WaveLds*>(lds + (size_t)wid * sizeof(WaveLds));
  const int nwaves = (int)gridDim.x * (NTHREADS / 64);
#pragma unroll 1
  for (int item = (int)blockIdx.x * (NTHREADS / 64) + wid; item < NB * GLA_H * 2 * 4 * NSEG; item += nwaves) {
    const int seg = item % NSEG, vs = (item / NSEG) % 4, dir = (item / (NSEG * 4)) % 2, h = (item / (NSEG * 8)) % GLA_H, b = item / (NSEG * 8 * GLA_H);
    if (PASS == 1 && seg == NSEG - 1) continue;
    int c0, nc; seg_range(seg, c0, nc);
    f32x16_t S[2]; float dprod[2] = {1.f, 1.f};
#pragma unroll
    for (int k = 0; k < 2; ++k)
#pragma unroll
      for (int r = 0; r < 16; ++r) S[k][r] = 0.f;
    float* stbase = p.scanst + (size_t)(item / NSEG) * (NSEG - 1) * GST_STRIDE;
    if (PASS == 2) {
#pragma unroll 1
      for (int j = 0; j < seg; ++j) { const float* st = stbase + (size_t)j * GST_STRIDE;
#pragma unroll
        for (int k = 0; k < 2; ++k)
#pragma unroll
          for (int r = 0; r < 16; ++r) S[k][r] = st[2048 + 32 * k + crow(r, hi)] * S[k][r] + st[(k * 16 + r) * 64 + lane]; }
    }
#pragma unroll 1
    for (int ci = 0; ci < nc; ++ci) gla_chunk<PASS == 2>(p, L, b, h, dir, vs, c0 + ci, S, dprod, lane);
    if (PASS == 1) { float* st = stbase + (size_t)seg * GST_STRIDE;
#pragma unroll
      for (int k = 0; k < 2; ++k) {
#pragma unroll
        for (int r = 0; r < 16; ++r) st[(k * 16 + r) * 64 + lane] = S[k][r];
        if (hi == 0) st[2048 + 32 * k + r32] = dprod[k]; } }
  }
}
}


namespace scan {
constexpr int GQ_LD = GLA_DK + 8;
constexpr int G_TILE = 64 * GQ_LD;
struct GPre { bf16x8_t tq[2], tk[2]; };
__device__ __forceinline__ void gla_prefetch(const Params& p, GPre& R, const int b, const int h, const int dir, const int pc, const int gt) {
  const int tlo = dir ? seq_token(pc * 64 + 63, dir) : seq_token(pc * 64, dir);
  const size_t m0 = (size_t)b * TB + tlo;
  const bf16_t* qb = gla_qp(p, dir) + m0 * GK + h * GLA_DK; const bf16_t* kb = gla_kp(p, dir) + m0 * GK + h * GLA_DK;
#pragma unroll
  for (int i = 0; i < 2; ++i) { const int j = gt + 256 * i, row = j >> 3; const unsigned off = (unsigned)((dir ? 63 - row : row) * GK + (j & 7) * 8); R.tq[i] = ld_nat(qb + off); R.tk[i] = ld_nat(kb + off); }
}
__device__ __forceinline__ void gla_tiles_to_lds(const GPre& R, bf16_t* Qt, bf16_t* Kt, const int gt) {
#pragma unroll
  for (int i = 0; i < 2; ++i) { const int j = gt + 256 * i, row = j >> 3, c8 = j & 7;
    *reinterpret_cast<bf16x8_t*>(Qt + row * GQ_LD + c8 * 8) = R.tq[i]; *reinterpret_cast<bf16x8_t*>(Kt + row * GQ_LD + c8 * 8) = R.tk[i]; }
}
template <bool FULL>
__device__ __forceinline__ void gla_chunk2(const Params& p, WaveLds& L, const bf16_t* Qt, const bf16_t* Kt, GPre& R, const int b, const int h, const int dir, const int vs, const int pc, const int pc_next,
                                           f32x16_t (&S)[2], float (&dprod)[2], const int gt, const int lane) {
  const int r32 = lane & 31, hi = lane >> 5;
  const int tok_l = seq_token(pc * 64 + lane, dir), mrow_l = b * TB + tok_l;
  const float* eb = gla_ebl(p) + (((size_t)dir * NB + b) * NCH + pc) * GK + h * GLA_DK;
  { const bf16_t* vr = p.Pb + (size_t)mrow_l * LDP + P1_GV + h * GLA_DV + vs * 32;
#pragma unroll
    for (int c = 0; c < 4; ++c) { const bf16x8_t v8 = ld_nat(vr + c * 8);
#pragma unroll
      for (int e = 0; e < 8; ++e) L.vt[(c * 8 + e) * VT_LD + lane] = (bf16_t)v8[e]; } }
  L.Tg[lane] = eb[lane];
  MFMA_ASM_PAD();
  const bool emit = FULL && pc >= CTX / 64;
  if (emit) L.Trow[lane] = b * SEQ + (tok_l - CTX);
  WAVE_LDS_SYNC();
  if (emit) {
    bf16_t* Oout = (dir ? p.Hb : p.Hf) + (size_t)(h * 4 + vs) * MLAT * 32 + r32;
#pragma unroll
    for (int tblk = 0; tblk < 2; ++tblk) {
      f32x16_t O;
#pragma unroll
      for (int r = 0; r < 16; ++r) O[r] = 0.f;
      const int t = r32 + 32 * tblk;
      const bf16_t* Qb = Qt + (32 * tblk + r32) * GQ_LD;
#pragma unroll
      for (int sblk = 0; sblk <= tblk; ++sblk) {
        const bf16_t* Kb = Kt + (32 * sblk + r32) * GQ_LD;
        f32x16_t P;
#pragma unroll
        for (int r = 0; r < 16; ++r) P[r] = 0.f;
#pragma unroll
        for (int st = 0; st < 4; ++st) P = MFMA32(ld_nat(Kb + 16 * st + 8 * hi), ld_nat(Qb + 16 * st + 8 * hi), P);
#pragma unroll
        for (int r = 0; r < 16; ++r) { const int sidx = crow(r, hi) + 32 * sblk; P[r] = (sidx <= t) ? P[r] : 0.f; }
        MFMA_ASM_PAD();
        const bf16x8_t pa0 = pk4_frag(P, 0), pa1 = pk4_frag(P, 8);
        O = MFMA32(pa0, ld_nat(L.vt + r32 * VT_LD + 32 * sblk + 8 * hi), O);
        O = MFMA32(pa1, ld_nat(L.vt + r32 * VT_LD + 32 * sblk + 16 + 8 * hi), O);
      }
#pragma unroll
      for (int kblk = 0; kblk < 2; ++kblk)
#pragma unroll
        for (int s2 = 0; s2 < 2; ++s2) O = MFMA32(ld_perm(Qb + 32 * kblk + 16 * s2, hi), acc_frag(S[kblk], s2), O);
#pragma unroll
      for (int r = 0; r < 16; ++r) Oout[(size_t)L.Trow[crow(r, hi) + 32 * tblk] * 32] = f2bf(O[r]);
    }
  }
  if (pc_next >= 0) gla_prefetch(p, R, b, h, dir, pc_next, gt);
  bf16x8_t I0, I1;
#pragma unroll
  for (int j = 0; j < 8; ++j) { I0[j] = (r32 == 8 * hi + j) ? (short)0x3F80 : (short)0; I1[j] = (r32 == 16 + 8 * hi + j) ? (short)0x3F80 : (short)0; }
#pragma unroll
  for (int kblk = 0; kblk < 2; ++kblk) {
    const float ek = eb[32 * kblk + r32];
#pragma unroll
    for (int r = 0; r < 16; ++r) S[kblk][r] *= L.Tg[crow(r, hi) + 32 * kblk];
#pragma unroll
    for (int sblk = 0; sblk < 2; ++sblk) {
      const bf16_t* Kb = Kt + (32 * sblk + r32) * GQ_LD;
      f32x16_t X;
#pragma unroll
      for (int r = 0; r < 16; ++r) X[r] = 0.f;
      X = MFMA32(ld_nat(Kb + 32 * kblk + 8 * hi), I0, X);
      X = MFMA32(ld_nat(Kb + 32 * kblk + 16 + 8 * hi), I1, X);
#pragma unroll
      for (int r = 0; r < 16; ++r) X[r] *= ek;
      S[kblk] = MFMA32(acc_frag(X, 0), ld_perm(L.vt + r32 * VT_LD + 32 * sblk, hi), S[kblk]);
      S[kblk] = MFMA32(acc_frag(X, 1), ld_perm(L.vt + r32 * VT_LD + 32 * sblk + 16, hi), S[kblk]);
    }
    dprod[kblk] *= ek;
  }
  WAVE_LDS_SYNC();
}
template <int PASS> __device__ __forceinline__ void gla_block(const Params& p, unsigned char* lds) {
  const int tid = threadIdx.x, lane = tid & 63, wid = UNIFORM(tid >> 6), r32 = lane & 31, hi = lane >> 5, grp = wid >> 2, vs = wid & 3, gt = tid & 255;
  WaveLds& L = *reinterpret_cast<WaveLds*>(lds + (size_t)wid * sizeof(WaveLds));
  bf16_t* Qt = reinterpret_cast<bf16_t*>(lds + OFF_TILES) + (size_t)grp * 2 * G_TILE; bf16_t* Kt = Qt + G_TILE;
  constexpr int NIT = NB * GLA_H * 2 * NSEG;
#pragma unroll 1
  for (int pidx = (int)blockIdx.x; pidx < NIT / 2; pidx += (int)gridDim.x) {
    const int it = 2 * pidx + grp, seg = it % NSEG, dir = (it / NSEG) % 2, h = (it / (NSEG * 2)) % GLA_H, b = it / (NSEG * 2 * GLA_H);
    int c0, nc, c0b, ncb; seg_range(seg, c0, nc); seg_range((2 * pidx + (grp ^ 1)) % NSEG, c0b, ncb);
    if (PASS == 1 && seg == NSEG - 1) nc = 0;
    if (PASS == 1 && (2 * pidx + (grp ^ 1)) % NSEG == NSEG - 1) ncb = 0;
    const int ncmax = nc > ncb ? nc : ncb;
    f32x16_t S[2]; float dprod[2] = {1.f, 1.f};
#pragma unroll
    for (int k = 0; k < 2; ++k)
#pragma unroll
      for (int r = 0; r < 16; ++r) S[k][r] = 0.f;
    float* stbase = p.scanst + (size_t)((((b * GLA_H + h) * 2 + dir) * 4 + vs)) * (NSEG - 1) * GST_STRIDE;
    if (PASS == 2) {
#ifndef HOST_TEST
      if (ML_MERGE) seg_acquire(p.bar + 2048, (((b * GLA_H + h) * 2 + dir) * 4 + vs) * NSEG, seg);
#endif
#pragma unroll 1
      for (int j = 0; j < seg; ++j) { const float* st = stbase + (size_t)j * GST_STRIDE; const float* sp = st;
#pragma unroll
        for (int k = 0; k < 2; ++k)
#pragma unroll
          for (int r = 0; r < 16; ++r) { S[k][r] = ST_LOAD(st + 2048 + 32 * k + crow(r, hi)) * S[k][r] + ST_LOAD(sp + lane); sp += 64; } }
    }
    GPre R;
    if (nc > 0) { gla_prefetch(p, R, b, h, dir, c0, gt); gla_tiles_to_lds(R, Qt, Kt, gt); }
    __syncthreads();
#pragma unroll 1
    for (int ci = 0; ci < ncmax; ++ci) {
      const bool act = ci < nc, more = ci + 1 < nc;
      if (act) gla_chunk2<PASS == 2>(p, L, Qt, Kt, R, b, h, dir, vs, c0 + ci, more ? c0 + ci + 1 : -1, S, dprod, gt, lane);
      __syncthreads();
      if (more) gla_tiles_to_lds(R, Qt, Kt, gt);
      __syncthreads();
    }
    if (PASS == 1 && nc > 0) { float* st = stbase + (size_t)seg * GST_STRIDE; float* sp = st;
#pragma unroll
      for (int k = 0; k < 2; ++k) {
#pragma unroll
        for (int r = 0; r < 16; ++r) { ST_STORE(sp + lane, S[k][r]); sp += 64; }
        if (hi == 0) ST_STORE(st + 2048 + 32 * k + r32, dprod[k]); }
#ifndef HOST_TEST
      if (ML_MERGE) seg_publish(p.bar + 2048, (((b * GLA_H + h) * 2 + dir) * 4 + vs) * NSEG + seg);
#endif
    }
  }
}
}

namespace na {
constexpr int VP = 144, WLDS = 64 * VP;
static_assert(NA_D == 64 && NA_KW == 16 && NA_KH == 8 && CTX % 64 == 0, "NA geometry");
__device__ __forceinline__ unsigned char* wave_lds(unsigned char* lds, int wid) { return lds + (size_t)wid * WLDS; }
template <int GRP> __device__ __forceinline__ void pv_group(f32x4_t (&O)[4], const int vb, const bf16x8_t pf) {
  const s16x4_t a0 = TR_READ(vb, GRP * 32 * VP + 0), b0 = TR_READ(vb, GRP * 32 * VP + 4 * VP + 0), a1 = TR_READ(vb, GRP * 32 * VP + 32), b1 = TR_READ(vb, GRP * 32 * VP + 4 * VP + 32);
  const s16x4_t a2 = TR_READ(vb, GRP * 32 * VP + 64), b2 = TR_READ(vb, GRP * 32 * VP + 4 * VP + 64), a3 = TR_READ(vb, GRP * 32 * VP + 96), b3 = TR_READ(vb, GRP * 32 * VP + 4 * VP + 96);
  LGKM_WAIT(); SBAR();
#define PKV(L, H) (bf16x8_t){L[0], L[1], L[2], L[3], H[0], H[1], H[2], H[3]}
  O[0] = MFMA16(pf, PKV(a0, b0), O[0]); O[1] = MFMA16(pf, PKV(a1, b1), O[1]); O[2] = MFMA16(pf, PKV(a2, b2), O[2]); O[3] = MFMA16(pf, PKV(a3, b3), O[3]);
#undef PKV
}
__device__ __forceinline__ bf16x8_t p_frag(const float (&pv)[8]) {
  u32x4_t w = {cvtpk(pv[0], pv[1]), cvtpk(pv[2], pv[3]), cvtpk(pv[4], pv[5]), cvtpk(pv[6], pv[7])}; return __builtin_bit_cast(bf16x8_t, w);
}
template <int PART>
__device__ __forceinline__ void na_part(const Params& p, unsigned char* wl, const bf16_t* __restrict__ Pbb, const int h, const int r, const int rs, const int cb, const int cs, const int qc, const int g0ctx,
                                        const bf16x8_t (&qf)[2], f32x4_t (&O)[4], float& mrun, float& lrun, const bool first, const int lane) {
  const int qi = lane & 15, g = lane >> 4;
  const int kap0 = 8 * (qi >> 2) + (qi & 3);
  float sv[8][8];
#pragma unroll
  for (int half = 0; half < 2; ++half) {
    bf16x8_t kf[4][2][2]; float bias[4][8];
#pragma unroll
    for (int q4 = 0; q4 < 4; ++q4) { const int gi = half * 4 + q4;
      const int tokbase = PART == 0 ? CTX + (rs + gi) * GW + cb : 32 * (g0ctx + gi);
#pragma unroll
      for (int T = 0; T < 2; ++T) { const bf16_t* kr = Pbb + (size_t)(tokbase + kap0 + 4 * T) * LDP + P1_NK + h * NA_D + 8 * g;
        kf[q4][T][0] = *reinterpret_cast<const bf16x8_t*>(kr); kf[q4][T][1] = *reinterpret_cast<const bf16x8_t*>(kr + 32);
#pragma unroll
        for (int e = 0; e < 4; ++e) { bias[q4][4 * T + e] = 0.f;
          if (PART == 0) { const int kcol = cb + 8 * g + 4 * T + e; const bool valid = kcol >= cs && kcol < cs + NA_KW;
            const int bi = (h * (2 * NA_KH - 1) + (rs + gi - r + NA_KH - 1)) * (2 * NA_KW - 1) + (valid ? kcol - qc + NA_KW - 1 : 0);
            bias[q4][4 * T + e] = valid ? p.rpb[bi] : -1e30f; } } } }
#pragma unroll
    for (int q4 = 0; q4 < 4; ++q4) { const int gi = half * 4 + q4;
#pragma unroll
      for (int T = 0; T < 2; ++T) {
        f32x4_t acc = {0.f, 0.f, 0.f, 0.f};
        acc = MFMA16(kf[q4][T][0], qf[0], acc); acc = MFMA16(kf[q4][T][1], qf[1], acc);
#pragma unroll
        for (int e = 0; e < 4; ++e) { const float sc = acc[e] * 0.125f; sv[gi][4 * T + e] = (PART == 0) ? (bias[q4][4 * T + e] < -1e29f ? -1e30f : sc + bias[q4][4 * T + e]) : sc; }
      } }
  }
  float mx = sv[0][0];
#pragma unroll
  for (int gi = 0; gi < 8; ++gi)
#pragma unroll
    for (int e = 0; e < 8; ++e) mx = fmaxf(mx, sv[gi][e]);
  mx = fmaxf(mx, __shfl_xor(mx, 16)); mx = fmaxf(mx, __shfl_xor(mx, 32));
  const float mn = first ? mx : fmaxf(mrun, mx), alpha = first ? 0.f : fast_exp(mrun - mn);
  float ls = 0.f;
#pragma unroll
  for (int gi = 0; gi < 8; ++gi)
#pragma unroll
    for (int e = 0; e < 8; ++e) { const float pe = fast_exp(sv[gi][e] - mn); sv[gi][e] = pe; ls += pe; }
  ls += __shfl_xor(ls, 16); ls += __shfl_xor(ls, 32);
  lrun = lrun * alpha + ls; mrun = mn;
  if (!first) {
#pragma unroll
    for (int e = 0; e < 4; ++e) { const float f = __shfl(alpha, 4 * g + e);
#pragma unroll
      for (int dt = 0; dt < 4; ++dt) O[dt][e] *= f; }
  }
  const int vb = LDS_ADDR(wl) + (8 * g + (qi >> 2)) * VP + 8 * (qi & 3);
#pragma unroll
  for (int c = 0; c < 4; ++c) {
#pragma unroll
    for (int it = 0; it < 8; ++it) { const int row = it * 8 + (lane >> 3), grp = row >> 5, kk = row & 31;
      const int tok = PART == 0 ? CTX + (rs + 2 * c + grp) * GW + cb + kk : 32 * (g0ctx + 2 * c + grp) + kk;
      *reinterpret_cast<u32x4_t*>(wl + row * VP + (lane & 7) * 16) = *reinterpret_cast<const u32x4_t*>(Pbb + (size_t)tok * LDP + P1_NV + h * NA_D + (lane & 7) * 8); }
    WAVE_LDS_SYNC();
    pv_group<0>(O, vb, p_frag(sv[2 * c]));
    pv_group<1>(O, vb, p_frag(sv[2 * c + 1]));
    WAVE_LDS_SYNC();
  }
}
__device__ __forceinline__ void fp_na(const Params& p, unsigned char* lds) {
  const int lane = threadIdx.x & 63, wid = UNIFORM((int)(threadIdx.x >> 6)), qi = lane & 15, g = lane >> 4;
  unsigned char* wl = wave_lds(lds, wid);
  const int nwaves = (int)gridDim.x * (NTHREADS / 64);
#pragma unroll 1
  for (int item = (int)blockIdx.x * (NTHREADS / 64) + wid; item < NB * NA_H * GROWS * 4; item += nwaves) {
    const int cg = item & 3, r = (item >> 2) % GROWS, h = (item / (4 * GROWS)) % NA_H, b = item / (4 * GROWS * NA_H);
    const int qc = cg * 16 + qi;
    int rs = r - NA_KH / 2; rs = rs < 0 ? 0 : (rs > GROWS - NA_KH ? GROWS - NA_KH : rs);
    int cb = cg * 16 - 8; cb = cb < 0 ? 0 : (cb > GW - 32 ? GW - 32 : cb);
    int cs = qc - NA_KW / 2; cs = cs < 0 ? 0 : (cs > GW - NA_KW ? GW - NA_KW : cs);
    const bf16_t* Pbb = p.Pb + (size_t)b * TB * LDP;
    const size_t tq = (size_t)CTX + r * GW + qc;
    bf16x8_t qf[2];
    qf[0] = *reinterpret_cast<const bf16x8_t*>(Pbb + tq * LDP + P1_NQ + h * NA_D + 8 * g);
    qf[1] = *reinterpret_cast<const bf16x8_t*>(Pbb + tq * LDP + P1_NQ + h * NA_D + 32 + 8 * g);
    f32x4_t O[4];
#pragma unroll
    for (int dt = 0; dt < 4; ++dt) O[dt] = (f32x4_t){0.f, 0.f, 0.f, 0.f};
    float mrun = -1e30f, lrun = 0.f;
    na_part<0>(p, wl, Pbb, h, r, rs, cb, cs, qc, 0, qf, O, mrun, lrun, true, lane);
#pragma unroll 1
    for (int g0 = 0; g0 < CTX / 32; g0 += 8) na_part<1>(p, wl, Pbb, h, r, rs, cb, cs, qc, g0, qf, O, mrun, lrun, false, lane);
    const float invl = 1.f / lrun;
#pragma unroll
    for (int e = 0; e < 4; ++e) {
      const float f = __shfl(invl, 4 * g + e);
      const size_t tl = (size_t)r * GW + cg * 16 + 4 * g + e, ml = (size_t)b * SEQ + tl;
      const bf16_t* zr = Pbb + ((size_t)CTX + tl) * LDP + P1_Z + BRC + h * NA_D + qi;
      bf16_t* orow = p.A0 + ml * LDA + BRC + h * NA_D + qi;
#pragma unroll
      for (int dt = 0; dt < 4; ++dt) orow[dt * 16] = f2bf(O[dt][e] * f * silu_f(bf2f(zr[dt * 16])));
    }
  }
}
}


namespace na2 {
constexpr int VP = 144, ROWB = 64 * VP, STG = 2 * ROWB;
constexpr int OFF_K = 0, OFF_V = 2 * STG, OFF_RPB = 4 * STG, NRPB = (2 * NA_KH - 1) * (2 * NA_KW - 1), LDS_NA = OFF_RPB + NRPB * 4;
template <int NG>
__device__ __forceinline__ void na_step(const float* rpl, const unsigned char* Kst, const unsigned char* Vst, const bool local, const int cb, const int r, const int krow0, const bool act0, const bool act1,
                                        const int cs, const int qc, const bf16x8_t (&qf)[2], f32x4_t (&O)[4], float& mrun, float& lrun, const int lane) {
  const int qi = lane & 15, g = lane >> 4, kap0 = 8 * (qi >> 2) + (qi & 3);
  float sv[NG][8];
#pragma unroll
  for (int gg = 0; gg < NG; ++gg) {
    const int k0 = local ? 64 * gg + cb : 32 * gg;
    const bool act = !local || (gg == 0 ? act0 : act1);
#pragma unroll
    for (int T = 0; T < 2; ++T) {
      const unsigned char* kr = Kst + (k0 + kap0 + 4 * T) * VP + 16 * g;
      f32x4_t acc = {0.f, 0.f, 0.f, 0.f};
      acc = MFMA16(*reinterpret_cast<const bf16x8_t*>(kr), qf[0], acc);
      acc = MFMA16(*reinterpret_cast<const bf16x8_t*>(kr + 64), qf[1], acc);
#pragma unroll
      for (int e = 0; e < 4; ++e) {
        float sc = acc[e] * 0.125f;
        if (local) { const int kcol = cb + 8 * g + 4 * T + e; const bool valid = act && kcol >= cs && kcol < cs + NA_KW;
          const int bi = (krow0 + gg - r + NA_KH - 1) * (2 * NA_KW - 1) + (valid ? kcol - qc + NA_KW - 1 : 0);
          sc = valid ? sc + rpl[valid ? bi : 0] : -1e30f; }
        sv[gg][4 * T + e] = sc;
      }
    }
  }
  float mx = sv[0][0];
#pragma unroll
  for (int gg = 0; gg < NG; ++gg)
#pragma unroll
    for (int e = 0; e < 8; ++e) mx = fmaxf(mx, sv[gg][e]);
  if (__any(mx > mrun + 8.f)) {
    mx = fmaxf(mx, __shfl_xor(mx, 16)); mx = fmaxf(mx, __shfl_xor(mx, 32));
    const float mn = fmaxf(mrun, mx), alpha = fast_exp(mrun - mn);
    lrun *= alpha; mrun = mn;
#pragma unroll
    for (int e = 0; e < 4; ++e) { const float f = __shfl(alpha, 4 * g + e);
#pragma unroll
      for (int dt = 0; dt < 4; ++dt) O[dt][e] *= f; }
  }
  float ls = 0.f;
#pragma unroll
  for (int gg = 0; gg < NG; ++gg)
#pragma unroll
    for (int e = 0; e < 8; ++e) { const float pe = fast_exp(sv[gg][e] - mrun); sv[gg][e] = pe; ls += pe; }
  lrun += ls;
#pragma unroll
  for (int gg = 0; gg < NG; ++gg) {
    const int k0 = local ? 64 * gg + cb : 32 * gg;
    const int vb = LDS_ADDR(Vst) + (k0 + 8 * g + (qi >> 2)) * VP + 8 * (qi & 3);
    na::pv_group<0>(O, vb, na::p_frag(sv[gg]));
  }
}
__device__ __forceinline__ void fp_na2(const Params& p, unsigned char* lds) {
  const int tid = threadIdx.x, lane = tid & 63, wid = UNIFORM(tid >> 6), qi = lane & 15, g = lane >> 4;
  const int skk = tid >> 3, sc16 = tid & 7;
  constexpr int NU = NB * NA_H * (GROWS / 2), NCS = CTX / 128;
  static_assert(CTX % 128 == 0, "context keys are staged 128 at a time");
  float* rpl = reinterpret_cast<float*>(lds + OFF_RPB);
  static_assert(NRPB <= NTHREADS, "bias table staging");
  int h, b, r, rs, rlo, rhi, nloc, nsteps, cb, cs; const bf16_t* Pbb; size_t tq;
  const int cg = wid & 3, qc = cg * 16 + qi;
#define NA_UNIT(u_) do { const int rp_ = (u_) % (GROWS / 2); h = ((u_) / (GROWS / 2)) % NA_H; b = (u_) / ((GROWS / 2) * NA_H); r = 2 * rp_ + (wid >> 2); \
    rs = r - NA_KH / 2; rs = rs < 0 ? 0 : (rs > GROWS - NA_KH ? GROWS - NA_KH : rs); \
    rlo = 2 * rp_ - NA_KH / 2; rlo = rlo < 0 ? 0 : (rlo > GROWS - NA_KH ? GROWS - NA_KH : rlo); \
    rhi = 2 * rp_ + 1 - NA_KH / 2; rhi = (rhi < 0 ? 0 : (rhi > GROWS - NA_KH ? GROWS - NA_KH : rhi)) + NA_KH - 1; \
    nloc = (rhi - rlo + 2) / 2; nsteps = nloc + NCS; \
    cb = cg * 16 - 8; cb = cb < 0 ? 0 : (cb > GW - 32 ? GW - 32 : cb); \
    cs = qc - NA_KW / 2; cs = cs < 0 ? 0 : (cs > GW - NA_KW ? GW - NA_KW : cs); \
    Pbb = p.Pb + (size_t)b * TB * LDP; tq = (size_t)CTX + r * GW + qc; } while (0)
  static_assert(CTX / 128 + (NA_KH + 2) / 2 <= 7, "NA step unroll");
  u32x4_t ka0, va0, kb0, vb0_, ka1, va1, kb1, vb1_, ka2, va2, kb2, vb2_, ka3, va3, kb3, vb3_;
  bf16x8_t qf[2];
#define NA_LOADQ() do { qf[0] = *reinterpret_cast<const bf16x8_t*>(Pbb + tq * LDP + P1_NQ + h * NA_D + 8 * g); qf[1] = *reinterpret_cast<const bf16x8_t*>(Pbb + tq * LDP + P1_NQ + h * NA_D + 32 + 8 * g); } while (0)
#define NA_LOAD(R_, s_) do { const int sl_ = (s_) < nsteps ? (s_) : nsteps - 1; \
    const int rowA_ = rlo + 2 * sl_, rowB_ = rowA_ + 1 > rhi ? rhi : rowA_ + 1; \
    const int tokA_ = sl_ < nloc ? CTX + rowA_ * GW : 128 * (sl_ - nloc), tokB_ = sl_ < nloc ? CTX + rowB_ * GW : 128 * (sl_ - nloc) + 64; \
    const bf16_t* sa_ = Pbb + (size_t)(tokA_ + skk) * LDP + h * NA_D + sc16 * 8; const bf16_t* sb_ = Pbb + (size_t)(tokB_ + skk) * LDP + h * NA_D + sc16 * 8; \
    ka##R_ = *reinterpret_cast<const u32x4_t*>(sa_ + P1_NK); va##R_ = *reinterpret_cast<const u32x4_t*>(sa_ + P1_NV); \
    kb##R_ = *reinterpret_cast<const u32x4_t*>(sb_ + P1_NK); vb##R_##_ = *reinterpret_cast<const u32x4_t*>(sb_ + P1_NV); } while (0)
#define NA_STORE(R_, buf_) do { unsigned char* kd_ = lds + OFF_K + (buf_) * STG + skk * VP + sc16 * 16; unsigned char* vd_ = lds + OFF_V + (buf_) * STG + skk * VP + sc16 * 16; \
    *reinterpret_cast<u32x4_t*>(kd_) = ka##R_; *reinterpret_cast<u32x4_t*>(vd_) = va##R_; *reinterpret_cast<u32x4_t*>(kd_ + ROWB) = kb##R_; *reinterpret_cast<u32x4_t*>(vd_ + ROWB) = vb##R_##_; } while (0)
#define NA_COMPUTE(s_, buf_) do { const unsigned char* Kst = lds + OFF_K + (buf_) * STG; const unsigned char* Vst = lds + OFF_V + (buf_) * STG; \
    if ((s_) < nloc) { const int kr0_ = rlo + 2 * (s_); const bool a0_ = kr0_ >= rs && kr0_ < rs + NA_KH, a1_ = kr0_ + 1 <= rhi && kr0_ + 1 >= rs && kr0_ + 1 < rs + NA_KH; \
      if (a0_ || a1_) na_step<2>(rpl, Kst, Vst, true, cb, r, kr0_, a0_, a1_, cs, qc, qf, O, mrun, lrun, lane); } \
    else if ((s_) < nsteps) na_step<4>(rpl, Kst, Vst, false, 0, r, 0, true, true, cs, qc, qf, O, mrun, lrun, lane); } while (0)
#define NA_STEP(s_, cur_, nxt_, buf_, nbuf_) do { NA_LOAD(cur_, (s_) + 4); NA_COMPUTE(s_, buf_); NA_STORE(nxt_, nbuf_); __syncthreads(); } while (0)
  int u = (int)blockIdx.x;
  if (u < NU) { NA_UNIT(u); NA_LOADQ(); NA_LOAD(0, 0); NA_LOAD(1, 1); NA_LOAD(2, 2); NA_LOAD(3, 3); }
#pragma unroll 1
  while (u < NU) {
    f32x4_t O[4];
#pragma unroll
    for (int dt = 0; dt < 4; ++dt) O[dt] = (f32x4_t){0.f, 0.f, 0.f, 0.f};
    float mrun = -1e30f, lrun = 0.f;
    if (tid < NRPB) rpl[tid] = p.rpb[(size_t)h * NRPB + tid];
    NA_STORE(0, 0);
    __syncthreads();
    NA_STEP(0, 0, 1, 0, 1);
    NA_STEP(1, 1, 2, 1, 0);
    NA_STEP(2, 2, 3, 0, 1);
    NA_STEP(3, 3, 0, 1, 0);
    NA_STEP(4, 0, 1, 0, 1);
    NA_STEP(5, 1, 2, 1, 0);
    NA_STEP(6, 2, 3, 0, 1);
    const size_t tl0 = (size_t)r * GW + cg * 16 + 4 * g, ml0 = (size_t)b * SEQ + tl0;
    const bf16_t* zr0 = Pbb + ((size_t)CTX + tl0) * LDP + P1_Z + BRC + h * NA_D + qi;
    bf16_t* orow0 = p.A0 + ml0 * LDA + BRC + h * NA_D + qi;
    bf16_t zv[4][4];
#pragma unroll
    for (int e = 0; e < 4; ++e)
#pragma unroll
      for (int dt = 0; dt < 4; ++dt) zv[e][dt] = zr0[(size_t)e * LDP + dt * 16];
    u += (int)gridDim.x;
    if (u < NU) { NA_UNIT(u); NA_LOADQ(); NA_LOAD(0, 0); NA_LOAD(1, 1); NA_LOAD(2, 2); NA_LOAD(3, 3); }
    lrun += __shfl_xor(lrun, 16); lrun += __shfl_xor(lrun, 32);
    const float invl = 1.f / lrun;
#pragma unroll
    for (int e = 0; e < 4; ++e) {
      const float f = __shfl(invl, 4 * g + e);
#pragma unroll
      for (int dt = 0; dt < 4; ++dt) orow0[(size_t)e * LDA + dt * 16] = f2bf(O[dt][e] * f * silu_f(bf2f(zv[e][dt])));
    }
  }
#undef NA_STEP
#undef NA_COMPUTE
#undef NA_LOAD
#undef NA_STORE
#undef NA_LOADQ
#undef NA_UNIT
}
}

__device__ __forceinline__ void fp_conv(const Params& p) {
  constexpr int CH8 = 2 * BRB / 8, NB8 = 8;
  const long g = gtid(); const int c8 = (int)(g % CH8), run = (int)(g / CH8), nrun = (int)(gsize() / CH8), j0 = c8 * 8;
  if (nrun == 0) { if (g == 0) {   } return; }
  const int R = (M + nrun - 1) / nrun;
  float w[3][8], bb[8];
#pragma unroll
  for (int e = 0; e < 8; ++e) { bb[e] = p.conv_b[j0 + e]; w[0][e] = p.conv_w[0 * 2 * BRB + j0 + e]; w[1][e] = p.conv_w[1 * 2 * BRB + j0 + e]; w[2][e] = p.conv_w[2 * 2 * BRB + j0 + e]; }
  const float sc = j0 < BRB ? 0.08838834764831845f : 1.f;
  const bf16_t* src = p.Pb + P0_MQ + j0;
  bf16_t* dst = j0 < BRB ? p.mqc + j0 : p.mkc + (j0 - BRB);
  int r = run * R; const int rend = (r + R < M) ? r + R : M;
  if (r >= rend) return;
  bf16x8_t X[NB8 + 2];
  X[0] = *reinterpret_cast<const bf16x8_t*>(src + (size_t)(r > 0 ? r - 1 : 0) * LDP);
  X[1] = *reinterpret_cast<const bf16x8_t*>(src + (size_t)r * LDP);
  for (; r < rend; r += NB8) {
#pragma unroll
    for (int i = 0; i < NB8; ++i) { const int row = r + 1 + i; X[2 + i] = *reinterpret_cast<const bf16x8_t*>(src + (size_t)(row < M ? row : M - 1) * LDP); }
#pragma unroll
    for (int i = 0; i < NB8; ++i) {
      const int m = r + i;
      if (m < rend) {
        const int t = m % TB; const bool hasl = (t != 0) && (t != CTX), hasr = (t != CTX - 1) && (t != TB - 1);
        float y[8];
#pragma unroll
        for (int e = 0; e < 8; ++e) { y[e] = bb[e] + bf2f((bf16_t)X[i + 1][e]) * w[1][e];
          if (hasl) y[e] += bf2f((bf16_t)X[i][e]) * w[0][e];
          if (hasr) y[e] += bf2f((bf16_t)X[i + 2][e]) * w[2][e]; }
#pragma unroll
        for (int e = 0; e < 8; ++e) y[e] = silu_f(y[e]) * sc;
        u32x4_t o; o.x = pk2bf(y[0], y[1]); o.y = pk2bf(y[2], y[3]); o.z = pk2bf(y[4], y[5]); o.w = pk2bf(y[6], y[7]);
        *reinterpret_cast<u32x4_t*>(dst + (size_t)m * BRB) = o;
      }
    }
    X[0] = X[NB8]; X[1] = X[NB8 + 1];
  }
}
template <int LAYER> __device__ __forceinline__ void fp_comb(const Params& p) {
  static_assert(BRB == 512 && BRC == 512, "fp_comb: 4 heads x 128 channels");
  const int lane = threadIdx.x & 63, gw = (int)(gtid() >> 6), ngw = (int)(gsize() >> 6), c0 = lane * 8;
  const int NR = LAYER == 0 ? M : MLAT;
  for (int row = gw; row < NR; row += ngw) {
    const size_t m = LAYER == 0 ? (size_t)row : ((size_t)(row / SEQ) * TB + CTX + (row % SEQ));
    const bf16x8_t a = *reinterpret_cast<const bf16x8_t*>(p.Hf + hoff(c0, (size_t)row, (size_t)NR)), b = *reinterpret_cast<const bf16x8_t*>(p.Hb + hoff(c0, (size_t)row, (size_t)NR));
    const bf16x8_t z8 = *reinterpret_cast<const bf16x8_t*>(p.Pb + m * LDP + (LAYER == 0 ? P0_Z + BRA : P1_Z) + c0);
    float g[8]; float ss = 0.f;
    if (LAYER == 0) { const bf16x8_t mo = *reinterpret_cast<const bf16x8_t*>(p.Pb + m * LDP + P0_MO + c0);
#pragma unroll
      for (int e = 0; e < 8; ++e) g[e] = sigmoid_f(bf2f((bf16_t)mo[e])) * (bf2f((bf16_t)a[e]) + bf2f((bf16_t)b[e])); }
    else {
#pragma unroll
      for (int e = 0; e < 8; ++e) g[e] = bf2f((bf16_t)a[e]) + bf2f((bf16_t)b[e]); }
#pragma unroll
    for (int e = 0; e < 8; ++e) ss += g[e] * g[e];
    ss += __shfl_xor(ss, 1); ss += __shfl_xor(ss, 2); ss += __shfl_xor(ss, 4); ss += __shfl_xor(ss, 8);
    const float rstd = rsqrtf(ss * (1.f / 128.f) + EPS);
    const float* gain = (LAYER == 0 ? p.h_norm : p.gla_norm) + c0;
    float o[8];
#pragma unroll
    for (int e = 0; e < 8; ++e) o[e] = g[e] * rstd * gain[e] * silu_f(bf2f((bf16_t)z8[e]));
    u32x4_t w; w.x = pk2bf(o[0], o[1]); w.y = pk2bf(o[2], o[3]); w.z = pk2bf(o[4], o[5]); w.w = pk2bf(o[6], o[7]);
    *reinterpret_cast<u32x4_t*>(p.A0 + (size_t)row * LDA + (LAYER == 0 ? BRA : 0) + c0) = w;
  }
}

#ifndef NA_PHASE
#define NA_PHASE 9
#endif
constexpr int NPHASE = 15;
constexpr int DMP = (DM + 255) / 256 * 256, QWP = (QW + 255) / 256 * 256, KVWP = (KVW + 255) / 256 * 256;
#ifdef HOST_TEST
#define FUSE_FINAL false
#else
#define FUSE_FINAL (FUSE_FINAL_STATIC && (int)gridDim.x == 256)
#endif
constexpr bool FAST_OK = (TB % 256 == 0) && (CTX == 256) && (DM % 128 == 0) && (DM >= 256) && (QR % 128 == 0) && (KVR % 128 == 0) && (CW0 % 128 == 0) && (CW1 % 128 == 0);
#ifndef HOST_TEST
#define MOD_MERGE (FAST_OK && WT_OK && GV_OK && USE_FAST(0) && USE_FAST(1) && 2 * (3 * DM / 32) <= NTHREADS)
#endif
#ifndef HOST_TEST
constexpr bool FUSE_FINAL_STATIC = USE_FAST(10) && USE_FAST(11) && FAST_OK && (((DM + 255) / 256 * 256) / 256 == 4) && (((MLAT / 256) * 4) % 256 == 0);
#endif
template <int ph> __device__ __forceinline__ void run_phase_t(const Params& p, unsigned char* lds) {
  switch (ph) {
    case 0:
      if (FAST_OK) {
        if (WT_OK) {
          constexpr int NMOD = 2 * (3 * DM / 32); const bool modfast = USE_FAST(0) && GV_OK && (int)gridDim.x >= NMOD;
          if (USE_FAST(0) && GV_OK) { fp_mod2(p, (float*)lds); __syncthreads(); }
          fp_wt_tiles<0>(p, lds, (int)blockIdx.x, (int)gridDim.x, modfast ? NMOD : 0, (modfast && (int)gridDim.x == 256 && NMOD == 192 && WT_N0 >= 640) ? 3 : 0);
          if (!(USE_FAST(6) && WT_CAN_DEFER)) fp_wt_tiles<1>(p, lds, (int)blockIdx.x, (int)gridDim.x, 0, 0);
        }
        else {
          fp_wt_pair<true>(p.l0_w_in, p.l1_w_in, p.Wt0, p.Wt1, DM, N0, N1, LDP);
          if (CW0 == CW1) fp_wt_pair<false>(p.l0_w_out, p.l1_w_out, p.Wo0, p.Wo1, CW0, DM, DM, DMP);
          else { fp_wt<2>(p.l0_w_out, nullptr, p.Wo0, CW0, DM, DMP); fp_wt<2>(p.l1_w_out, nullptr, p.Wo1, CW1, DM, DMP); }
          fp_wt_rev(p.w_uq, p.q_norm, p.Wq, QR, QW, QWP); fp_wt_rev(p.w_ukv, p.kv_norm, p.Wkv, KVR, KVW, KVWP);
        }
      }
      if (USE_FAST(0)) { if (!(FAST_OK && WT_OK && GV_OK)) { if (GV_OK) fp_mod2(p, (float*)lds); else fp_mod(p, (float*)lds); } fp_zero(p); } else nv_mod(p);
      break;
    case 1:
#ifndef HOST_TEST
      if (MOD_MERGE) {
        if ((int)threadIdx.x < 2 * (3 * DM / 32)) { int sp = 0; while (__hip_atomic_load(&p.bar[MOD_FLAG0 + threadIdx.x], __ATOMIC_RELAXED, __HIP_MEMORY_SCOPE_AGENT) == 0u) { __builtin_amdgcn_s_sleep(1); if (++sp > (1 << 20)) break; } }
        __syncthreads();
      }
#endif
      if (USE_FAST(1)) { if (GV_OK) fp_sw2(p, (float*)lds); else fp_sw(p, (float*)lds); __syncthreads(); fp_prep0(p, (float*)lds); } else { nv_prep0(p); nv_sw(p); }
      fp_gm1(p);
      break;
    case 2:
      if (USE_FAST(2)) run_gemm(lds, p.A0, LDA, p.Wt0, DM, M, LDP, DM, EpiIn<0>{p.Pb, p.ssq0, p.sw, p.ssq_q, p.ssq_kv, p.ropet});
      else nv_gemm_in<0>(p);
      break;
    case 3:
      if (USE_FAST(3)) { run_gemm(lds, p.Pb + P0_CQ, LDP, p.Wq, QR, M, QWP, QR, EpiQ{p.qb, p.ssq_q, p.ropet});
                         run_gemm(lds, p.Pb + P0_CKV, LDP, p.Wkv, KVR, M, KVWP, KVR, EpiKV{p.kn, p.vb, p.ssq_kv}, ((M / 256) * (QWP / 256)) % (int)gridDim.x); }
      else { nv_uq(p); nv_ukv(p); }
      if (USE_FAST(12)) fp_conv(p); else nv_conv(p);
      break;
    case 4:
      if (USE_FAST(13)) scan::mlstm_block<1>(p, lds); else nv_mlstm(p);
      if (USE_FAST(4)) { __syncthreads(); fp_attn(p, lds); } else nv_attn_mla(p);
      break;
    case 5: if (USE_FAST(13)) scan::mlstm_block<2>(p, lds); break;
    case 6: if (USE_FAST(5)) fp_comb<0>(p); else nv_comb0(p); break;
    case 7:
      if (USE_FAST(6)) {
        run_gemm(lds, p.A0, LDA, p.Wo0, CW0, M, DMP, CW0, EpiOut0{p.x, p.ctx, p.modv, p.gm1, p.out, p.A1, p.ssq1});
        if (FAST_OK && WT_OK && WT_CAN_DEFER) {
          const int nwg = (M / 256) * (DMP / 256), G = (int)gridDim.x, nheavy = nwg % G, b = (int)blockIdx.x;
          __syncthreads();
          if (nheavy == 0) fp_wt_tiles<1>(p, lds, b, G, 0, 0); else if (b >= nheavy) fp_wt_tiles<1>(p, lds, b - nheavy, G - nheavy, 0, 0);
        }
      }
      else nv_out0(p);
      break;
    case 8:
      if (USE_FAST(7)) run_gemm(lds, p.A1, LDA, p.Wt1, DM, M, LDP, DM, EpiIn<1>{p.Pb, p.ssq1, p.sw + (size_t)NV * LDP, nullptr, nullptr, nullptr});
      else nv_gemm_in<1>(p);
      break;
    case 9:
      if (USE_FAST(8)) scan::gla_prepass(p, lds); else nv_gla(p);
      if (NA_PHASE == 9) { if (USE_FAST(14)) { __syncthreads(); na2::fp_na2(p, lds); } else nv_na(p); }
      break;
    case 10:
      if (NA_PHASE == 10) { if (USE_FAST(14)) { na2::fp_na2(p, lds); __syncthreads(); } else nv_na(p); }
      if (USE_FAST(8)) scan::gla_block<1>(p, lds);
      break;
    case 11: if (USE_FAST(8)) scan::gla_block<2>(p, lds); break;
    case 12: if (USE_FAST(9)) fp_comb<1>(p); else nv_comb1(p); break;
    case 13:
#ifndef HOST_TEST
      if (FUSE_FINAL) { run_gemm(lds, p.A0, LDA, p.Wo1, CW1, MLAT, DMP, CW1, EpiOut1F{p.modv, p.out, p.ssq2, p.final_norm, p.bar}); break; }
#endif
      if (USE_FAST(10)) run_gemm(lds, p.A0, LDA, p.Wo1, CW1, MLAT, DMP, CW1, EpiOut1{p.modv, p.out, p.ssq2});
      else nv_out1(p);
      break;
    case 14: if (FUSE_FINAL) break; if (USE_FAST(11)) fp_final(p); else nv_final(p); break;
    default: break;
  }
}

#ifdef HOST_TEST
constexpr int TEST_THREADS = 512, TEST_GRID = 3;
static int phase_threads(int ph) {
  auto F = [](int b) { return (g_fastmask >> b) & 1; };
  switch (ph) {
    case 0: return F(0) ? 512 : 0;  case 1: return F(1) ? 512 : 0;  case 2: return F(2) ? 512 : 0;  case 3: return (F(3) || F(12)) ? 512 : 0;
    case 4: return (F(4) || F(13)) ? 512 : 128;  case 5: return 512;  case 6: return F(5) ? 512 : 0;  case 7: return F(6) ? 512 : 0;  case 8: return F(7) ? 512 : 0;
    case 9: return (F(8) || F(14)) ? 512 : 128;  case 10: return 512;  case 11: return 512;  case 12: return F(9) ? 512 : 0;  case 13: return F(10) ? 512 : 0;  case 14: return F(11) ? 512 : 0;
  }
  return 512;
}
#endif
constexpr size_t al256(size_t x) { return (x + 255) / 256 * 256; }
constexpr size_t WS_PB = 0;
constexpr size_t WS_A0 = WS_PB + al256((size_t)M * LDP * 2);
constexpr size_t WS_A1 = WS_A0 + al256((size_t)M * LDA * 2);
constexpr size_t WS_H = WS_A1 + al256((size_t)M * (LDA > 2 * BRB ? LDA : 2 * BRB) * 2);
constexpr size_t WS_SMALL = WS_H + al256((size_t)M * BRB * 2 * 2);
constexpr size_t WS_MODV = WS_SMALL;
constexpr size_t WS_SW = WS_MODV + al256((size_t)2 * NV * 3 * DM * 4);
constexpr size_t WS_SSQ = WS_SW + al256((size_t)2 * NV * LDP * 4);
constexpr size_t WS_GM1 = WS_SSQ + al256((size_t)5 * M * 4);
constexpr size_t WS_ROPE = WS_GM1 + al256((size_t)NV * DM * 4);
constexpr size_t WS_WT0 = WS_ROPE + al256((size_t)RPOS * 16 * 4);
constexpr size_t WS_WT1 = WS_WT0 + al256((size_t)LDP * DM * 2);
constexpr size_t WS_WO0 = WS_WT1 + al256((size_t)LDP * DM * 2);
constexpr size_t WS_WO1 = WS_WO0 + al256((size_t)DMP * CW0 * 2);
constexpr size_t WS_WQ = WS_WO1 + al256((size_t)DMP * CW1 * 2);
constexpr size_t WS_WKV = WS_WQ + al256((size_t)QWP * QR * 2);
constexpr size_t WS_SCAN = WS_WKV + al256((size_t)KVWP * KVR * 2);
constexpr size_t WS_END0 = WS_SCAN + al256((size_t)NB * ML_H * 2 * 4 * 7 * (4096 + 128 + 8) * 4);
constexpr bool QKV_IN_OUT = (size_t)M * (QW + 2 * BRA) * 2 <= (size_t)MLAT * DM * 4;
constexpr size_t WS_BAR = WS_END0;
constexpr size_t WS_BAR_BYTES = 32768;
constexpr size_t WS_QKV = WS_BAR + WS_BAR_BYTES;
constexpr size_t WS_END = WS_QKV + (QKV_IN_OUT ? 0 : al256((size_t)M * (QW + 2 * BRA) * 2));

__host__ __device__ inline void carve(Params& p, unsigned char* ws, float* out) {
  p.out = out;
  p.bar = (unsigned*)(ws + WS_BAR);
  p.Pb = (bf16_t*)(ws + WS_PB); p.A0 = (bf16_t*)(ws + WS_A0); p.A1 = (bf16_t*)(ws + WS_A1);
  p.mqc = p.A1; p.mkc = p.A1 + (size_t)M * BRB;
  p.Hf = (bf16_t*)(ws + WS_H); p.Hb = p.Hf + (size_t)M * BRB;
  p.modv = (float*)(ws + WS_MODV); p.sw = (float*)(ws + WS_SW);
  float* s = (float*)(ws + WS_SSQ); p.ssq0 = s; p.ssq1 = s + M; p.ssq_q = s + 2 * M; p.ssq_kv = s + 3 * M; p.ssq2 = s + 4 * M;
  p.gm1 = (float*)(ws + WS_GM1); p.ropet = (float*)(ws + WS_ROPE); p.scanst = (float*)(ws + WS_SCAN);
  p.Wt0 = (bf16_t*)(ws + WS_WT0); p.Wt1 = (bf16_t*)(ws + WS_WT1); p.Wo0 = (bf16_t*)(ws + WS_WO0); p.Wo1 = (bf16_t*)(ws + WS_WO1); p.Wq = (bf16_t*)(ws + WS_WQ); p.Wkv = (bf16_t*)(ws + WS_WKV);
  p.qb = QKV_IN_OUT ? (bf16_t*)out : (bf16_t*)(ws + WS_QKV); p.kn = p.qb + (size_t)M * QW; p.vb = p.kn + (size_t)M * BRA;
}
__host__ __device__ inline void set_inputs(Params& p, void* const* d_in) {
  const float* const* in = (const float* const*)d_in;
  p.x = in[0]; p.c = in[1]; p.ctx = in[2]; p.c_ctx = in[3];
  p.l0_norm = in[4]; p.l0_w_mod = in[5]; p.l0_b_mod = in[6]; p.l0_w_in = in[7]; p.q_norm = in[8]; p.w_uq = in[9]; p.kv_norm = in[10]; p.w_ukv = in[11];
  p.conv_w = in[12]; p.conv_b = in[13]; p.b_i = in[14]; p.b_f = in[15]; p.h_norm = in[16]; p.l0_w_out = in[17];
  p.l1_norm = in[18]; p.l1_w_mod = in[19]; p.l1_b_mod = in[20]; p.l1_w_in = in[21]; p.w_gate = in[22]; p.b_gate = in[23]; p.gla_norm = in[24]; p.rpb = in[25];
  p.l1_w_out = in[26]; p.final_norm = in[27];
}


#ifndef HOST_TEST
struct XcdBarrier {
    unsigned* bar; unsigned x;
    volatile LAS unsigned* st;
};

__device__ __forceinline__ XcdBarrier xcd_barrier_post(unsigned* bar, volatile LAS unsigned* st) {
    XcdBarrier b; b.bar = bar; b.x = xb_xcc_id(); b.st = st;
    if (threadIdx.x == 0) (void)xb_add(&bar[XB_XCNT(b.x)], 1u);
    return b;
}
__device__ __forceinline__ void xcd_barrier_complete(unsigned* bar, unsigned x, unsigned& nloc, unsigned& nx) {
    const unsigned G = gridDim.x * gridDim.y * gridDim.z;
    unsigned sum, cnt, mine, sp = 0u;
    for (;;) {
        sum = 0u; cnt = 0u; mine = 0u;
#pragma unroll
        for (unsigned j = 0; j < 16; ++j) { const unsigned c = xb_ld(&bar[XB_XCNT(j)]); sum += c; cnt += (c > 0u) ? 1u : 0u; mine = (j == x) ? c : mine; }
        if (sum == G) break;
        __builtin_amdgcn_s_sleep(1);
        if ((++sp & 255u) == 0u) { if (xb_ld(&bar[XB_TMO])) break; if (sp > XB_SPIN_CAP) { atomicAdd(&bar[XB_TMO], 1u); break; } }
    }
    nloc = mine > 0u ? mine : 1u; nx = cnt > 0u ? cnt : 1u;
}

__device__ __forceinline__ void xcd_barrier(const XcdBarrier& b) {
    asm volatile("s_waitcnt vmcnt(0)" ::: "memory");
    __syncthreads();
    if (threadIdx.x == 0) {
        unsigned* bar = b.bar;
        __builtin_amdgcn_s_waitcnt(0);
        unsigned nloc = b.st[0], nx = b.st[1];
        if (nloc == 0u) { xcd_barrier_complete(bar, b.x, nloc, nx); b.st[0] = nloc; b.st[1] = nx; }
        const unsigned old = xb_add(&bar[XB_XSUB(b.x)], 1u);
        const unsigned gen = old / nloc;
        if (old + 1u == (gen + 1u) * nloc) {
            __builtin_amdgcn_fence(__ATOMIC_RELEASE, "agent");
            asm volatile("s_waitcnt vmcnt(0)" ::: "memory");
            const unsigned og = xb_add(&bar[XB_TOP], 1u);
            const unsigned tg = og / nx;
            if (og + 1u == (tg + 1u) * nx) xb_add(&bar[XB_TOPGEN], 1u);
            else XB_SPIN(xb_ld(&bar[XB_TOPGEN]) == tg, bar);
            __builtin_amdgcn_fence(__ATOMIC_ACQUIRE, "agent");
            xb_add(&bar[XB_XGEN(b.x)], 1u);
            asm volatile("s_waitcnt vmcnt(0)" ::: "memory");
        } else {
            XB_SPIN(xb_ld(&bar[XB_XGEN(b.x)]) == gen, bar);
            __builtin_amdgcn_fence(__ATOMIC_ACQUIRE, "agent");
            asm volatile("s_waitcnt vmcnt(0)" ::: "memory");
        }
    }
    __syncthreads();
}
#endif
struct KArgs { const float* in[28]; float* out; unsigned char* ws; int ph_lo, ph_hi; };
template <int ph> __device__ __forceinline__ void phase_scoped(const KArgs& a, unsigned char* lds) {
  Params p; set_inputs(p, (void* const*)a.in); carve(p, a.ws, a.out); p.ph_lo = 0; p.ph_hi = 0;
  run_phase_t<ph>(p, lds);
}
#ifdef HOST_TEST
static void run_phase(const KArgs& a, int ph, unsigned char* lds) {
  switch (ph) { case 0: phase_scoped<0>(a, lds); break; case 1: phase_scoped<1>(a, lds); break; case 2: phase_scoped<2>(a, lds); break; case 3: phase_scoped<3>(a, lds); break;
    case 4: phase_scoped<4>(a, lds); break; case 5: phase_scoped<5>(a, lds); break; case 6: phase_scoped<6>(a, lds); break; case 7: phase_scoped<7>(a, lds); break;
    case 8: phase_scoped<8>(a, lds); break; case 9: phase_scoped<9>(a, lds); break; case 10: phase_scoped<10>(a, lds); break; case 11: phase_scoped<11>(a, lds); break; case 12: phase_scoped<12>(a, lds); break; case 13: phase_scoped<13>(a, lds); break; case 14: phase_scoped<14>(a, lds); break; default: break; }
}
#endif

#ifndef HOST_TEST
constexpr int LDS_BYTES = 151552;
__global__ void __launch_bounds__(NTHREADS, 2) mega(KArgs a) {
  extern __shared__ __attribute__((aligned(16))) unsigned char lds[];
  volatile LAS unsigned* bst = (volatile LAS unsigned*)((LAS unsigned char*)lds + (LDS_BYTES - 64));
  if (threadIdx.x < 2) bst[threadIdx.x] = 0u;
  if (blockIdx.x == 0) { unsigned* bw = (unsigned*)(a.ws + WS_BAR); for (int i = threadIdx.x; i < (int)(WS_BAR_BYTES / 4); i += NTHREADS) bw[i] = 0u; }
  asm volatile("s_waitcnt vmcnt(0) lgkmcnt(0)" ::: "memory");
  cg::this_grid().sync();
  const XcdBarrier bar = xcd_barrier_post((unsigned*)(a.ws + WS_BAR), bst);
#ifndef DUPMASK
#define DUPMASK 0
#endif
#define PH_NOSEAM ((MOD_MERGE ? 1u : 0u) | (ML_MERGE ? (1u << 4) : 0u) | ((ML_MERGE && USE_FAST(8)) ? (1u << 10) : 0u))
#define PHASE(k) if (a.ph_lo <= (k) && (k) < a.ph_hi) { if ((DUPMASK >> (k)) & 1) { phase_scoped<k>(a, lds); xcd_barrier(bar); } phase_scoped<k>(a, lds); if ((k) + 1 < a.ph_hi) { if ((PH_NOSEAM >> (k)) & 1u) __syncthreads(); else xcd_barrier(bar); } }
  PHASE(0) PHASE(1) PHASE(2) PHASE(3) PHASE(4) PHASE(5) PHASE(6) PHASE(7) PHASE(8) PHASE(9) PHASE(10) PHASE(11) PHASE(12) PHASE(13) PHASE(14)
#undef PHASE
}

extern "C" void kernel_launch(void* const* d_in, const int* in_sizes, int n_in, void* d_out, int out_size, void* d_ws, size_t ws_size, hipStream_t stream) {
  static int grid = 0;
  if (grid == 0) {
    int dev = 0, cus = 0, per_cu = 0;
    (void)hipGetDevice(&dev);
    (void)hipDeviceGetAttribute(&cus, hipDeviceAttributeMultiprocessorCount, dev);
    (void)hipFuncSetAttribute((const void*)mega, hipFuncAttributeMaxDynamicSharedMemorySize, LDS_BYTES);
    (void)hipOccupancyMaxActiveBlocksPerMultiprocessor(&per_cu, (const void*)mega, NTHREADS, LDS_BYTES);
    fprintf(stderr, "kernel_launch: cus=%d per_cu=%d ws_size=%zu need=%zu n_in=%d out_size=%d\n", cus, per_cu, ws_size, (size_t)WS_END, n_in, out_size);
    grid = cus;
    if (n_in != 28 || ws_size < WS_END || out_size != MLAT * DM || per_cu < 1) { fprintf(stderr, "kernel_launch: unexpected shapes / workspace; nothing launched\n"); grid = -1; }
  }
  if (grid < 0) return;
  KArgs a{};
  for (int i = 0; i < 28; ++i) a.in[i] = (const float*)d_in[i];
  a.out = (float*)d_out; a.ws = (unsigned char*)d_ws; a.ph_lo = 0; a.ph_hi = (FUSE_FINAL_STATIC && grid == 256) ? NPHASE - 1 : NPHASE;
  void* args[] = {&a};
  hipError_t e = hipLaunchCooperativeKernel((const void*)mega, dim3(grid), dim3(NTHREADS), args, LDS_BYTES, stream);
  if (e != hipSuccess) fprintf(stderr, "cooperative launch failed: %s (grid %d)\n", hipGetErrorString(e), grid);
}
#endif
```
